# Optimizing an MI355X kernel written in HIP

```python
import functools
import jax
import jax.numpy as jnp
from jax import lax
import numpy as np

D_MODEL = 1024
BATCH = 4
SEQ = 8192
DEPTH = 4

GRID_W = 64
CTX_LEN = 256
N_MIXERS = 4
BLOCK = 128
ROPE_THETA = 10000.0
EPS = 1e-6
NEG_INF = -1e30
N_MOD = 6

A_HEADS = 8
A_KV_HEADS = 2
A_HEAD_DIM = 128

B_HEADS = 8
B_Q_LORA = 384
B_KV_LORA = 256
B_NOPE_DIM = 128
B_ROPE_DIM = 64
B_V_DIM = 128

C_WIDTH = 1024
C_GROUPS = 8
C_CHUNK = 128

D_HEADS = 16
D_KV_HEADS = 2
D_HEAD_DIM = 64
D_WINDOW = 128

FF_DENSE = 2816
N_EXPERTS = 8
TOP_K = 2
FF_EXPERT = 3584

kernel_name = 'hybrid_interleaved_diffusion_trunk'


def rmsnorm(t, g):
    tf = t.astype(jnp.float32)
    y = tf * lax.rsqrt(jnp.mean(tf * tf, axis=-1, keepdims=True) + EPS)
    return (y * g.astype(jnp.float32)).astype(t.dtype)


def layernorm(t, g, b):
    tf = t.astype(jnp.float32)
    mu = jnp.mean(tf, axis=-1, keepdims=True)
    var = jnp.mean(jnp.square(tf - mu), axis=-1, keepdims=True)
    y = (tf - mu) * lax.rsqrt(var + EPS)
    return (y * g.astype(jnp.float32) + b.astype(jnp.float32)).astype(t.dtype)


def modulate(t, g, shift, scale):
    return rmsnorm(t, g) * (1 + scale) + shift


def axial_rope_tables(rows, cols, dim):
    quarter = dim // 4
    inv_freq = ROPE_THETA ** (-jnp.arange(quarter, dtype=jnp.float32) / quarter)
    ang_r = rows.astype(jnp.float32)[:, None] * inv_freq
    ang_c = cols.astype(jnp.float32)[:, None] * inv_freq
    ang = jnp.concatenate([ang_r, ang_r, ang_c, ang_c], axis=-1)
    return jnp.cos(ang), jnp.sin(ang)


def apply_rope(t, cos, sin):
    shp = t.shape
    tr = t.reshape(shp[:-1] + (2, 2, shp[-1] // 4))
    rot = jnp.stack([-tr[..., 1, :], tr[..., 0, :]], axis=-2).reshape(shp)
    return t * cos[:, None, :].astype(t.dtype) + rot * sin[:, None, :].astype(t.dtype)


def softmax_with_sink(s, sink):
    m = jnp.maximum(jnp.max(s, axis=-1, keepdims=True), sink)
    e = jnp.exp(s - m)
    return e / (jnp.sum(e, axis=-1, keepdims=True) + jnp.exp(sink - m))


def dense_block_attention(q, k, v, scale, sink=None):
    B, L, Hk, G, dq = q.shape
    nb = L // BLOCK
    qb = jnp.moveaxis(q.reshape(B, nb, BLOCK, Hk, G, dq), 1, 0)

    def one_block(qi):
        s = jnp.einsum('bqhgd,bkhd->bhgqk', qi, k, preferred_element_type=jnp.float32) * scale
        if sink is None:
            p = jax.nn.softmax(s, axis=-1)
        else:
            p = softmax_with_sink(s, sink[None, :, :, None, None])
        return jnp.einsum('bhgqk,bkhd->bqhgd', p.astype(v.dtype), v)

    o = lax.map(one_block, qb)
    return jnp.moveaxis(o, 0, 1).reshape(B, L, Hk * G * v.shape[-1])


def window_sink_attention(q, k, v, kc, vc, sink, scale):
    B, S, Hk, G, dh = q.shape
    nb = S // BLOCK
    n_ctx = kc.shape[1]

    def neighbour_blocks(t):
        tb = jnp.pad(t.reshape(B, nb, BLOCK, Hk, t.shape[-1]), ((0, 0), (1, 1), (0, 0), (0, 0), (0, 0)))
        w = jnp.concatenate([tb[:, :-2], tb[:, 1:-1], tb[:, 2:]], axis=2)
        return jnp.moveaxis(w, 1, 0)

    kw, vw = neighbour_blocks(k), neighbour_blocks(v)
    qb = jnp.moveaxis(q.reshape(B, nb, BLOCK, Hk, G, dh), 1, 0)
    offs = jnp.arange(3 * BLOCK)
    rel = offs[None, :] - BLOCK - jnp.arange(BLOCK)[:, None]
    kblock = jnp.arange(nb)[:, None] + offs[None, :] // BLOCK - 1
    mask = (jnp.abs(rel) <= D_WINDOW)[None] & ((kblock >= 0) & (kblock < nb))[:, None, :]
    sink_b = sink[None, :, :, None, None]

    def one_block(args):
        qi, ki, vi, mi = args
        s_ctx = jnp.einsum('bqhgd,bkhd->bhgqk', qi, kc, preferred_element_type=jnp.float32) * scale
        s_win = jnp.einsum('bqhgd,bkhd->bhgqk', qi, ki, preferred_element_type=jnp.float32) * scale
        s = jnp.concatenate([s_ctx, jnp.where(mi, s_win, NEG_INF)], axis=-1)
        p = softmax_with_sink(s, sink_b).astype(v.dtype)
        return (jnp.einsum('bhgqk,bkhd->bqhgd', p[..., :n_ctx], vc)
                + jnp.einsum('bhgqk,bkhd->bqhgd', p[..., n_ctx:], vi))

    o = lax.map(one_block, (qb, kw, vw, mask))
    return jnp.moveaxis(o, 0, 1).reshape(B, S, Hk * G * v.shape[-1])


def gqa_project(t, wqkv, n_heads, n_kv, dh):
    B, L, _ = t.shape
    q, k, v = jnp.split(t @ wqkv, [n_heads * dh, (n_heads + n_kv) * dh], axis=-1)
    return q.reshape(B, L, n_heads, dh), k.reshape(B, L, n_kv, dh), v.reshape(B, L, n_kv, dh)


def mixer_gqa_axial(h, hc, rope, wqkv, q_norm, k_norm, wo, need_ctx):
    B, S, _ = h.shape
    C = hc.shape[1]
    G = A_HEADS // A_KV_HEADS
    scale = A_HEAD_DIM ** -0.5
    q, k, v = gqa_project(h, wqkv, A_HEADS, A_KV_HEADS, A_HEAD_DIM)
    qc, kc, vc = gqa_project(hc, wqkv, A_HEADS, A_KV_HEADS, A_HEAD_DIM)
    q = apply_rope(rmsnorm(q, q_norm), *rope)
    k = apply_rope(rmsnorm(k, k_norm), *rope)
    kc = rmsnorm(kc, k_norm)
    k_all = jnp.concatenate([kc, k], axis=1)
    v_all = jnp.concatenate([vc, v], axis=1)
    o = dense_block_attention(q.reshape(B, S, A_KV_HEADS, G, A_HEAD_DIM), k_all, v_all, scale) @ wo
    oc = None
    if need_ctx:
        qc = rmsnorm(qc, q_norm).reshape(B, C, A_KV_HEADS, G, A_HEAD_DIM)
        oc = dense_block_attention(qc, kc, vc, scale) @ wo
    return o, oc


def mla_project(t, rope, w_down, q_lora_norm, kv_lora_norm, w_uq, w_ukv):
    B, L, _ = t.shape
    dq, dkv, k_rope = jnp.split(t @ w_down, [B_Q_LORA, B_Q_LORA + B_KV_LORA], axis=-1)
    q = (rmsnorm(dq, q_lora_norm) @ w_uq).reshape(B, L, B_HEADS, B_NOPE_DIM + B_ROPE_DIM)
    kv = (rmsnorm(dkv, kv_lora_norm) @ w_ukv).reshape(B, L, B_HEADS, B_NOPE_DIM + B_V_DIM)
    q_nope, q_rope = jnp.split(q, [B_NOPE_DIM], axis=-1)
    k_nope, v = jnp.split(kv, [B_NOPE_DIM], axis=-1)
    k_rope = k_rope[:, :, None, :]
    if rope is not None:
        q_rope = apply_rope(q_rope, *rope)
        k_rope = apply_rope(k_rope, *rope)
    q = jnp.concatenate([q_nope, q_rope], axis=-1)[:, :, :, None, :]
    k = jnp.concatenate([k_nope, jnp.broadcast_to(k_rope, (B, L, B_HEADS, B_ROPE_DIM))], axis=-1)
    return q, k, v


def mixer_mla(h, hc, rope, w_down, q_lora_norm, kv_lora_norm, w_uq, w_ukv, wo, need_ctx):
    scale = (B_NOPE_DIM + B_ROPE_DIM) ** -0.5
    q, k, v = mla_project(h, rope, w_down, q_lora_norm, kv_lora_norm, w_uq, w_ukv)
    qc, kc, vc = mla_project(hc, None, w_down, q_lora_norm, kv_lora_norm, w_uq, w_ukv)
    k_all = jnp.concatenate([kc, k], axis=1)
    v_all = jnp.concatenate([vc, v], axis=1)
    o = dense_block_attention(q, k_all, v_all, scale) @ wo
    oc = dense_block_attention(qc, kc, vc, scale) @ wo if need_ctx else None
    return o, oc


def sgu_sequence(t, w_in, ln_g, ln_b, w_spatial, b_spatial, w_out):
    B, L, _ = t.shape
    u, v = jnp.split(jax.nn.gelu(t @ w_in, approximate=False), 2, axis=-1)
    v = layernorm(v, ln_g, ln_b).reshape(B, L // C_CHUNK, C_CHUNK, C_GROUPS, C_WIDTH // C_GROUPS)
    mixed = jnp.einsum('gpq,bnqgc->bnpgc', w_spatial, v) + b_spatial.T[:, :, None]
    return (u * mixed.reshape(B, L, C_WIDTH)) @ w_out


def mixer_swa_sink(h, hc, rope, wqkv, sinks, wo, need_ctx):
    B, S, _ = h.shape
    C = hc.shape[1]
    G = D_HEADS // D_KV_HEADS
    scale = D_HEAD_DIM ** -0.5
    q, k, v = gqa_project(h, wqkv, D_HEADS, D_KV_HEADS, D_HEAD_DIM)
    qc, kc, vc = gqa_project(hc, wqkv, D_HEADS, D_KV_HEADS, D_HEAD_DIM)
    q = apply_rope(q, *rope)
    k = apply_rope(k, *rope)
    sink = sinks.astype(jnp.float32).reshape(D_KV_HEADS, G)
    o = window_sink_attention(q.reshape(B, S, D_KV_HEADS, G, D_HEAD_DIM), k, v, kc, vc, sink, scale) @ wo
    oc = None
    if need_ctx:
        oc = dense_block_attention(qc.reshape(B, C, D_KV_HEADS, G, D_HEAD_DIM), kc, vc, scale, sink) @ wo
    return o, oc


def swiglu(t, w13, w2):
    a, b = jnp.split(t @ w13, 2, axis=-1)
    return (jax.nn.silu(a) * b) @ w2


def moe_swiglu(t, router, w13, w2):
    logits = jnp.einsum('bld,de->ble', t, router, preferred_element_type=jnp.float32)
    top_val, top_idx = lax.top_k(logits, TOP_K)
    weights = jax.nn.softmax(top_val, axis=-1)
    gates = jnp.einsum('blk,blke->ble', weights,
                       jax.nn.one_hot(top_idx, N_EXPERTS, dtype=jnp.float32)).astype(t.dtype)
    out = jnp.zeros_like(t)
    for e in range(N_EXPERTS):
        out = out + gates[..., e:e + 1] * swiglu(t, w13[e], w2[e])
    return out


def setup_inputs(seed: int = 0) -> dict:
    key = jax.random.key(seed)
    keys = iter(jax.random.split(key, 64))
    f32 = jnp.float32

    def normal(shape, std):
        return std * jax.random.normal(next(keys), shape, f32)

    def gain(shape):
        return 1.0 + 0.05 * jax.random.normal(next(keys), shape, f32)

    D = D_MODEL
    n_cyc = DEPTH // N_MIXERS
    n_pair = DEPTH // 2
    a_qkv = (A_HEADS + 2 * A_KV_HEADS) * A_HEAD_DIM
    d_qkv = (D_HEADS + 2 * D_KV_HEADS) * D_HEAD_DIM
    return {
        'x': normal((BATCH, SEQ, D), 1.0),
        'c': normal((BATCH, D), 1.0),
        'ctx': normal((BATCH, CTX_LEN, D), 1.0),
        'c_ctx': normal((D,), 1.0),
        'ada_w': normal((DEPTH, D, N_MOD * D), 0.5 * D ** -0.5),
        'ada_b': normal((DEPTH, N_MOD * D), 0.02),
        'norm_mix': gain((DEPTH, D)),
        'norm_ffn': gain((DEPTH, D)),
        'final_norm': gain((D,)),
        'a_wqkv': normal((n_cyc, D, a_qkv), D ** -0.5),
        'a_q_norm': gain((n_cyc, A_HEAD_DIM)),
        'a_k_norm': gain((n_cyc, A_HEAD_DIM)),
        'a_wo': normal((n_cyc, A_HEADS * A_HEAD_DIM, D), (A_HEADS * A_HEAD_DIM) ** -0.5),
        'b_w_down': normal((n_cyc, D, B_Q_LORA + B_KV_LORA + B_ROPE_DIM), D ** -0.5),
        'b_q_lora_norm': gain((n_cyc, B_Q_LORA)),
        'b_kv_lora_norm': gain((n_cyc, B_KV_LORA)),
        'b_w_uq': normal((n_cyc, B_Q_LORA, B_HEADS * (B_NOPE_DIM + B_ROPE_DIM)), B_Q_LORA ** -0.5),
        'b_w_ukv': normal((n_cyc, B_KV_LORA, B_HEADS * (B_NOPE_DIM + B_V_DIM)), B_KV_LORA ** -0.5),
        'b_wo': normal((n_cyc, B_HEADS * B_V_DIM, D), (B_HEADS * B_V_DIM) ** -0.5),
        'c_w_in': normal((n_cyc, D, 2 * C_WIDTH), D ** -0.5),
        'c_ln_g': gain((n_cyc, C_WIDTH)),
        'c_ln_b': normal((n_cyc, C_WIDTH), 0.02),
        'c_w_spatial': normal((n_cyc, C_GROUPS, C_CHUNK, C_CHUNK), C_CHUNK ** -0.5),
        'c_b_spatial': 1.0 + normal((n_cyc, C_GROUPS, C_CHUNK), 0.1),
        'c_w_out': normal((n_cyc, C_WIDTH, D), C_WIDTH ** -0.5),
        'd_wqkv': normal((n_cyc, D, d_qkv), D ** -0.5),
        'd_sinks': normal((n_cyc, D_HEADS), 1.0),
        'd_wo': normal((n_cyc, D_HEADS * D_HEAD_DIM, D), (D_HEADS * D_HEAD_DIM) ** -0.5),
        'ffn_w13': normal((n_pair, D, 2 * FF_DENSE), D ** -0.5),
        'ffn_w2': normal((n_pair, FF_DENSE, D), FF_DENSE ** -0.5),
        'moe_router': normal((n_pair, D, N_EXPERTS), D ** -0.5),
        'moe_w13': normal((n_pair, N_EXPERTS, D, 2 * FF_EXPERT), D ** -0.5),
        'moe_w2': normal((n_pair, N_EXPERTS, FF_EXPERT, D), FF_EXPERT ** -0.5),
    }


def reference(x, c, ctx, c_ctx, ada_w, ada_b, norm_mix, norm_ffn, final_norm,
              a_wqkv, a_q_norm, a_k_norm, a_wo,
              b_w_down, b_q_lora_norm, b_kv_lora_norm, b_w_uq, b_w_ukv, b_wo,
              c_w_in, c_ln_g, c_ln_b, c_w_spatial, c_b_spatial, c_w_out,
              d_wqkv, d_sinks, d_wo,
              ffn_w13, ffn_w2, moe_router, moe_w13, moe_w2):
    B, S, _ = x.shape
    n_rows = S // GRID_W
    rows = jnp.repeat(jnp.arange(n_rows, dtype=jnp.int32), GRID_W)
    cols = jnp.tile(jnp.arange(GRID_W, dtype=jnp.int32), n_rows)
    ropes = {d: axial_rope_tables(rows, cols, d) for d in sorted({A_HEAD_DIM, B_ROPE_DIM, D_HEAD_DIM})}

    mod_lat = (jnp.einsum('bd,ldm->lbm', jax.nn.silu(c), ada_w) + ada_b[:, None, :])[:, :, None, :]
    mod_ctx = (jnp.einsum('d,ldm->lm', jax.nn.silu(c_ctx), ada_w) + ada_b)[:, None, None, :]

    h, hc = x, ctx
    for i in range(DEPTH):
        j, kind = i // N_MIXERS, i % N_MIXERS
        need_ctx = i < DEPTH - 1
        sh1, sc1, g1, sh2, sc2, g2 = jnp.split(mod_lat[i], N_MOD, axis=-1)
        csh1, csc1, cg1, csh2, csc2, cg2 = jnp.split(mod_ctx[i], N_MOD, axis=-1)
        a = modulate(h, norm_mix[i], sh1, sc1)
        ac = modulate(hc, norm_mix[i], csh1, csc1)
        if kind == 0:
            o, oc = mixer_gqa_axial(a, ac, ropes[A_HEAD_DIM], a_wqkv[j], a_q_norm[j], a_k_norm[j], a_wo[j], need_ctx)
        elif kind == 1:
            o, oc = mixer_mla(a, ac, ropes[B_ROPE_DIM], b_w_down[j], b_q_lora_norm[j], b_kv_lora_norm[j],
                              b_w_uq[j], b_w_ukv[j], b_wo[j], need_ctx)
        elif kind == 2:
            sgu = functools.partial(sgu_sequence, w_in=c_w_in[j], ln_g=c_ln_g[j], ln_b=c_ln_b[j],
                                    w_spatial=c_w_spatial[j], b_spatial=c_b_spatial[j], w_out=c_w_out[j])
            o = sgu(a)
            oc = sgu(ac) if need_ctx else None
        else:
            o, oc = mixer_swa_sink(a, ac, ropes[D_HEAD_DIM], d_wqkv[j], d_sinks[j], d_wo[j], need_ctx)
        h = h + g1 * o

        p = i // 2
        if i % 2 == 0:
            ffn = functools.partial(swiglu, w13=ffn_w13[p], w2=ffn_w2[p])
        else:
            ffn = functools.partial(moe_swiglu, router=moe_router[p], w13=moe_w13[p], w2=moe_w2[p])
        h = h + g2 * ffn(modulate(h, norm_ffn[i], sh2, sc2))
        if need_ctx:
            hc = hc + cg1 * oc
            hc = hc + cg2 * ffn(modulate(hc, norm_ffn[i], csh2, csc2))
    return rmsnorm(h, final_norm)
```

```cpp
#include <hip/hip_runtime.h>
#include <cstdio>
#include <cstdint>
#include <cstring>
#include <cmath>

#define GAS __attribute__((address_space(1)))
#define LAS __attribute__((address_space(3)))
typedef unsigned short bf16;
typedef float f32x4 __attribute__((ext_vector_type(4)));
typedef float f32x2 __attribute__((ext_vector_type(2)));
typedef short bf16x8 __attribute__((ext_vector_type(8)));
typedef unsigned u32x4 __attribute__((ext_vector_type(4)));
typedef unsigned u32x2 __attribute__((ext_vector_type(2)));

constexpr int DM = 1024, NB = 4, SEQ = 8192, NCTX = 256, RPB = SEQ + NCTX  , T = NB * RPB  ;
constexpr int GRIDW = 64;
constexpr float EPS = 1e-6f;
constexpr int A_NQKV = 1536, B_NDOWN = 704, B_NDOWN_P = 768, B_QL = 384, B_KVL = 256, B_NUQ = 1536, B_NUKV = 2048, C_NIN = 2048, D_NQKV = 1280;
constexpr int FF = 2816, FE = 3584, NE = 8;
constexpr int MAXSLOT = 69632;

constexpr size_t MiB = 1u << 20;
constexpr size_t al(size_t x) { return (x + 255) & ~(size_t)255; }
constexpr size_t WS_CTL = 0, CTL_BYTES = 1 * MiB;
constexpr size_t WS_MOD = 1 * MiB;
constexpr size_t WS_ROPE128 = 2 * MiB;
constexpr size_t WS_ROPE64 = WS_ROPE128 + 128 * 32 * 8;
constexpr size_t WS_IDX = 3 * MiB;
constexpr size_t WS_GW = WS_IDX + al((size_t)NE * T * 4);
constexpr size_t WS_TOK = WS_GW + al((size_t)NE * T * 4);
constexpr size_t WS_TOKW = WS_TOK + al((size_t)T * 16);
constexpr size_t WS_W0 = 8 * MiB;
static_assert(WS_TOKW + (size_t)T * 8 <= WS_W0, "routing tables fit below the weights");
constexpr size_t W_QKVA = WS_W0;
constexpr size_t W_OA = W_QKVA + (size_t)A_NQKV * DM * 2;
constexpr size_t W_DOWN = W_OA + (size_t)DM * DM * 2;
constexpr size_t W_UQ = W_DOWN + (size_t)B_NDOWN_P * DM * 2;
constexpr size_t W_UKV = W_UQ + (size_t)B_NUQ * B_QL * 2;
constexpr size_t W_OB = W_UKV + (size_t)B_NUKV * B_KVL * 2;
constexpr size_t W_IN = W_OB + (size_t)DM * DM * 2;
constexpr size_t W_OUT = W_IN + (size_t)C_NIN * DM * 2;
constexpr size_t W_SP = W_OUT + (size_t)DM * DM * 2;
constexpr size_t W_QKVD = W_SP + (size_t)8 * 128 * 128 * 2;
constexpr size_t W_OD = W_QKVD + (size_t)D_NQKV * DM * 2;
constexpr size_t W_13F = W_OD + (size_t)DM * DM * 2;
constexpr size_t W_2F = W_13F + (size_t)2 * 2 * FF * DM * 2;
constexpr size_t W_13M = W_2F + (size_t)2 * DM * FF * 2;
constexpr size_t W_2M = W_13M + (size_t)2 * NE * 2 * FE * DM * 2;
constexpr size_t WS_WEND = W_2M + (size_t)2 * NE * DM * FE * 2;
constexpr size_t WS_H = al(WS_WEND);
constexpr size_t WS_A = WS_H + (size_t)T * DM * 2;
constexpr size_t WS_QKV = WS_A + (size_t)T * DM * 2;
constexpr size_t WS_KB = WS_QKV + (size_t)T * 1536 * 2;
constexpr size_t WS_VB = WS_KB + (size_t)T * 1536 * 2;
constexpr size_t WS_OB = WS_VB + (size_t)T * DM * 2;
constexpr size_t WS_DOWN = WS_OB + (size_t)T * DM * 2;
constexpr size_t WS_DQN = WS_DOWN + (size_t)T * B_NDOWN_P * 2;
constexpr size_t WS_DKVN = WS_DQN + (size_t)T * B_QL * 2;
constexpr size_t WS_ACT = WS_DKVN + (size_t)T * B_KVL * 2;
constexpr size_t WS_Y = WS_ACT + (size_t)MAXSLOT * FE * 2;
constexpr size_t WS_END = WS_Y + (size_t)MAXSLOT * DM * 2;
constexpr int CW_CNT = 64;
constexpr int CW_BAR = 4096;

__device__ __forceinline__ unsigned f2bf(float f) { unsigned u = __builtin_bit_cast(unsigned, f); return (u + 0x7fffu + ((u >> 16) & 1u)) >> 16; }
__device__ __forceinline__ unsigned pk2(float lo, float hi) { unsigned r; asm("v_cvt_pk_bf16_f32 %0, %1, %2" : "=v"(r) : "v"(lo), "v"(hi)); return r; }
__device__ __forceinline__ float bf2f(unsigned b) { return __builtin_bit_cast(float, b << 16); }
__device__ __forceinline__ float bflo(unsigned w) { return __builtin_bit_cast(float, w << 16); }
__device__ __forceinline__ float bfhi(unsigned w) { return __builtin_bit_cast(float, w & 0xffff0000u); }
__device__ __forceinline__ float wave_sum(float v) {
#pragma unroll
    for (int o = 1; o < 64; o <<= 1) v += __shfl_xor(v, o);
    return v;
}
__device__ __forceinline__ int otid(int wv) { int l; asm volatile("v_mbcnt_lo_u32_b32 %0, -1, 0\n\tv_mbcnt_hi_u32_b32 %0, -1, %0" : "=v"(l)); return wv * 64 + l; }
__device__ __forceinline__ float silu_f(float x) { return x / (1.f + __expf(-x)); }
__device__ __forceinline__ float gelu_erf(float x) { return 0.5f * x * (1.f + erff(x * 0.70710678118654752f)); }

struct P {
    const float* in[33];
    float* out;
    unsigned char* ws;
    int ph_lo, ph_hi;
};
#define WSP(type, off) ((type*)(p.ws + (off)))
#define SUB_SKIP(u, ai, bj) ((u).sub != 0 && (u).sub != 1 + (ai) * 2 + (bj))

__device__ __forceinline__ void row_info(int r, int& b, int& j) { b = r / RPB; j = r - b * RPB; }
__device__ __forceinline__ const float* in_row(const P& p, int r) {
    int b, j; row_info(r, b, j);
    return j < NCTX ? p.in[2] + ((size_t)b * NCTX + j) * DM : p.in[0] + ((size_t)b * SEQ + (j - NCTX)) * DM;
}
__device__ __forceinline__ const float* mod_vec(const P& p, int layer, int r, int chunk) {
    int b, j; row_info(r, b, j); const int mr = j < NCTX ? 4 : b;
    return WSP(const float, WS_MOD) + ((size_t)(layer * 5 + mr) * 6 + chunk) * DM;
}

__device__ __forceinline__ void transpose_item(const float* W, int K, int N, bf16* WT, int mode, int ffh, LAS float* scr, int item, int lane) {
    const int nblk = N / 64, kb = item / nblk, nb = item % nblk, k0 = 64 * kb, n0 = 64 * nb;
    const int lr = lane >> 4, lc = (lane & 15) * 4;
#pragma unroll 8
    for (int i = 0; i < 16; ++i) { const int kk = 4 * i + lr; const f32x4 v = *(const f32x4*)(W + (size_t)(k0 + kk) * N + n0 + lc); LAS float* d = scr + kk * 65 + lc; d[0] = v.x; d[1] = v.y; d[2] = v.z; d[3] = v.w; }
    asm volatile("s_waitcnt lgkmcnt(0)" ::: "memory");
    int d0 = n0;
    if (mode == 1) { if (n0 < ffh) d0 = (n0 / 128) * 256 + n0 % 128; else { const int j = n0 - ffh; d0 = (j / 128) * 256 + 128 + j % 128; } }
    const int c = lane & 7;
#pragma unroll
    for (int j = 0; j < 8; ++j) { const int n = (lane >> 3) + 8 * j; const LAS float* s = scr + (8 * c) * 65 + n;
        u32x4 o; o.x = pk2(s[0 * 65], s[1 * 65]); o.y = pk2(s[2 * 65], s[3 * 65]); o.z = pk2(s[4 * 65], s[5 * 65]); o.w = pk2(s[6 * 65], s[7 * 65]);
        const int dn = d0 + n;
        if (mode == 2) *(u32x4*)(WT + (((size_t)(dn >> 8) * (K >> 6) + kb) * 256 + (dn & 255)) * 64 + 8 * c) = o;
        else *(u32x4*)(WT + (size_t)dn * K + k0 + 8 * c) = o; }
    asm volatile("s_waitcnt lgkmcnt(0)" ::: "memory");
}
struct TJob { const float* W; bf16* WT; int K, N, mode, ffh, items; };

__device__ __forceinline__ void phase_prologue(const P& p, int wv, int bid, int nb, unsigned char* lds_) {
    LAS unsigned char* lds = (LAS unsigned char*)lds_;
    const int tid = otid(wv), lane = tid & 63, wave = tid >> 6;
    {
        const int g = bid * 512 + tid;
        if (g < 128 * 32) { const int pos = g >> 5, i = g & 31; const float inv = (float)pow(10000.0, -(double)i / 32.0); const float a = (float)pos * inv;
            WSP(f32x2, WS_ROPE128)[g] = (f32x2){cosf(a), sinf(a)}; }
        else if (g < 128 * 32 + 128 * 16) { const int q = g - 128 * 32, pos = q >> 4, i = q & 15; const float inv = (float)pow(10000.0, -(double)i / 16.0); const float a = (float)pos * inv;
            WSP(f32x2, WS_ROPE64)[q] = (f32x2){cosf(a), sinf(a)}; }
    }
    {
        LAS float* sc = (LAS float*)lds;
        LAS float* red = (LAS float*)(lds + 5 * 1024 * 4);
        for (int it = bid; it < 192; it += nb) {
            const int layer = it / 48, cg = it % 48;
            __syncthreads();
            for (int i = tid; i < 5 * 1024; i += 512) { const int r = i >> 10, k = i & 1023; const float v = r < 4 ? p.in[1][r * DM + k] : p.in[3][k]; sc[i] = silu_f(v); }
            __syncthreads();
            const float* W = p.in[4] + (size_t)layer * DM * 6144 + cg * 128 + lane * 2;
            f32x2 acc[5];
#pragma unroll
            for (int r = 0; r < 5; ++r) acc[r] = (f32x2){0.f, 0.f};
            for (int k = wave * 128; k < wave * 128 + 128; ++k) { const f32x2 w = *(const f32x2*)(W + (size_t)k * 6144);
#pragma unroll
                for (int r = 0; r < 5; ++r) acc[r] += w * sc[r * 1024 + k]; }
#pragma unroll
            for (int r = 0; r < 5; ++r) *(LAS f32x2*)(red + (wave * 5 + r) * 128 + lane * 2) = acc[r];
            __syncthreads();
            for (int i = tid; i < 5 * 128; i += 512) { const int r = i >> 7, c = i & 127; float s = 0.f;
#pragma unroll
                for (int w = 0; w < 8; ++w) s += red[(w * 5 + r) * 128 + c];
                const int col = cg * 128 + c;
                WSP(float, WS_MOD)[(size_t)(layer * 5 + r) * 6144 + col] = s + p.in[5][layer * 6144 + col]; }
        }
        __syncthreads();
    }
    {
        LAS float* scr = (LAS float*)(lds + wave * 16640);
        const int gw = bid * 8 + wave, NGW = nb * 8;
        int start = 0;
        auto run = [&](const float* W, bf16* WT, int K, int N, int mode, int ffh) {
            const int items = (K / 64) * (N / 64);
            int first = gw - start; if (first < 0) first += NGW;
            for (int it = first; it < items; it += NGW) transpose_item(W, K, N, WT, mode, ffh, scr, it, lane);
            start = (start + items) % NGW;
        };
        run(p.in[9], WSP(bf16, W_QKVA), DM, A_NQKV, 0, 0);
        run(p.in[12], WSP(bf16, W_OA), DM, DM, 0, 0);
        run(p.in[13], WSP(bf16, W_DOWN), DM, B_NDOWN, 0, 0);
        run(p.in[16], WSP(bf16, W_UQ), B_QL, B_NUQ, 0, 0);
        run(p.in[17], WSP(bf16, W_UKV), B_KVL, B_NUKV, 0, 0);
        run(p.in[18], WSP(bf16, W_OB), DM, DM, 0, 0);
        run(p.in[19], WSP(bf16, W_IN), DM, C_NIN, 0, 0);
        run(p.in[24], WSP(bf16, W_OUT), DM, DM, 0, 0);
        run(p.in[25], WSP(bf16, W_QKVD), DM, D_NQKV, 0, 0);
        run(p.in[27], WSP(bf16, W_OD), DM, DM, 0, 0);
        for (int l = 0; l < 2; ++l) {
            run(p.in[28] + (size_t)l * DM * 2 * FF, WSP(bf16, W_13F) + (size_t)l * 2 * FF * DM, DM, 2 * FF, 1, FF);
            run(p.in[29] + (size_t)l * FF * DM, WSP(bf16, W_2F) + (size_t)l * DM * FF, FF, DM, 2, 0);
        }
        for (int le = 0; le < 2 * NE; ++le) {
            run(p.in[31] + (size_t)le * DM * 2 * FE, WSP(bf16, W_13M) + (size_t)le * 2 * FE * DM, DM, 2 * FE, 1, FE);
            run(p.in[32] + (size_t)le * FE * DM, WSP(bf16, W_2M) + (size_t)le * DM * FE, FE, DM, 2, 0);
        }
        const int g = bid * 512 + tid, ng = nb * 512;
        for (int i = g; i < 64 * DM / 8; i += ng) *(u32x4*)(WSP(bf16, W_DOWN) + (size_t)B_NDOWN * DM + i * 8) = (u32x4){0u, 0u, 0u, 0u};
        for (int i = g; i < 8 * 128 * 128 / 4; i += ng) { const f32x4 v = *(const f32x4*)(p.in[22] + i * 4); *(u32x2*)(WSP(bf16, W_SP) + i * 4) = (u32x2){pk2(v.x, v.y), pk2(v.z, v.w)}; }
    }
}

__device__ __forceinline__ void moe_offsets_lds(const P& p, int m, LAS int* off  ) {
    const unsigned* cnt = WSP(const unsigned, WS_CTL) + CW_CNT + 64 * m; int o = 0;
    for (int e = 0; e < NE; ++e) { off[e] = o; const int c = (int)__hip_atomic_load(cnt + e, __ATOMIC_RELAXED, __HIP_MEMORY_SCOPE_AGENT); o += (c + 255) & ~255; }
    off[NE] = o;
}

template <int MODE>
__device__ __forceinline__ void phase_norm(const P& p, int wv, int bid, int nb, unsigned char* lds_, int layer, int which  , int m_prev, int prev_layer, int m_cur, bool route_ctx) {
    LAS unsigned char* lds = (LAS unsigned char*)lds_;
    const int tid = otid(wv), lane = tid & 63, wave = tid >> 6;
    const int per = (T + nb - 1) / nb, r0 = bid * per, r1 = min(T, r0 + per);
    LAS float* rt = (LAS float*)lds;
    LAS int* re = (LAS int*)(lds + 32768);
    LAS float* rw = (LAS float*)(lds + 32768 + 8192);
    LAS int* soff = (LAS int*)(lds + 32768 + 16384);
    if (MODE & 4) { const float* R = p.in[30] + (size_t)m_cur * DM * NE; for (int i = tid; i < DM * NE; i += 512) rt[i] = R[i]; }
    if (MODE & 2) { if (tid == 0) moe_offsets_lds(p, m_prev, soff); }
    __syncthreads();
    const float* gain = (MODE & 8) ? p.in[8] : (which == 0 ? p.in[6] : p.in[7]) + (size_t)layer * DM;
    int cur_mr = -1; f32x4 gm[4], shv[4], g2v[4];
#pragma unroll
    for (int q = 0; q < 4; ++q) { gm[q] = (f32x4){0.f, 0.f, 0.f, 0.f}; shv[q] = gm[q]; g2v[q] = gm[q]; }
    for (int r = r0 + wave; r < r1; r += 8) {
        int b, j; row_info(r, b, j); const bool isctx = j < NCTX;
        if ((MODE & 8) && isctx) continue;
        { const int mr = isctx ? 4 : b;
          if (mr != cur_mr) { cur_mr = mr;
            if (MODE & 2) { const float* g2 = mod_vec(p, prev_layer, r, 5);
#pragma unroll
                for (int q = 0; q < 4; ++q) g2v[q] = *(const f32x4*)(g2 + q * 256 + lane * 4); }
            if (MODE & 8) {
#pragma unroll
                for (int q = 0; q < 4; ++q) gm[q] = *(const f32x4*)(gain + q * 256 + lane * 4); }
            else { const float* sh_ = mod_vec(p, layer, r, which * 3 + 0); const float* sc_ = mod_vec(p, layer, r, which * 3 + 1);
#pragma unroll
                for (int q = 0; q < 4; ++q) { const f32x4 g = *(const f32x4*)(gain + q * 256 + lane * 4), s1 = *(const f32x4*)(sc_ + q * 256 + lane * 4); gm[q] = g * (s1 + 1.f); shv[q] = *(const f32x4*)(sh_ + q * 256 + lane * 4); } } } }
        f32x4 v[4];
        if (MODE & 1) { const float* src = in_row(p, r);
#pragma unroll
            for (int q = 0; q < 4; ++q) v[q] = *(const f32x4*)(src + q * 256 + lane * 4); }
        else { const bf16* src = WSP(const bf16, WS_H) + (size_t)r * DM;
#pragma unroll
            for (int q = 0; q < 4; ++q) { const u32x2 w = *(const u32x2*)(src + q * 256 + lane * 4); v[q] = (f32x4){bflo(w.x), bfhi(w.x), bflo(w.y), bfhi(w.y)}; } }
        if (MODE & 2) {
            const int4 tk = WSP(const int4, WS_TOK)[r];
            const bool routed = tk.x >= 0;
            if (routed) {
                const int s0 = soff[tk.x] + tk.y, s1 = soff[tk.z] + tk.w;
                const bf16* y0 = WSP(const bf16, WS_Y) + (size_t)s0 * DM; const bf16* y1 = WSP(const bf16, WS_Y) + (size_t)s1 * DM;
                const f32x2 tw = WSP(const f32x2, WS_TOKW)[r];
#pragma unroll
                for (int q = 0; q < 4; ++q) { const u32x2 a = *(const u32x2*)(y0 + q * 256 + lane * 4), c = *(const u32x2*)(y1 + q * 256 + lane * 4); const f32x4 g = g2v[q];
                    v[q].x += g.x * (tw.x * bflo(a.x) + tw.y * bflo(c.x)); v[q].y += g.y * (tw.x * bfhi(a.x) + tw.y * bfhi(c.x)); v[q].z += g.z * (tw.x * bflo(a.y) + tw.y * bflo(c.y)); v[q].w += g.w * (tw.x * bfhi(a.y) + tw.y * bfhi(c.y)); }
                if (!(MODE & 8)) {
#pragma unroll
                    for (int q = 0; q < 4; ++q) *(u32x2*)(WSP(bf16, WS_H) + (size_t)r * DM + q * 256 + lane * 4) = (u32x2){pk2(v[q].x, v[q].y), pk2(v[q].z, v[q].w)};
                }
            }
        }
        float ss = 0.f;
#pragma unroll
        for (int q = 0; q < 4; ++q) ss += (v[q].x * v[q].x + v[q].y * v[q].y) + (v[q].z * v[q].z + v[q].w * v[q].w);
        const float rs = rsqrtf(wave_sum(ss) * (1.f / DM) + EPS);
        if (MODE & 8) {
            float* o = p.out + ((size_t)b * SEQ + (j - NCTX)) * DM;
#pragma unroll
            for (int q = 0; q < 4; ++q) *(f32x4*)(o + q * 256 + lane * 4) = v[q] * rs * gm[q];
            continue;
        }
#pragma unroll
        for (int q = 0; q < 4; ++q) {
            v[q] = (v[q] * rs) * gm[q] + shv[q];
            *(u32x2*)(WSP(bf16, WS_A) + (size_t)r * DM + q * 256 + lane * 4) = (u32x2){pk2(v[q].x, v[q].y), pk2(v[q].z, v[q].w)}; }
        if (MODE & 4) {
            const int li = r - r0;
            if (isctx && !route_ctx) { if (lane == 0) { re[li * 2] = -1; re[li * 2 + 1] = -1; } }
            else {
                float lg[8];
#pragma unroll
                for (int e = 0; e < 8; ++e) lg[e] = 0.f;
#pragma unroll
                for (int q = 0; q < 4; ++q)
#pragma unroll
                    for (int c = 0; c < 4; ++c) { const int col = q * 256 + lane * 4 + c; const f32x4 w0 = *(LAS f32x4*)(rt + col * 8), w1 = *(LAS f32x4*)(rt + col * 8 + 4); const float a = v[q][c];
                        lg[0] += a * w0.x; lg[1] += a * w0.y; lg[2] += a * w0.z; lg[3] += a * w0.w; lg[4] += a * w1.x; lg[5] += a * w1.y; lg[6] += a * w1.z; lg[7] += a * w1.w; }
#pragma unroll
                for (int e = 0; e < 8; ++e) lg[e] = wave_sum(lg[e]);
                int e0 = 0; float v0 = lg[0];
#pragma unroll
                for (int e = 1; e < 8; ++e) if (lg[e] > v0) { v0 = lg[e]; e0 = e; }
                int e1 = -1; float v1 = -3.0e38f;
#pragma unroll
                for (int e = 0; e < 8; ++e) if (e != e0 && lg[e] > v1) { v1 = lg[e]; e1 = e; }
                const float w1 = 1.f / (1.f + __expf(v0 - v1)), w0 = 1.f - w1;
                if (lane == 0) { re[li * 2] = e0; re[li * 2 + 1] = e1; rw[li * 2] = w0; rw[li * 2 + 1] = w1; }
            }
        }
    }
    if (MODE & 4) {
        __syncthreads();
        if (tid < NE) {
            const int e = tid, n = r1 - r0; int c = 0;
            for (int i = 0; i < 2 * n; ++i) c += (re[i] == e);
            unsigned* cnt = WSP(unsigned, WS_CTL) + CW_CNT + 64 * m_cur + e;
            int base = c ? (int)__hip_atomic_fetch_add(cnt, (unsigned)c, __ATOMIC_RELAXED, __HIP_MEMORY_SCOPE_AGENT) : 0;
            int* idx = WSP(int, WS_IDX) + (size_t)e * T; float* gw = WSP(float, WS_GW) + (size_t)e * T; int* tok = WSP(int, WS_TOK);
            for (int i = 0; i < 2 * n; ++i) if (re[i] == e) { const int r = r0 + (i >> 1); idx[base] = r; gw[base] = rw[i]; tok[r * 4 + (i & 1) * 2] = e; tok[r * 4 + (i & 1) * 2 + 1] = base; WSP(float, WS_TOKW)[r * 2 + (i & 1)] = rw[i]; ++base; }
        }
        for (int i = tid; i < r1 - r0; i += 512) if (re[i * 2] < 0) { int* tok = WSP(int, WS_TOK); const int r = r0 + i; tok[r * 4] = -1; tok[r * 4 + 1] = 0; tok[r * 4 + 2] = -1; tok[r * 4 + 3] = 0; }
    }
}

template <bool FINAL>
__device__ __forceinline__ void phase_combine(const P& p, int wv, int bid, int nb, unsigned char* lds_, int layer, int which, int m_prev, int prev_layer) {
    LAS unsigned char* lds = (LAS unsigned char*)lds_;
    const int tid = otid(wv), lane = tid & 63, wave = tid >> 6;
    const int per = (T + nb - 1) / nb, r0 = bid * per, r1 = min(T, r0 + per);
    LAS int* soff = (LAS int*)(lds + 32768 + 16384);
    if (tid < NE) soff[16 + tid] = (int)__hip_atomic_load(WSP(const unsigned, WS_CTL) + CW_CNT + 64 * m_prev + tid, __ATOMIC_RELAXED, __HIP_MEMORY_SCOPE_AGENT);
    __syncthreads();
    if (tid == 0) { int o = 0; for (int e = 0; e < NE; ++e) { soff[e] = o; o += (soff[16 + e] + 255) & ~255; } soff[NE] = o; }
    __syncthreads();
    const float* gain = FINAL ? p.in[8] : (which == 0 ? p.in[6] : p.in[7]) + (size_t)layer * DM;
    int cur_mr = -1; f32x4 gm[4], shv[4], g2v[4];
#pragma unroll
    for (int q = 0; q < 4; ++q) { gm[q] = (f32x4){0.f, 0.f, 0.f, 0.f}; shv[q] = gm[q]; g2v[q] = gm[q]; }
    const int4* TOK = WSP(const int4, WS_TOK); const f32x2* TOKW = WSP(const f32x2, WS_TOKW);
    const bf16* Yb = WSP(const bf16, WS_Y); bf16* Hb = WSP(bf16, WS_H);
#define CMB_LOAD(hX, aX, cX, rr, tk) do { const bool _ro = (tk).x >= 0; const int _s0 = _ro ? soff[(tk).x] + (tk).y : 0, _s1 = _ro ? soff[(tk).z] + (tk).w : 0; \
        const bf16* _h = Hb + (size_t)(rr) * DM + lane * 4; const bf16* _y0 = Yb + (size_t)_s0 * DM + lane * 4; const bf16* _y1 = Yb + (size_t)_s1 * DM + lane * 4; \
        _Pragma("unroll") for (int q = 0; q < 4; ++q) { hX[q] = *(const u32x2*)(_h + q * 256); aX[q] = *(const u32x2*)(_y0 + q * 256); cX[q] = *(const u32x2*)(_y1 + q * 256); } } while (0)
    int r = r0 + wave;
    if (r < r1) {
        int4 tk_c = TOK[r]; f32x2 tw_c = TOKW[r];
        int4 tk_n = tk_c; f32x2 tw_n = tw_c; if (r + 8 < r1) { tk_n = TOK[r + 8]; tw_n = TOKW[r + 8]; }
        u32x2 hA[4], aA[4], cA[4];
        CMB_LOAD(hA, aA, cA, r, tk_c);
        for (; r < r1; r += 8) {
            u32x2 hB[4], aB[4], cB[4];
#pragma unroll
            for (int q = 0; q < 4; ++q) { hB[q] = hA[q]; aB[q] = aA[q]; cB[q] = cA[q]; }
            if (r + 8 < r1) CMB_LOAD(hB, aB, cB, r + 8, tk_n);
            int4 tk_nn = tk_n; f32x2 tw_nn = tw_n; if (r + 16 < r1) { tk_nn = TOK[r + 16]; tw_nn = TOKW[r + 16]; }
            int b, j; row_info(r, b, j); const bool isctx = j < NCTX;
            if (!(FINAL && isctx)) {
                const int mr = isctx ? 4 : b;
                if (mr != cur_mr) { cur_mr = mr; const float* g2 = mod_vec(p, prev_layer, r, 5);
#pragma unroll
                    for (int q = 0; q < 4; ++q) g2v[q] = *(const f32x4*)(g2 + q * 256 + lane * 4);
                    if (FINAL) {
#pragma unroll
                        for (int q = 0; q < 4; ++q) gm[q] = *(const f32x4*)(gain + q * 256 + lane * 4); }
                    else { const float* sh_ = mod_vec(p, layer, r, which * 3 + 0); const float* sc_ = mod_vec(p, layer, r, which * 3 + 1);
#pragma unroll
                        for (int q = 0; q < 4; ++q) { const f32x4 g = *(const f32x4*)(gain + q * 256 + lane * 4), s1 = *(const f32x4*)(sc_ + q * 256 + lane * 4); gm[q] = g * (s1 + 1.f); shv[q] = *(const f32x4*)(sh_ + q * 256 + lane * 4); } } }
                f32x4 v[4];
#pragma unroll
                for (int q = 0; q < 4; ++q) v[q] = (f32x4){bflo(hA[q].x), bfhi(hA[q].x), bflo(hA[q].y), bfhi(hA[q].y)};
                if (tk_c.x >= 0) {
#pragma unroll
                    for (int q = 0; q < 4; ++q) { const u32x2 a = aA[q], c = cA[q]; const f32x4 g = g2v[q];
                        v[q].x += g.x * (tw_c.x * bflo(a.x) + tw_c.y * bflo(c.x)); v[q].y += g.y * (tw_c.x * bfhi(a.x) + tw_c.y * bfhi(c.x)); v[q].z += g.z * (tw_c.x * bflo(a.y) + tw_c.y * bflo(c.y)); v[q].w += g.w * (tw_c.x * bfhi(a.y) + tw_c.y * bfhi(c.y)); }
                    if (!FINAL) {
#pragma unroll
                        for (int q = 0; q < 4; ++q) *(u32x2*)(Hb + (size_t)r * DM + q * 256 + lane * 4) = (u32x2){pk2(v[q].x, v[q].y), pk2(v[q].z, v[q].w)}; }
                }
                float ss = 0.f;
#pragma unroll
                for (int q = 0; q < 4; ++q) ss += (v[q].x * v[q].x + v[q].y * v[q].y) + (v[q].z * v[q].z + v[q].w * v[q].w);
                const float rs = rsqrtf(wave_sum(ss) * (1.f / DM) + EPS);
                if (FINAL) { float* o = p.out + ((size_t)b * SEQ + (j - NCTX)) * DM;
#pragma unroll
                    for (int q = 0; q < 4; ++q) *(f32x4*)(o + q * 256 + lane * 4) = v[q] * rs * gm[q]; }
                else {
#pragma unroll
                    for (int q = 0; q < 4; ++q) { const f32x4 o = (v[q] * rs) * gm[q] + shv[q]; *(u32x2*)(WSP(bf16, WS_A) + (size_t)r * DM + q * 256 + lane * 4) = (u32x2){pk2(o.x, o.y), pk2(o.z, o.w)}; } }
            }
#pragma unroll
            for (int q = 0; q < 4; ++q) { hA[q] = hB[q]; aA[q] = aB[q]; cA[q] = cB[q]; }
            tk_c = tk_n; tw_c = tw_n; tk_n = tk_nn; tw_n = tw_nn;
        }
    }
#undef CMB_LOAD
}

template <bool FROM_IN>
__device__ __forceinline__ void phase_norm_plain(const P& p, int wv, int bid, int nb, int layer, int which) {
    const int tid = otid(wv), lane = tid & 63, wave = tid >> 6;
    const int per = (T + nb - 1) / nb, r0 = bid * per, r1 = min(T, r0 + per);
    const float* gain = (which == 0 ? p.in[6] : p.in[7]) + (size_t)layer * DM;
    int cur_mr = -1; f32x4 gm[4], shv[4];
#pragma unroll
    for (int q = 0; q < 4; ++q) { gm[q] = (f32x4){0.f, 0.f, 0.f, 0.f}; shv[q] = gm[q]; }
    for (int r = r0 + wave; r < r1; r += 16) {
        const int ra = r, rb = (r + 8 < r1) ? r + 8 : r;
        f32x4 va[4], vb[4];
        if (FROM_IN) { const float* sa = in_row(p, ra); const float* sb = in_row(p, rb);
#pragma unroll
            for (int q = 0; q < 4; ++q) { va[q] = *(const f32x4*)(sa + q * 256 + lane * 4); vb[q] = *(const f32x4*)(sb + q * 256 + lane * 4); } }
        else { const bf16* sa = WSP(const bf16, WS_H) + (size_t)ra * DM; const bf16* sb = WSP(const bf16, WS_H) + (size_t)rb * DM; u32x2 wa[4], wb[4];
#pragma unroll
            for (int q = 0; q < 4; ++q) { wa[q] = *(const u32x2*)(sa + q * 256 + lane * 4); wb[q] = *(const u32x2*)(sb + q * 256 + lane * 4); }
#pragma unroll
            for (int q = 0; q < 4; ++q) { va[q] = (f32x4){bflo(wa[q].x), bfhi(wa[q].x), bflo(wa[q].y), bfhi(wa[q].y)}; vb[q] = (f32x4){bflo(wb[q].x), bfhi(wb[q].x), bflo(wb[q].y), bfhi(wb[q].y)}; } }
        float sa2 = 0.f, sb2 = 0.f;
#pragma unroll
        for (int q = 0; q < 4; ++q) { sa2 += (va[q].x * va[q].x + va[q].y * va[q].y) + (va[q].z * va[q].z + va[q].w * va[q].w); sb2 += (vb[q].x * vb[q].x + vb[q].y * vb[q].y) + (vb[q].z * vb[q].z + vb[q].w * vb[q].w); }
        const float rsa = rsqrtf(wave_sum(sa2) * (1.f / DM) + EPS), rsb = rsqrtf(wave_sum(sb2) * (1.f / DM) + EPS);
#pragma unroll
        for (int half = 0; half < 2; ++half) {
            const int rr = half ? rb : ra; int b, j; row_info(rr, b, j); const int mr = (j < NCTX) ? 4 : b;
            if (mr != cur_mr) { cur_mr = mr; const float* sh_ = mod_vec(p, layer, rr, which * 3 + 0); const float* sc_ = mod_vec(p, layer, rr, which * 3 + 1);
#pragma unroll
                for (int q = 0; q < 4; ++q) { const f32x4 g = *(const f32x4*)(gain + q * 256 + lane * 4), s1 = *(const f32x4*)(sc_ + q * 256 + lane * 4); gm[q] = g * (s1 + 1.f); shv[q] = *(const f32x4*)(sh_ + q * 256 + lane * 4); } }
            const float rs = half ? rsb : rsa;
#pragma unroll
            for (int q = 0; q < 4; ++q) { const f32x4 o = ((half ? vb[q] : va[q]) * rs) * gm[q] + shv[q];
                *(u32x2*)(WSP(bf16, WS_A) + (size_t)rr * DM + q * 256 + lane * 4) = (u32x2){pk2(o.x, o.y), pk2(o.z, o.w)}; }
        }
    }
}

__device__ __forceinline__ void phase_post_a(const P& p, int wv, int bid, int nb) {
    const int tid = otid(wv), hw = (bid * 512 + tid) >> 5, nhw = nb * 16, l = tid & 31;
    const f32x2* cs = WSP(const f32x2, WS_ROPE128);
    for (int it = hw; it < T * 10; it += nhw) {
        const int r = it / 10, h = it - r * 10; int b, j; row_info(r, b, j);
        bf16* ptr = WSP(bf16, WS_QKV) + (size_t)r * A_NQKV + h * 128 + l * 4;
        const u32x2 raw = *(const u32x2*)ptr; float x[4] = {bflo(raw.x), bfhi(raw.x), bflo(raw.y), bfhi(raw.y)};
        float ss = x[0] * x[0] + x[1] * x[1] + x[2] * x[2] + x[3] * x[3];
#pragma unroll
        for (int o = 1; o < 32; o <<= 1) ss += __shfl_xor(ss, o);
        const float rs = rsqrtf(ss * (1.f / 128.f) + EPS);
        const float* w = (h < 8 ? p.in[10] : p.in[11]) + l * 4;
#pragma unroll
        for (int e = 0; e < 4; ++e) x[e] = x[e] * rs * w[e];
        float y[4];
        if (j >= NCTX) {
            const int s = j - NCTX, pos = (l < 16) ? (s / GRIDW) : (s % GRIDW);
            const bool second = (l & 8) != 0;
#pragma unroll
            for (int e = 0; e < 4; ++e) { const float o = __shfl_xor(x[e], 8); const int f = ((l & 7) * 4 + e); const f32x2 c = cs[pos * 32 + f];
                y[e] = second ? (x[e] * c.x + o * c.y) : (x[e] * c.x - o * c.y); }
        } else {
#pragma unroll
            for (int e = 0; e < 4; ++e) y[e] = x[e];
        }
        *(u32x2*)ptr = (u32x2){pk2(y[0], y[1]), pk2(y[2], y[3])};
    }
}
__device__ __forceinline__ void phase_post_b1(const P& p, int wv, int bid, int nb) {
    const int tid = otid(wv), lane = tid & 63, gw = bid * 8 + (tid >> 6), ngw = nb * 8;
    const f32x2* cs = WSP(const f32x2, WS_ROPE64);
    for (int r = gw; r < T; r += ngw) {
        int b, j; row_info(r, b, j);
        const bf16* d = WSP(const bf16, WS_DOWN) + (size_t)r * B_NDOWN_P;
        float q[6], kv[4];
        float s1 = 0.f, s2 = 0.f;
#pragma unroll
        for (int i = 0; i < 6; ++i) { q[i] = bf2f(d[i * 64 + lane]); s1 += q[i] * q[i]; }
#pragma unroll
        for (int i = 0; i < 4; ++i) { kv[i] = bf2f(d[384 + i * 64 + lane]); s2 += kv[i] * kv[i]; }
        float kr = bf2f(d[640 + lane]);
        const float r1 = rsqrtf(wave_sum(s1) * (1.f / 384.f) + EPS), r2 = rsqrtf(wave_sum(s2) * (1.f / 256.f) + EPS);
#pragma unroll
        for (int i = 0; i < 6; ++i) WSP(bf16, WS_DQN)[(size_t)r * B_QL + i * 64 + lane] = (bf16)f2bf(q[i] * r1 * p.in[14][i * 64 + lane]);
#pragma unroll
        for (int i = 0; i < 4; ++i) WSP(bf16, WS_DKVN)[(size_t)r * B_KVL + i * 64 + lane] = (bf16)f2bf(kv[i] * r2 * p.in[15][i * 64 + lane]);
        if (j >= NCTX) {
            const int s = j - NCTX, pos = (lane < 32) ? (s / GRIDW) : (s % GRIDW); const float o = __shfl_xor(kr, 16); const f32x2 c = cs[pos * 16 + (lane & 15)];
            kr = (lane & 16) ? (kr * c.x + o * c.y) : (kr * c.x - o * c.y);
        }
        const bf16 krb = (bf16)f2bf(kr);
#pragma unroll
        for (int h = 0; h < 8; ++h) WSP(bf16, WS_KB)[(size_t)r * 1536 + h * 192 + 128 + lane] = krb;
    }
}
__device__ __forceinline__ void phase_rope64(const P& p, int wv, int bid, int nb, bf16* buf, int ld, int nh, int hs, int off) {
    const int tid = otid(wv), lane = tid & 63, gw = bid * 8 + (tid >> 6), ngw = nb * 8;
    const f32x2* cs = WSP(const f32x2, WS_ROPE64);
    for (int r = gw; r < T; r += ngw) {
        int b, j; row_info(r, b, j); if (j < NCTX) continue;
        const int s = j - NCTX, pos = (lane < 32) ? (s / GRIDW) : (s % GRIDW); const f32x2 c = cs[pos * 16 + (lane & 15)];
        for (int h = 0; h < nh; ++h) { bf16* q = buf + (size_t)r * ld + h * hs + off + lane; const float x = bf2f(*q), o = __shfl_xor(x, 16);
            *q = (bf16)f2bf((lane & 16) ? (x * c.x + o * c.y) : (x * c.x - o * c.y)); }
    }
}

__device__ __forceinline__ void phase_sgu_simple(const P& p, int wv, int bid, int nb, unsigned char* lds_) {
    LAS unsigned char* lds = (LAS unsigned char*)lds_;
    const int tid = otid(wv), lane = tid & 63, wave = tid >> 6;
    LAS float* mean = (LAS float*)lds; LAS float* rstd = mean + 128; LAS float* vl = (LAS float*)(lds + 1024);
    const bf16* U = WSP(const bf16, WS_QKV); const bf16* V = WSP(const bf16, WS_KB); bf16* Mo = WSP(bf16, WS_VB);
    const float* Wsp = p.in[22]; const float* bsp = p.in[23];
    for (int ch = bid; ch < T / 128; ch += nb) {
        const int row0 = ch * 128;
        __syncthreads();
        for (int rr = wave; rr < 128; rr += 8) { const bf16* vr = V + (size_t)(row0 + rr) * DM; float x[16]; float s = 0.f;
#pragma unroll
            for (int i = 0; i < 16; ++i) { x[i] = bf2f(vr[i * 64 + lane]); s += x[i]; }
            const float mu = wave_sum(s) * (1.f / 1024.f); float q = 0.f;
#pragma unroll
            for (int i = 0; i < 16; ++i) { const float d = x[i] - mu; q += d * d; }
            const float var = wave_sum(q) * (1.f / 1024.f);
            if (lane == 0) { mean[rr] = mu; rstd[rr] = rsqrtf(var + EPS); } }
        for (int g = 0; g < 8; ++g) {
            __syncthreads();
            for (int i = tid; i < 128 * 128; i += 512) { const int q = i >> 7, c = i & 127, col = g * 128 + c;
                const float x = bf2f(V[(size_t)(row0 + q) * DM + col]); vl[i] = bf2f(f2bf((x - mean[q]) * rstd[q] * p.in[20][col] + p.in[21][col])); }
            __syncthreads();
            const int pp = tid >> 2, c0 = (tid & 3) * 32;
            float acc[32];
#pragma unroll
            for (int i = 0; i < 32; ++i) acc[i] = 0.f;
            const float* wrow = Wsp + ((size_t)g * 128 + pp) * 128;
            for (int q = 0; q < 128; ++q) { const float w = bf2f(f2bf(wrow[q]));
#pragma unroll
                for (int i = 0; i < 32; ++i) acc[i] += w * vl[q * 128 + c0 + i]; }
            const float bb = bsp[g * 128 + pp];
#pragma unroll
            for (int i = 0; i < 32; ++i) { const size_t o = (size_t)(row0 + pp) * DM + g * 128 + c0 + i; Mo[o] = (bf16)f2bf(bf2f(U[o]) * (acc[i] + bb)); }
        }
    }
}

__device__ __forceinline__ void phase_sgu(const P& p, int wv, int bid, int nb, unsigned char* lds_) {
    using f32x16 = __attribute__((ext_vector_type(16))) float;
    LAS unsigned char* lds = (LAS unsigned char*)lds_;
    const int tid = otid(wv), lane = tid & 63, wave = tid >> 6, r32 = lane & 31, hi = lane >> 5;
    constexpr int VT_ROW = 272, VT_BYTES = 128 * VT_ROW;
    LAS unsigned char* vT = lds; LAS unsigned char* oT = lds + 2 * VT_BYTES;
    const bf16* U = WSP(const bf16, WS_QKV); const bf16* V = WSP(const bf16, WS_KB); bf16* Mo = WSP(bf16, WS_VB);
    const bf16* Wsp = WSP(const bf16, W_SP); const float* bsp = p.in[23]; const float* lng = p.in[20]; const float* lnb = p.in[21];
    const int pb = wave & 3, cbh = wave >> 2;
    const int sq = tid >> 2, sc0 = (tid & 3) * 32;
    const int nch = T / 128, nfull = (nch / nb) * nb, ntail = (nch - nfull) * 8;
    for (int ui = bid; ui < nfull + ntail; ui += nb) {
        int ch, g0, g1; if (ui < nfull) { ch = ui; g0 = 0; g1 = 8; } else { ch = nfull + ((ui - nfull) >> 3); g0 = (ui - nfull) & 7; g1 = g0 + 1; }
        const int row0 = ch * 128;
        const bf16* vrow = V + (size_t)(row0 + sq) * DM; const bf16* urow = U + (size_t)(row0 + sq) * DM; bf16* mrow = Mo + (size_t)(row0 + sq) * DM;
        float s1 = 0.f, s2 = 0.f;
#pragma unroll
        for (int hb = 0; hb < 2; ++hb) { u32x4 w[16];
#pragma unroll
            for (int j = 0; j < 16; ++j) w[j] = *(const u32x4*)(vrow + (tid & 3) * 256 + hb * 128 + j * 8);
#pragma unroll
            for (int j = 0; j < 16; ++j) { const float x0 = bflo(w[j].x), x1 = bfhi(w[j].x), x2 = bflo(w[j].y), x3 = bfhi(w[j].y), x4 = bflo(w[j].z), x5 = bfhi(w[j].z), x6 = bflo(w[j].w), x7 = bfhi(w[j].w);
                s1 += ((x0 + x1) + (x2 + x3)) + ((x4 + x5) + (x6 + x7)); s2 += ((x0 * x0 + x1 * x1) + (x2 * x2 + x3 * x3)) + ((x4 * x4 + x5 * x5) + (x6 * x6 + x7 * x7)); } }
        s1 += __shfl_xor(s1, 1); s2 += __shfl_xor(s2, 1); s1 += __shfl_xor(s1, 2); s2 += __shfl_xor(s2, 2);
        const float mq = s1 * (1.f / 1024.f), rq = rsqrtf(fmaxf(s2 * (1.f / 1024.f) - mq * mq, 0.f) + EPS);
        u32x4 vreg[4], ureg[4];
#pragma unroll
        for (int j = 0; j < 4; ++j) { vreg[j] = *(const u32x4*)(vrow + g0 * 128 + sc0 + j * 8); ureg[j] = *(const u32x4*)(urow + g0 * 128 + sc0 + j * 8); }
#pragma unroll 1
        for (int g = g0; g < g1; ++g) {
            LAS unsigned char* buf = vT + (g & 1) * VT_BYTES;
            { const float* gg = lng + g * 128 + sc0; const float* gb = lnb + g * 128 + sc0;
#pragma unroll
              for (int j = 0; j < 4; ++j) { const u32x4 w = vreg[j]; const f32x4 ga = *(const f32x4*)(gg + j * 8), gc = *(const f32x4*)(gg + j * 8 + 4), ba = *(const f32x4*)(gb + j * 8), bc = *(const f32x4*)(gb + j * 8 + 4);
                  const float xv[8] = {bflo(w.x), bfhi(w.x), bflo(w.y), bfhi(w.y), bflo(w.z), bfhi(w.z), bflo(w.w), bfhi(w.w)}; const float gv[8] = {ga.x, ga.y, ga.z, ga.w, gc.x, gc.y, gc.z, gc.w}; const float bv[8] = {ba.x, ba.y, ba.z, ba.w, bc.x, bc.y, bc.z, bc.w};
#pragma unroll
                  for (int e = 0; e < 8; ++e) *(LAS bf16*)(buf + (sc0 + j * 8 + e) * VT_ROW + sq * 2) = (bf16)f2bf((xv[e] - mq) * rq * gv[e] + bv[e]); } }
            const u32x4 u0 = ureg[0], u1 = ureg[1], u2 = ureg[2], u3 = ureg[3];
            if (g + 1 < g1) {
#pragma unroll
                for (int j = 0; j < 4; ++j) { vreg[j] = *(const u32x4*)(vrow + (g + 1) * 128 + sc0 + j * 8); ureg[j] = *(const u32x4*)(urow + (g + 1) * 128 + sc0 + j * 8); } }
            bf16x8 af[8];
            { const bf16* wr = Wsp + ((size_t)g * 128 + pb * 32 + r32) * 128 + hi * 8;
#pragma unroll
              for (int ks = 0; ks < 8; ++ks) af[ks] = *(const bf16x8*)(wr + ks * 16); }
            float bias[16];
#pragma unroll
            for (int r = 0; r < 16; ++r) bias[r] = bsp[g * 128 + pb * 32 + (r & 3) + 8 * (r >> 2) + 4 * hi];
            __syncthreads();
#pragma unroll
            for (int t = 0; t < 2; ++t) { f32x16 acc = f32x16{}; const LAS unsigned char* br = buf + ((cbh * 2 + t) * 32 + r32) * VT_ROW + hi * 16;
#pragma unroll
                for (int ks = 0; ks < 8; ++ks) { const bf16x8 bfr = *(const LAS bf16x8*)(br + ks * 32); acc = __builtin_amdgcn_mfma_f32_32x32x16_bf16(af[ks], bfr, acc, 0, 0, 0); }
#pragma unroll
                for (int r = 0; r < 16; ++r) { const int pr = pb * 32 + (r & 3) + 8 * (r >> 2) + 4 * hi; *(LAS bf16*)(oT + pr * VT_ROW + ((cbh * 2 + t) * 32 + r32) * 2) = (bf16)f2bf(acc[r] + bias[r]); } }
            __syncthreads();
            { const u32x4 uu[4] = {u0, u1, u2, u3};
#pragma unroll
              for (int j = 0; j < 4; ++j) { const u32x4 mx = *(const LAS u32x4*)(oT + sq * VT_ROW + (sc0 + j * 8) * 2); u32x4 o;
                  o.x = pk2(bflo(uu[j].x) * bflo(mx.x), bfhi(uu[j].x) * bfhi(mx.x)); o.y = pk2(bflo(uu[j].y) * bflo(mx.y), bfhi(uu[j].y) * bfhi(mx.y));
                  o.z = pk2(bflo(uu[j].z) * bflo(mx.z), bfhi(uu[j].z) * bfhi(mx.z)); o.w = pk2(bflo(uu[j].w) * bflo(mx.w), bfhi(uu[j].w) * bfhi(mx.w));
                  *(u32x4*)(mrow + g * 128 + sc0 + j * 8) = o; } }
        }
        __syncthreads();
    }
}

namespace pg8 {
constexpr int BM = 256, BK = 64, HALF = 128, HTB = HALF * BK * 2, STAGE_BYTES = 8 * HTB, NXCD = 8, WGM = 4;
__host__ __device__ __forceinline__ int lds_byte(int r, int c) { const int st = (r >> 4) * 2 + (c >> 5), rr = r & 15, cc = c & 31, ob = rr * 64 + cc * 2; return st * 1024 + (ob ^ (((ob >> 9) & 1) << 5)); }
__host__ __device__ __forceinline__ void stage_rc(int b, int& R, int& C) { const int st = b / 1024, sb = b % 1024, swz = sb ^ (((sb >> 9) & 1) << 5); R = (st >> 1) * 16 + swz / 64; C = (st & 1) * 32 + (swz % 64) / 2; }
__host__ __device__ __forceinline__ int perm32(int rho) { const int n = rho >> 4, i = rho & 15; return 8 * (i >> 2) + 4 * n + (i & 3); }
struct Unit { int pm, pn, e, sub; };
struct Sched {
    int nM, nN, nwg, G, c; const LAS int* tl; int grouped, part, skipctx;
    __device__ __forceinline__ void init(int nM_, int nN_, int G_, int c_, const LAS int* tl_, int grouped_, int part_ = 0, int skipctx_ = 0) { nM = nM_; nN = nN_; nwg = nM * nN; G = G_; c = c_; tl = tl_; grouped = grouped_; part = part_; skipctx = skipctx_; }
    __device__ __forceinline__ bool next(int i, Unit& u) const {
        long L = (long)i * G + c; int sub = 0;
        const int full = (nwg / G) * G, R = nwg - full;
        if (part == 1 && L >= full) return false;
        if (part == 2) { if (i > 0 || R == 0) return false;
            if (4 * R <= G) { const int uu = (c >> 5) * 8 + (c & 7); if (uu >= R) return false; L = full + uu; sub = 1 + ((c >> 3) & 3); }
            else { if (c >= R) return false; L = full + c; } }
        if (L >= nwg) return false;
        int wgid = (int)L; { const int q = nwg / NXCD, r = nwg % NXCD, xcd = wgid % NXCD, off = wgid / NXCD; wgid = (xcd < r ? xcd * (q + 1) : r * (q + 1) + (xcd - r) * q) + off; }
        const int nig = WGM * nN, gid = wgid / nig, fm = gid * WGM, gsz = (nM - fm) < WGM ? (nM - fm) : WGM;
        u.pm = fm + ((wgid % nig) % gsz); u.pn = (wgid % nig) / gsz; int e = 0;
        if (grouped) {
#pragma unroll
            for (int x = 1; x < 8; ++x) e += (u.pm >= tl[x]) ? 1 : 0; }
        if (skipctx) u.pm = u.pm + (u.pm >> 5) + 1;
        u.e = e; u.sub = sub; return true;
    }
};
__device__ __forceinline__ unsigned cvt_pk_bf16(float lo, float hi) { unsigned r; asm volatile("v_cvt_pk_bf16_f32 %0, %1, %2" : "=v"(r) : "v"(lo), "v"(hi)); return r; }
__device__ __forceinline__ f32x2 gelu_pk(f32x2 v) {
    const f32x2 av = __builtin_elementwise_abs(v), d = av * 0.2316418882f + 1.0f;
    f32x2 t; t.x = __builtin_amdgcn_rcpf(d.x); t.y = __builtin_amdgcn_rcpf(d.y);
    f32x2 q = t * 0.5307027145f + (-0.7265760135f); q = q * t + 0.7107068705f; q = q * t + (-0.142248368f); q = q * t + 0.127414796f; q = q * t;
    const f32x2 s = (v * v) * (-0.72134752044f);
    f32x2 e; e.x = __builtin_amdgcn_exp2f(s.x); e.y = __builtin_amdgcn_exp2f(s.y);
    const f32x2 m = v * (q * e), r = v - m;
    f32x2 o; o.x = v.x < 0.f ? m.x : r.x; o.y = v.y < 0.f ? m.y : r.y; return o;
}
typedef f32x4 Acc[2][2][4][2];
__device__ __forceinline__ u32x4 pack8(f32x4 v0, f32x4 v1) { u32x4 w; w.x = cvt_pk_bf16(v0[0], v0[1]); w.y = cvt_pk_bf16(v0[2], v0[3]); w.z = cvt_pk_bf16(v1[0], v1[1]); w.w = cvt_pk_bf16(v1[2], v1[3]); return w; }
template <int ROPE>
struct EpiStoreT {
    static constexpr bool PERM = true;
    bf16* O; int ld; const f32x2* cs;
    __device__ __forceinline__ void operator()(const Acc& acc, const Unit& u, int wr, int wc, int fr, int fq) const {
        const int row0 = u.pm * BM + wr * 64 + fr, col0 = u.pn * BM + wc * 32 + 8 * fq;
        const int tb = (u.pm * BM) / RPB, tj = u.pm * BM - tb * RPB; const bool lat = tj >= NCTX;
#pragma unroll
        for (int ai = 0; ai < 2; ++ai)
#pragma unroll
            for (int m = 0; m < 4; ++m) { const int row = row0 + ai * HALF + m * 16; bf16* rowp = O + (size_t)row * ld + col0;
                const int spos = row - tb * RPB - NCTX;
#pragma unroll
                for (int bj = 0; bj < 2; ++bj) { if (SUB_SKIP(u, ai, bj)) continue;
                    f32x4 v0 = acc[ai][bj][m][0], v1 = acc[ai][bj][m][1];
                    if constexpr (ROPE != 0) {
                        const int slab = u.pn * 8 + bj * 4 + wc; bool rot; int axis;
                        if (ROPE == 1) { const int sm = slab % 6; rot = sm >= 4; axis = sm - 4; } else { rot = slab < 36; axis = slab & 1; }
                        if (rot && lat) {
                            const int pos = axis ? (spos & (GRIDW - 1)) : (spos / GRIDW); const f32x2* c = cs + pos * 16 + 8 * (fq & 1);
                            const f32x4 c0 = *(const f32x4*)(c), c1 = *(const f32x4*)(c + 2), c2 = *(const f32x4*)(c + 4), c3 = *(const f32x4*)(c + 6);
                            const float cc[8] = {c0.x, c0.z, c1.x, c1.z, c2.x, c2.z, c3.x, c3.z}, sn[8] = {c0.y, c0.w, c1.y, c1.w, c2.y, c2.w, c3.y, c3.w};
                            const float sg = (fq & 2) ? 1.f : -1.f;
                            float x[8] = {v0[0], v0[1], v0[2], v0[3], v1[0], v1[1], v1[2], v1[3]};
#pragma unroll
                            for (int e = 0; e < 8; ++e) { const auto rr = __builtin_amdgcn_permlane32_swap(__float_as_uint(x[e]), __float_as_uint(x[e]), false, false);
                                const float o = __uint_as_float((fq & 2) ? rr[0] : rr[1]); x[e] = x[e] * cc[e] + sg * o * sn[e]; }
                            v0 = (f32x4){x[0], x[1], x[2], x[3]}; v1 = (f32x4){x[4], x[5], x[6], x[7]};
                        }
                    }
                    *(u32x4*)(rowp + bj * HALF) = pack8(v0, v1); } }
    }
};
typedef EpiStoreT<0> EpiStore;
struct EpiKV {
    static constexpr bool PERM = true;
    bf16* Kb; bf16* Vb;
    __device__ __forceinline__ void operator()(const Acc& acc, const Unit& u, int wr, int wc, int fr, int fq) const {
        const int row0 = u.pm * BM + wr * 64 + fr, c0 = wc * 32 + 8 * fq;
#pragma unroll
        for (int ai = 0; ai < 2; ++ai)
#pragma unroll
            for (int m = 0; m < 4; ++m) { const size_t r = (size_t)(row0 + ai * HALF + m * 16);
                if (!SUB_SKIP(u, ai, 0)) *(u32x4*)(Kb + r * 1536 + u.pn * 192 + c0) = pack8(acc[ai][0][m][0], acc[ai][0][m][1]);
                if (!SUB_SKIP(u, ai, 1)) *(u32x4*)(Vb + r * DM + u.pn * 128 + c0) = pack8(acc[ai][1][m][0], acc[ai][1][m][1]); }
    }
};
struct EpiGelu {
    static constexpr bool PERM = true;
    bf16* U; bf16* V;
    __device__ __forceinline__ void operator()(const Acc& acc, const Unit& u, int wr, int wc, int fr, int fq) const {
        const int row0 = u.pm * BM + wr * 64 + fr; bf16* base = u.pn < 4 ? U : V; const int col0 = (u.pn & 3) * BM + wc * 32 + 8 * fq;
#pragma unroll
        for (int ai = 0; ai < 2; ++ai)
#pragma unroll
            for (int m = 0; m < 4; ++m) { bf16* rowp = base + (size_t)(row0 + ai * HALF + m * 16) * DM + col0;
#pragma unroll
                for (int bj = 0; bj < 2; ++bj) { if (SUB_SKIP(u, ai, bj)) continue; const f32x4 v0 = acc[ai][bj][m][0], v1 = acc[ai][bj][m][1];
                    const f32x2 a = gelu_pk((f32x2){v0[0], v0[1]}), b = gelu_pk((f32x2){v0[2], v0[3]}), c = gelu_pk((f32x2){v1[0], v1[1]}), d = gelu_pk((f32x2){v1[2], v1[3]});
                    *(u32x4*)(rowp + bj * HALF) = pack8((f32x4){a.x, a.y, b.x, b.y}, (f32x4){c.x, c.y, d.x, d.y}); } }
    }
};
struct EpiSwiglu {
    static constexpr bool PERM = true;
    bf16* O; int ld;
    __device__ __forceinline__ void operator()(const Acc& acc, const Unit& u, int wr, int wc, int fr, int fq) const {
        const int rl0 = wr * 64 + fr, nkt = ld >> 6;
        bf16* base = O + ((size_t)u.pm * nkt + (u.pn * 2 + (wc >> 1))) * (BM * BK) + (wc & 1) * 32 + 8 * fq;
#pragma unroll
        for (int ai = 0; ai < 2; ++ai)
#pragma unroll
            for (int m = 0; m < 4; ++m) { f32x4 o[2];
#pragma unroll
                for (int n = 0; n < 2; ++n) { const f32x4 a = acc[ai][0][m][n], b = acc[ai][1][m][n];
#pragma unroll
                    for (int k = 0; k < 4; ++k) o[n][k] = a[k] * __builtin_amdgcn_rcpf(1.f + __builtin_amdgcn_exp2f(-1.4426950408889634f * a[k])) * b[k]; }
                *(u32x4*)(base + (size_t)(rl0 + ai * HALF + m * 16) * BK) = pack8(o[0], o[1]); }
    }
};
struct EpiResid {
    static constexpr bool PERM = true;
    const float* x; const float* ctx; unsigned char* ws; int layer, chunk, from_in;
    __device__ __forceinline__ void operator()(const Acc& acc, const Unit& u, int wr, int wc, int fr, int fq) const {
        P p; p.in[0] = x; p.in[2] = ctx; p.ws = ws;
        const int r0 = u.pm * BM; const float* gate = mod_vec(p, layer, r0, chunk);
        const float* xin0 = in_row(p, r0); bf16* h0 = (bf16*)(ws + WS_H) + (size_t)r0 * DM;
        const int rl0 = wr * 64 + fr, col0 = u.pn * BM + wc * 32 + 8 * fq;
#pragma unroll
        for (int ai = 0; ai < 2; ++ai)
#pragma unroll
            for (int m = 0; m < 4; ++m) { const size_t off = (size_t)(rl0 + ai * HALF + m * 16) * DM + col0;
#pragma unroll
                for (int bj = 0; bj < 2; ++bj) { if (SUB_SKIP(u, ai, bj)) continue; const f32x4 g0 = *(const f32x4*)(gate + col0 + bj * HALF), g1 = *(const f32x4*)(gate + col0 + bj * HALF + 4); f32x4 s0, s1;
                    if (from_in) { s0 = *(const f32x4*)(xin0 + off + bj * HALF); s1 = *(const f32x4*)(xin0 + off + bj * HALF + 4); }
                    else { const u32x4 w = *(const u32x4*)(h0 + off + bj * HALF); s0 = (f32x4){bflo(w.x), bfhi(w.x), bflo(w.y), bfhi(w.y)}; s1 = (f32x4){bflo(w.z), bfhi(w.z), bflo(w.w), bfhi(w.w)}; }
                    *(u32x4*)(h0 + off + bj * HALF) = pack8(s0 + g0 * acc[ai][bj][m][0], s1 + g1 * acc[ai][bj][m][1]); }
                asm volatile("" ::: "memory"); }
    }
};

template <class Epi, bool GATHER, int K, bool SUB = false, bool ATILE = false, bool BTILE = false>
__device__ __forceinline__ void gemm_phase(int wv, LAS unsigned char* lds, const bf16* A, const bf16* Bt, size_t bstride, const Sched& S, const Epi& E, const LAS unsigned short* gtab) {
    const int tid = otid(wv), wid = __builtin_amdgcn_readfirstlane(tid >> 6), lane = tid & 63, wr = wid >> 2, wc = wid & 3, fr = lane & 15, fq = lane >> 4;
    constexpr int nt = K / BK;
    unsigned voffA[2], voffB[2]; int RA[2], CA[2];
#pragma unroll
    for (int i = 0; i < 2; ++i) { int R, C; stage_rc(tid * 16 + i * 8192, R, C); const int Rb = Epi::PERM ? ((R & ~31) + perm32(R & 31)) : R;
        RA[i] = R; CA[i] = C; voffA[i] = (unsigned)(R * (ATILE ? BK : K) + C) * 2u; voffB[i] = (unsigned)(Rb * (BTILE ? BK : K) + C) * 2u; }
    constexpr size_t kstepA = ATILE ? (size_t)BM * BK * 2 : (size_t)(BK * 2), hstepA = ATILE ? (size_t)HALF * BK * 2 : (size_t)HALF * K * 2, tstepA = (size_t)BM * K * 2;
    constexpr size_t kstepB = BTILE ? (size_t)BM * BK * 2 : (size_t)(BK * 2), hstepB = BTILE ? (size_t)HALF * BK * 2 : (size_t)HALF * K * 2, tstepB = (size_t)BM * K * 2;
    const unsigned ldsw = (unsigned)wid * 1024u;
    const int aoff = lds_byte(wr * 64 + fr, fq * 8), boff = lds_byte(wc * 32 + fr, fq * 8);
    const char* Ab = (const char*)A;
    unsigned cg[2][2], ng[2][2];
#define PG8_SA(b, h) (((b) * 2 + (h)) * HTB)
#define PG8_SB(b, h) ((4 + (b) * 2 + (h)) * HTB)
#define PG8_GLDS(gp, bufoff, i) __builtin_amdgcn_global_load_lds((const unsigned*)(gp), (LAS unsigned*)(lds + (bufoff) + ldsw + (i) * 8192), 16, 0, 0)
#define PG8_STAGE_B(bufoff, gbase) do { _Pragma("unroll") for (int _i = 0; _i < 2; ++_i) PG8_GLDS((const char*)(gbase) + voffB[_i], bufoff, _i); } while (0)
#define PG8_STAGE_A(bufoff, nxtsel, h, kt) do { \
        if constexpr (GATHER) { const char* _b = Ab + (size_t)(kt) * kstepA; _Pragma("unroll") for (int _i = 0; _i < 2; ++_i) { const unsigned _o = (nxtsel) ? ng[h][_i] : cg[h][_i]; PG8_GLDS(_b + _o, bufoff, _i); } } \
        else { const char* _b = ((nxtsel) ? nA : cA) + (size_t)(h) * hstepA + (size_t)(kt) * kstepA; _Pragma("unroll") for (int _i = 0; _i < 2; ++_i) PG8_GLDS(_b + voffA[_i], bufoff, _i); } } while (0)
#define PG8_LDA(dst, b, h) do { _Pragma("unroll") for (int m = 0; m < 4; ++m) _Pragma("unroll") for (int k = 0; k < 2; ++k) dst[m][k] = *(const LAS bf16x8*)(lds + PG8_SA(b, h) + aoff + m * 2048 + k * 1024); } while (0)
#define PG8_LDB(dst, b, h) do { _Pragma("unroll") for (int n = 0; n < 2; ++n) _Pragma("unroll") for (int k = 0; k < 2; ++k) dst[n][k] = *(const LAS bf16x8*)(lds + PG8_SB(b, h) + boff + n * 2048 + k * 1024); } while (0)
#define PG8_MMA(ai, bj, At, Bt_) do { if constexpr (SUB) { if (csub != 0 && csub != 1 + (ai) * 2 + (bj)) break; } __builtin_amdgcn_s_setprio(1); _Pragma("unroll") for (int m = 0; m < 4; ++m) _Pragma("unroll") for (int n = 0; n < 2; ++n) _Pragma("unroll") for (int k = 0; k < 2; ++k) \
        acc[ai][bj][m][n] = __builtin_amdgcn_mfma_f32_16x16x32_bf16(Bt_[n][k], At[m][k], acc[ai][bj][m][n], 0, 0, 0); __builtin_amdgcn_s_setprio(0); } while (0)
#define PG8_WAIT_V(n) asm volatile("s_waitcnt vmcnt(" #n ")" ::: "memory")
#define PG8_WAIT_L(n) asm volatile("s_waitcnt lgkmcnt(" #n ")" ::: "memory")
#define PG8_BAR __builtin_amdgcn_s_barrier()
#define PG8_SCHED __builtin_amdgcn_sched_barrier(0)
#define PG8_GOFF(dst, ui_) do { _Pragma("unroll") for (int _h = 0; _h < 2; ++_h) _Pragma("unroll") for (int _i = 0; _i < 2; ++_i) \
        dst[_h][_i] = ((unsigned)gtab[(ui_) * 256 + _h * HALF + RA[_i]] * (unsigned)K + (unsigned)CA[_i]) * 2u; } while (0)
    Unit cur, nxt; int ui = 0;
    if (!S.next(0, cur)) return;
    f32x4 acc[2][2][4][2];
#pragma unroll
    for (int a = 0; a < 2; ++a)
#pragma unroll
        for (int b = 0; b < 2; ++b)
#pragma unroll
            for (int m = 0; m < 4; ++m)
#pragma unroll
                for (int n = 0; n < 2; ++n) acc[a][b][m][n] = (f32x4){0.f, 0.f, 0.f, 0.f};
    bf16x8 At[4][2], B0[2][2], B1[2][2];
    const char* cA = Ab + (size_t)cur.pm * tstepA; const char* cB = (const char*)(Bt + (size_t)cur.e * bstride) + (size_t)cur.pn * tstepB;
    const char* nA = cA; int csub = cur.sub;
    if constexpr (GATHER) { PG8_GOFF(cg, 0); PG8_GOFF(ng, 0); }
    PG8_STAGE_B(PG8_SB(0, 0), cB); PG8_STAGE_B(PG8_SB(0, 1), cB + hstepB); PG8_STAGE_A(PG8_SA(0, 0), false, 0, 0); PG8_STAGE_A(PG8_SA(0, 1), false, 1, 0);
    if (wr == 1) PG8_BAR;
    PG8_WAIT_V(2); PG8_BAR;
    PG8_STAGE_B(PG8_SB(1, 0), cB + kstepB); PG8_STAGE_A(PG8_SA(1, 0), false, 0, 1); PG8_STAGE_B(PG8_SB(1, 1), cB + hstepB + kstepB);
    PG8_WAIT_V(6); PG8_BAR;
    for (;;) {
        const bool has_next = S.next(ui + 1, nxt);
        nA = has_next ? Ab + (size_t)nxt.pm * tstepA : cA; const char* nB = has_next ? (const char*)(Bt + (size_t)nxt.e * bstride) + (size_t)nxt.pn * tstepB : cB;
        if constexpr (GATHER) { if (has_next) PG8_GOFF(ng, ui + 1); else { _Pragma("unroll") for (int _h = 0; _h < 2; ++_h) _Pragma("unroll") for (int _i = 0; _i < 2; ++_i) ng[_h][_i] = cg[_h][_i]; } }
#pragma nounroll
        for (int t = 0; t < nt; t += 2) {
            const bool last = (t == nt - 2);
            const int t1 = t + 1, t2 = last ? 0 : t + 2, t3 = t2 + 1;
            const char* b2 = (last ? nB : cB) + (size_t)t2 * kstepB; const char* b3 = b2 + kstepB;
            PG8_LDB(B0, 0, 0); PG8_LDB(B1, 0, 1); PG8_SCHED; PG8_LDA(At, 0, 0); PG8_STAGE_A(PG8_SA(1, 1), false, 1, t1);
            PG8_WAIT_V(8); PG8_WAIT_L(0); PG8_BAR; PG8_MMA(0, 0, At, B0); PG8_MMA(0, 1, At, B1); PG8_BAR; PG8_SCHED;
            PG8_LDA(At, 0, 1); PG8_STAGE_B(PG8_SB(0, 0), b2); PG8_STAGE_B(PG8_SB(0, 1), b2 + hstepB); PG8_STAGE_A(PG8_SA(0, 0), last, 0, t2);
            PG8_WAIT_V(8); PG8_WAIT_L(0); PG8_BAR; PG8_MMA(1, 0, At, B0); PG8_MMA(1, 1, At, B1); PG8_BAR; PG8_SCHED;
            PG8_LDB(B0, 1, 0); PG8_LDB(B1, 1, 1); PG8_SCHED; PG8_LDA(At, 1, 0); PG8_STAGE_A(PG8_SA(0, 1), last, 1, t2);
            PG8_WAIT_V(8); PG8_WAIT_L(0); PG8_BAR; PG8_MMA(0, 0, At, B0); PG8_MMA(0, 1, At, B1); PG8_BAR; PG8_SCHED;
            PG8_LDA(At, 1, 1); PG8_STAGE_B(PG8_SB(1, 0), b3); PG8_STAGE_B(PG8_SB(1, 1), b3 + hstepB); PG8_STAGE_A(PG8_SA(1, 0), last, 0, t3);
            PG8_WAIT_V(8); PG8_WAIT_L(0); PG8_BAR; PG8_MMA(1, 0, At, B0); PG8_MMA(1, 1, At, B1); PG8_BAR; PG8_SCHED;
        }
        if (wr == 0) PG8_BAR;
        E(acc, cur, wr, wc, fr, fq);
        if (!has_next) break;
#pragma unroll
        for (int a = 0; a < 2; ++a)
#pragma unroll
            for (int b = 0; b < 2; ++b)
#pragma unroll
                for (int m = 0; m < 4; ++m)
#pragma unroll
                    for (int n = 0; n < 2; ++n) acc[a][b][m][n] = (f32x4){0.f, 0.f, 0.f, 0.f};
        cur = nxt; cA = nA; cB = nB; ++ui; csub = cur.sub;
        if constexpr (GATHER) { _Pragma("unroll") for (int _h = 0; _h < 2; ++_h) _Pragma("unroll") for (int _i = 0; _i < 2; ++_i) cg[_h][_i] = ng[_h][_i]; }
        if (wr == 1) PG8_BAR;
    }
    PG8_WAIT_V(0);
    PG8_BAR;
#undef PG8_SA
#undef PG8_SB
#undef PG8_GLDS
#undef PG8_STAGE_A
#undef PG8_STAGE_B
#undef PG8_LDA
#undef PG8_LDB
#undef PG8_MMA
#undef PG8_WAIT_V
#undef PG8_WAIT_L
#undef PG8_BAR
#undef PG8_SCHED
#undef PG8_GOFF
}

template <class Epi, int K, bool ATILE, bool BTILE>
__device__ __forceinline__ void gemm_sub_unit(int wv, LAS unsigned char* lds, const bf16* A, const bf16* Bt, size_t bstride, const Sched& S, const Epi& E) {
    Unit u; if (!S.next(0, u)) return;
    const int tid = otid(wv), wid = __builtin_amdgcn_readfirstlane(tid >> 6), lane = tid & 63, wr = wid >> 2, wc = wid & 3, fr = lane & 15, fq = lane >> 4;
    constexpr int nt = K / BK;
    unsigned voffA[2], voffB[2];
#pragma unroll
    for (int i = 0; i < 2; ++i) { int R, C; stage_rc(tid * 16 + i * 8192, R, C); const int Rb = Epi::PERM ? ((R & ~31) + perm32(R & 31)) : R;
        voffA[i] = (unsigned)(R * (ATILE ? BK : K) + C) * 2u; voffB[i] = (unsigned)(Rb * (BTILE ? BK : K) + C) * 2u; }
    constexpr size_t kstepA = ATILE ? (size_t)BM * BK * 2 : (size_t)(BK * 2), hstepA = ATILE ? (size_t)HALF * BK * 2 : (size_t)HALF * K * 2, tstepA = (size_t)BM * K * 2;
    constexpr size_t kstepB = BTILE ? (size_t)BM * BK * 2 : (size_t)(BK * 2), hstepB = BTILE ? (size_t)HALF * BK * 2 : (size_t)HALF * K * 2, tstepB = (size_t)BM * K * 2;
    const unsigned ldsw = (unsigned)wid * 1024u;
    const int aoff = lds_byte(wr * 64 + fr, fq * 8), boff = lds_byte(wc * 32 + fr, fq * 8);
#pragma nounroll
    for (int sq = (u.sub ? u.sub - 1 : 0); sq < (u.sub ? u.sub : 4); ++sq) {
    const int ai = sq >> 1, bj = sq & 1; Unit uq = u; uq.sub = sq + 1;
    const char* cA = (const char*)A + (size_t)u.pm * tstepA + (size_t)ai * hstepA;
    const char* cB = (const char*)(Bt + (size_t)u.e * bstride) + (size_t)u.pn * tstepB + (size_t)bj * hstepB;
#define SU_SA(b) ((b) * 2 * HTB)
#define SU_SB(b) ((4 + (b) * 2) * HTB)
#define SU_STAGE(b, kt) do { _Pragma("unroll") for (int _i = 0; _i < 2; ++_i) { \
        __builtin_amdgcn_global_load_lds((const unsigned*)(cA + (size_t)(kt) * kstepA + voffA[_i]), (LAS unsigned*)(lds + SU_SA(b) + ldsw + _i * 8192), 16, 0, 0); \
        __builtin_amdgcn_global_load_lds((const unsigned*)(cB + (size_t)(kt) * kstepB + voffB[_i]), (LAS unsigned*)(lds + SU_SB(b) + ldsw + _i * 8192), 16, 0, 0); } } while (0)
    f32x4 a1[4][2];
#pragma unroll
    for (int m = 0; m < 4; ++m)
#pragma unroll
        for (int n = 0; n < 2; ++n) a1[m][n] = (f32x4){0.f, 0.f, 0.f, 0.f};
#define SU_READ(At, Bf, b) do { _Pragma("unroll") for (int _m = 0; _m < 4; ++_m) { _Pragma("unroll") for (int _k = 0; _k < 2; ++_k) At[_m][_k] = *(const LAS bf16x8*)(lds + SU_SA(b) + aoff + _m * 2048 + _k * 1024); } \
        _Pragma("unroll") for (int _n = 0; _n < 2; ++_n) { _Pragma("unroll") for (int _k = 0; _k < 2; ++_k) Bf[_n][_k] = *(const LAS bf16x8*)(lds + SU_SB(b) + boff + _n * 2048 + _k * 1024); } } while (0)
#define SU_MMA(At, Bf) do { __builtin_amdgcn_s_setprio(1); _Pragma("unroll") for (int _m = 0; _m < 4; ++_m) { _Pragma("unroll") for (int _n = 0; _n < 2; ++_n) { _Pragma("unroll") for (int _k = 0; _k < 2; ++_k) \
        a1[_m][_n] = __builtin_amdgcn_mfma_f32_16x16x32_bf16(Bf[_n][_k], At[_m][_k], a1[_m][_n], 0, 0, 0); } } __builtin_amdgcn_s_setprio(0); } while (0)
#define SU_HALF(Fa, Fb, Ga, Gb, b, t2) do { \
        asm volatile("s_waitcnt lgkmcnt(0)" ::: "memory"); __builtin_amdgcn_s_barrier();        \
        SU_STAGE(b, t2); \
        asm volatile("s_waitcnt vmcnt(4)" ::: "memory"); __builtin_amdgcn_s_barrier();           \
        __builtin_amdgcn_sched_barrier(0); \
        SU_READ(Ga, Gb, (b) ^ 1); \
        __builtin_amdgcn_sched_barrier(0); \
        SU_MMA(Fa, Fb); \
        __builtin_amdgcn_sched_barrier(0); } while (0)
    bf16x8 A0[4][2], B0[2][2], A1[4][2], B1[2][2];
    SU_STAGE(0, 0); SU_STAGE(1, 1);
    asm volatile("s_waitcnt vmcnt(4)" ::: "memory"); __builtin_amdgcn_s_barrier();
    SU_READ(A0, B0, 0);
    static_assert(nt % 2 == 0, "K tiles come in pairs");
#pragma nounroll
    for (int t = 0; t < nt; t += 2) {
        { const int t2 = (t + 2 < nt) ? t + 2 : 0; SU_HALF(A0, B0, A1, B1, 0, t2); }
        { const int t3 = (t + 3 < nt) ? t + 3 : 1; SU_HALF(A1, B1, A0, B0, 1, t3); }
    }
    asm volatile("s_waitcnt vmcnt(0) lgkmcnt(0)" ::: "memory");
    __builtin_amdgcn_s_barrier();
#undef SU_READ
#undef SU_MMA
#undef SU_HALF
    f32x4 acc[2][2][4][2];
#pragma unroll
    for (int a = 0; a < 2; ++a)
#pragma unroll
        for (int bb = 0; bb < 2; ++bb)
#pragma unroll
            for (int m = 0; m < 4; ++m)
#pragma unroll
                for (int n = 0; n < 2; ++n) acc[a][bb][m][n] = a1[m][n];
    E(acc, uq, wr, wc, fr, fq);
    }
#undef SU_SA
#undef SU_SB
#undef SU_STAGE
}
}

namespace att {
using f32x16 = __attribute__((ext_vector_type(16))) float;
using s16x4 = __attribute__((ext_vector_type(4))) short;
constexpr int NW = 8, QBLK = 32, KVBLK = 64;
#define ATT_SBAR() __builtin_amdgcn_sched_barrier(0)
__device__ __forceinline__ int crow(int r, int hi) { return (r & 3) + 8 * (r >> 2) + 4 * hi; }
__device__ __forceinline__ unsigned cvtpk(float lo, float hi) { unsigned r; asm volatile("v_cvt_pk_bf16_f32 %0, %1, %2" : "=v"(r) : "v"(lo), "v"(hi)); return r; }
template <int DQK> struct Cst { static constexpr float scale() { return DQK == 128 ? 0.088388347648318440f : (DQK == 192 ? 0.072168783648703220f : 0.125f); } };
template <int DQK> __device__ __forceinline__ int kswz(int row, int colB) { constexpr int RS = DQK * 2; return row * RS + (colB ^ ((RS == 256 ? (row & 15) : ((row >> 1) & 7)) << 4)); }
template <int DV> __device__ __forceinline__ int v_st(int k, int c) { const int kk = (k & ~0xC) | ((k & 4) << 1) | ((k & 8) >> 1); return ((kk >> 3) * (DV / 32) + (c >> 5)) * 512 + ((kk & 7) * 32 + (c & 31)) * 2; }
__device__ __forceinline__ int v_rd_base(int lane) { return ((lane & 3) << 3) | (((lane >> 2) & 3) << 6) | (((lane >> 4) & 1) << 5) | (((lane >> 5) & 1) << 8); }
typedef short v4i16_t __attribute__((ext_vector_type(4)));
typedef __attribute__((address_space(3))) v4i16_t lds_v4i16_t;
template <int OFF> __device__ __forceinline__ s16x4 tr_read(int vb) { return __builtin_bit_cast(s16x4, __builtin_amdgcn_ds_read_tr16_b64_v4i16((lds_v4i16_t*)(unsigned)(vb + OFF))); }

template <int DQK, int THRI> __device__ __forceinline__ void partialSM(f32x16& p0, f32x16& p1, float& m_reg, float& mn, float& alpha) {
    constexpr float SC = Cst<DQK>::scale(), C = SC * 1.4426950408889634f, THR = (float)THRI;
    float pmax = p0[0];
#pragma unroll
    for (int r = 1; r < 16; ++r) pmax = fmaxf(pmax, p0[r]);
#pragma unroll
    for (int r = 0; r < 16; ++r) pmax = fmaxf(pmax, p1[r]);
    { auto rr = __builtin_amdgcn_permlane32_swap(__float_as_uint(pmax), __float_as_uint(pmax), false, false); pmax = fmaxf(__uint_as_float(rr[0]), __uint_as_float(rr[1])); }
    if (__builtin_expect(__all(pmax - m_reg <= THR / SC), 1)) { mn = m_reg; alpha = 1.f; }
    else { mn = fmaxf(m_reg, pmax); alpha = __builtin_amdgcn_exp2f((m_reg - mn) * C); m_reg = mn; }
    const float mnC = -mn * C;
#pragma unroll
    for (int r = 0; r < 16; ++r) p0[r] = fmaf(p0[r], C, mnC);
#pragma unroll
    for (int r = 0; r < 16; ++r) p1[r] = fmaf(p1[r], C, mnC);
#pragma unroll
    for (int r = 0; r < 16; ++r) p0[r] = __builtin_amdgcn_exp2f(p0[r]);
}
__device__ __forceinline__ void finishSM(f32x16& p0, f32x16& p1, float alpha, float& l_reg, bf16x8& pa0, bf16x8& pa1, bf16x8& pa2, bf16x8& pa3) {
#pragma unroll
    for (int r = 0; r < 16; ++r) p1[r] = __builtin_amdgcn_exp2f(p1[r]);
    float ps = 0;
#pragma unroll
    for (int r = 0; r < 16; ++r) ps += p0[r];
#pragma unroll
    for (int r = 0; r < 16; ++r) ps += p1[r];
    { auto rr = __builtin_amdgcn_permlane32_swap(__float_as_uint(ps), __float_as_uint(ps), false, false); ps = __uint_as_float(rr[0]) + __uint_as_float(rr[1]); }
    l_reg = l_reg * alpha + ps;
#define ATT_PK4(Pv, BASE, OUT) do { unsigned a0 = cvtpk(Pv[BASE + 0], Pv[BASE + 1]), a1 = cvtpk(Pv[BASE + 2], Pv[BASE + 3]); \
    unsigned b0 = cvtpk(Pv[BASE + 4], Pv[BASE + 5]), b1 = cvtpk(Pv[BASE + 6], Pv[BASE + 7]); \
    auto r0 = __builtin_amdgcn_permlane32_swap(a0, b0, false, false); auto r1 = __builtin_amdgcn_permlane32_swap(a1, b1, false, false); \
    u32x4 w = {r0[0], r1[0], r0[1], r1[1]}; OUT = *reinterpret_cast<bf16x8*>(&w); } while (0)
    ATT_PK4(p0, 0, pa0); ATT_PK4(p0, 8, pa1); ATT_PK4(p1, 0, pa2); ATT_PK4(p1, 8, pa3);
#undef ATT_PK4
}
template <int DQK, int QL> __device__ __forceinline__ void qkt(f32x16& p0, f32x16& p1, const char* Ks, const bf16x8* qr, const char* ql, const int* kb, int r32, int hi) {
    p0 = f32x16{}; p1 = f32x16{};
#pragma unroll
    for (int d0 = 0; d0 < DQK / 16; ++d0) {
        bf16x8 b0, b1;
        if constexpr (DQK == 192) { b0 = *reinterpret_cast<const bf16x8*>(Ks + kb[d0 & 3] + 128 * (d0 >> 2)); b1 = *reinterpret_cast<const bf16x8*>(Ks + kb[d0 & 3] + 128 * (d0 >> 2) + 32 * DQK * 2); }
        else { const int cb = (d0 * 16 + hi * 8) * 2; b0 = *reinterpret_cast<const bf16x8*>(Ks + kswz<DQK>(r32, cb)); b1 = *reinterpret_cast<const bf16x8*>(Ks + kswz<DQK>(32 + r32, cb)); }
        bf16x8 q; if constexpr (QL > 0) { if (d0 >= DQK / 16 - QL) q = *reinterpret_cast<const bf16x8*>(ql + (d0 - (DQK / 16 - QL)) * 1024); else q = qr[d0]; } else q = qr[d0];
        p0 = __builtin_amdgcn_mfma_f32_32x32x16_bf16(b0, q, p0, 0, 0, 0);
        p1 = __builtin_amdgcn_mfma_f32_32x32x16_bf16(b1, q, p1, 0, 0, 0); }
}
template <int DV, int D0> __device__ __forceinline__ void pv_one(f32x16& od, int vb, bf16x8 pa0, bf16x8 pa1, bf16x8 pa2, bf16x8 pa3) {
    constexpr int KS = (DV / 32) * 1024, HF = (DV / 32) * 512;
    const s16x4 l0 = tr_read<D0 * 512 + 0 * KS>(vb), h0 = tr_read<D0 * 512 + 0 * KS + HF>(vb), l1 = tr_read<D0 * 512 + 1 * KS>(vb), h1 = tr_read<D0 * 512 + 1 * KS + HF>(vb);
    const s16x4 l2 = tr_read<D0 * 512 + 2 * KS>(vb), h2 = tr_read<D0 * 512 + 2 * KS + HF>(vb), l3 = tr_read<D0 * 512 + 3 * KS>(vb), h3 = tr_read<D0 * 512 + 3 * KS + HF>(vb);
#define ATT_PK(L, H) (bf16x8){L[0], L[1], L[2], L[3], H[0], H[1], H[2], H[3]}
    od = __builtin_amdgcn_mfma_f32_32x32x16_bf16(pa0, ATT_PK(l0, h0), od, 0, 0, 0);
    od = __builtin_amdgcn_mfma_f32_32x32x16_bf16(pa1, ATT_PK(l1, h1), od, 0, 0, 0);
    od = __builtin_amdgcn_mfma_f32_32x32x16_bf16(pa2, ATT_PK(l2, h2), od, 0, 0, 0);
    od = __builtin_amdgcn_mfma_f32_32x32x16_bf16(pa3, ATT_PK(l3, h3), od, 0, 0, 0);
#undef ATT_PK
}
template <int DV> __device__ __forceinline__ void pv_all(f32x16* o, int vb, bf16x8 pa0, bf16x8 pa1, bf16x8 pa2, bf16x8 pa3) {
    pv_one<DV, 0>(o[0], vb, pa0, pa1, pa2, pa3); pv_one<DV, 1>(o[1], vb, pa0, pa1, pa2, pa3);
    if constexpr (DV == 128) { pv_one<DV, 2>(o[2], vb, pa0, pa1, pa2, pa3); pv_one<DV, 3>(o[3], vb, pa0, pa1, pa2, pa3); }
}
template <int DQK, int DV> struct Shm { static constexpr int V = KVBLK * DV * 2, K = KVBLK * DQK * 2, WSO = 2 * V + 2 * K, QLO = WSO + NW * 64 * 4; };

template <int DQK, int DV, int SD, bool WINDOW, int THRI, int QL, bool DMA = false>
__device__ __forceinline__ void attn_unit(const bf16* __restrict__ Qb, int ldq, const bf16* __restrict__ Kh, int ldk, const bf16* __restrict__ Vh, int ldv, bf16* __restrict__ Ob, int ldo,
                                          int NT, int segB, int qlat0, int klat0, float m_init, float l_init, char* lds, int wv) {
    constexpr int SHM_V = Shm<DQK, DV>::V, SHM_K = Shm<DQK, DV>::K, NKP = DQK / 64, NVP = DV / 64, ND0 = DV / 32;
    int tid_ = otid(wv);
    const int tid = tid_, wid = tid >> 6, lane = tid & 63, r32 = lane & 31, hi = lane >> 5;
    char* V_lds = lds; char* K_lds = lds + 2 * SHM_V;
    float* wsf = (float*)(lds + Shm<DQK, DV>::WSO) + wid * 64; float* li_l = wsf; float* al_l = wsf + 32;
    float m_reg = m_init, l_reg = l_init; f32x16 o[ND0]; bf16x8 qr[DQK / 16 - QL > 0 ? DQK / 16 - QL : 1];
    char* ql = lds + Shm<DQK, DV>::QLO + wid * (QL > 0 ? QL : 1) * 1024 + lane * 16;
#pragma unroll
    for (int d = 0; d < ND0; ++d) o[d] = f32x16{};
    const bf16* Qw = Qb + (long)(wid * QBLK + r32) * ldq + hi * 8;
#pragma unroll
    for (int d0 = 0; d0 < DQK / 16; ++d0) { const bf16x8 q = *reinterpret_cast<const bf16x8*>(Qw + d0 * 16); if (d0 < DQK / 16 - QL) qr[d0 < DQK / 16 - QL ? d0 : 0] = q; else *reinterpret_cast<bf16x8*>(ql + (d0 - (DQK / 16 - QL)) * 1024) = q; }
    const int srow = tid >> 3, sch = tid & 7;
    const int kflip = (DQK == 128) ? ((srow >> 3) & 1) * 128 : 0;
    const int kgo = srow * ldk + sch * 8, klo = kswz<DQK>(srow, sch * 16) & ~kflip, vgo = srow * ldv + sch * 8, vlo = v_st<DV>(srow, sch * 8);
    const int vb0 = (int)(uintptr_t)V_lds + v_rd_base(lane);
    int kb[4];
#pragma unroll
    for (int j = 0; j < 4; ++j) kb[j] = kswz<DQK>(r32, 32 * j + 16 * hi);
    bf16x8 ks[SD][NKP], vs[SD][NVP];
#define ATT_BAR() asm volatile("s_waitcnt lgkmcnt(0)\n\ts_barrier" ::: "memory")
#define ATT_KROW(t) ((t) < 4 ? 64 * (t) : segB + 64 * ((t) - 4))
#define ATT_SLOAD(i, t) do { const long _kr = ATT_KROW(t); _Pragma("unroll") for (int _x = 0; _x < NVP; ++_x) vs[i][_x] = *reinterpret_cast<const bf16x8*>(Vh + _kr * ldv + vgo + 64 * _x); \
        _Pragma("unroll") for (int _x = 0; _x < NKP; ++_x) ks[i][_x] = *reinterpret_cast<const bf16x8*>(Kh + _kr * ldk + kgo + 64 * _x); } while (0)
#define ATT_SWRITE(b, i) do { _Pragma("unroll") for (int _x = 0; _x < NVP; ++_x) *(bf16x8*)(V_lds + (b) * SHM_V + vlo + 1024 * _x) = vs[i][_x]; \
        _Pragma("unroll") for (int _x = 0; _x < NKP; ++_x) *(bf16x8*)(K_lds + (b) * SHM_K + klo + ((128 * _x) ^ kflip)) = ks[i][_x]; } while (0)
#define ATT_SWAIT() do { if constexpr (SD == 2) { if constexpr (NKP + NVP == 4) asm volatile("s_waitcnt vmcnt(4)" ::: "memory"); else if constexpr (NKP + NVP == 2) asm volatile("s_waitcnt vmcnt(2)" ::: "memory"); else asm volatile("s_waitcnt vmcnt(5)" ::: "memory"); } \
        else asm volatile("s_waitcnt vmcnt(0)" ::: "memory"); } while (0)
#define ATT_RESC(a) do { if (__any((a) < 1.f)) { if (hi == 0) al_l[r32] = (a); asm volatile("s_waitcnt lgkmcnt(0)" ::: "memory"); \
        _Pragma("unroll") for (int d = 0; d < ND0; ++d) _Pragma("unroll") for (int r = 0; r < 16; ++r) o[d][r] *= al_l[crow(r, hi)]; } } while (0)
#define ATT_MASK(P0, P1, t) do { if constexpr (WINDOW) { if ((t) >= 4) { const int _d0 = klat0 + 64 * ((t) - 4) - (qlat0 + wid * QBLK + r32); \
        _Pragma("unroll") for (int r = 0; r < 16; ++r) { const int _d = _d0 + crow(r, hi); P0[r] = (_d > 128 || _d < -128) ? -1e30f : P0[r]; P1[r] = (_d + 32 > 128 || _d + 32 < -128) ? -1e30f : P1[r]; } } } } while (0)
    f32x16 pA0, pA1, pB0, pB1; float mnA, mnB, alA, alB; bf16x8 pa0, pa1, pa2, pa3;
    constexpr int SE = 0, SO = SD - 1;
    if (wv >= 4) __builtin_amdgcn_s_setprio(1);
    if constexpr (!DMA) {
    ATT_SLOAD(SE, 0); asm volatile("s_waitcnt vmcnt(0)" ::: "memory"); ATT_SWRITE(0, SE); ATT_BAR();
    qkt<DQK, QL>(pA0, pA1, K_lds, qr, ql, kb, r32, hi); partialSM<DQK, THRI>(pA0, pA1, m_reg, mnA, alA);
    ATT_SLOAD(SO, 1); if constexpr (SD == 2) { if (2 < NT) ATT_SLOAD(SE, 2); }
    ATT_SWAIT(); ATT_SWRITE(1, SO); ATT_BAR();
    for (int j = 1; j + 1 < NT; j += 2) {
        ATT_SBAR(); qkt<DQK, QL>(pB0, pB1, K_lds + SHM_K, qr, ql, kb, r32, hi); ATT_MASK(pB0, pB1, j);
        finishSM(pA0, pA1, alA, l_reg, pa0, pa1, pa2, pa3); ATT_SBAR();
        ATT_SLOAD(SO, j + SD); ATT_SBAR();
        pv_all<DV>(o, vb0, pa0, pa1, pa2, pa3); partialSM<DQK, THRI>(pB0, pB1, m_reg, mnB, alB);
        ATT_BAR(); ATT_SWAIT(); ATT_SWRITE(0, SE);
        ATT_RESC(alB); ATT_BAR();
        ATT_SBAR(); qkt<DQK, QL>(pA0, pA1, K_lds, qr, ql, kb, r32, hi); ATT_MASK(pA0, pA1, j + 1);
        finishSM(pB0, pB1, alB, l_reg, pa0, pa1, pa2, pa3); ATT_SBAR();
        if (SD == 1 || j + 3 < NT) ATT_SLOAD(SE, j + 1 + SD); ATT_SBAR();
        pv_all<DV>(o, vb0 + SHM_V, pa0, pa1, pa2, pa3); partialSM<DQK, THRI>(pA0, pA1, m_reg, mnA, alA);
        ATT_BAR(); ATT_SWAIT(); ATT_SWRITE(1, SO);
        ATT_RESC(alA); ATT_BAR();
    }
    ATT_SBAR(); qkt<DQK, QL>(pB0, pB1, K_lds + SHM_K, qr, ql, kb, r32, hi); ATT_MASK(pB0, pB1, NT - 1);
    finishSM(pA0, pA1, alA, l_reg, pa0, pa1, pa2, pa3); ATT_SBAR();
    pv_all<DV>(o, vb0, pa0, pa1, pa2, pa3); partialSM<DQK, THRI>(pB0, pB1, m_reg, mnB, alB);
    ATT_BAR(); ATT_RESC(alB);
    finishSM(pB0, pB1, alB, l_reg, pa0, pa1, pa2, pa3); ATT_SBAR();
    pv_all<DV>(o, vb0 + SHM_V, pa0, pa1, pa2, pa3);
    } else {
        static_assert(!DMA || (DQK == 128 && DV == 128 && !WINDOW), "DMA staging: D = 128 dense only");
        LAS char* ldsL = (LAS char*)lds;
        const int krow = 4 * wid + ((lane >> 4) & 3);
        const int kgo_d = krow * ldk + (((lane & 15) ^ (krow & 15)) << 3);
        const int vsub = 2 * wid + (lane >> 5), w32 = lane & 31, vkk = ((vsub >> 2) << 3) | (w32 >> 2), vk = (vkk & ~0xC) | ((vkk & 4) << 1) | ((vkk & 8) >> 1);
        const int vgo_d = vk * ldv + (vsub & 3) * 32 + (w32 & 3) * 8;
#define ATT_DMA_K(b, t) do { const bf16* _g = Kh + (long)ATT_KROW(t) * ldk + kgo_d; \
        __builtin_amdgcn_global_load_lds((const unsigned*)_g, (LAS unsigned*)(ldsL + 2 * SHM_V + (b) * SHM_K + wv * 1024), 16, 0, 0); \
        __builtin_amdgcn_global_load_lds((const unsigned*)(_g + 32 * ldk), (LAS unsigned*)(ldsL + 2 * SHM_V + (b) * SHM_K + wv * 1024 + 8192), 16, 0, 0); } while (0)
#define ATT_DMA_V(b, t) do { const bf16* _g = Vh + (long)ATT_KROW(t) * ldv + vgo_d; \
        __builtin_amdgcn_global_load_lds((const unsigned*)_g, (LAS unsigned*)(ldsL + (b) * SHM_V + wv * 1024), 16, 0, 0); \
        __builtin_amdgcn_global_load_lds((const unsigned*)(_g + 32 * ldv), (LAS unsigned*)(ldsL + (b) * SHM_V + wv * 1024 + 8192), 16, 0, 0); } while (0)
#define ATT_LAND() asm volatile("s_waitcnt vmcnt(0) lgkmcnt(0)\n\ts_barrier" ::: "memory")
        ATT_DMA_K(0, 0); ATT_DMA_V(0, 0); ATT_DMA_K(1, 1);
        ATT_LAND();
        qkt<DQK, QL>(pA0, pA1, K_lds, qr, ql, kb, r32, hi); partialSM<DQK, THRI>(pA0, pA1, m_reg, mnA, alA);
        ATT_BAR();
        ATT_DMA_K(0, 2); ATT_DMA_V(1, 1);
        for (int j = 1; j + 1 < NT; j += 2) {
            ATT_SBAR(); qkt<DQK, QL>(pB0, pB1, K_lds + SHM_K, qr, ql, kb, r32, hi);
            finishSM(pA0, pA1, alA, l_reg, pa0, pa1, pa2, pa3); ATT_SBAR();
            pv_all<DV>(o, vb0, pa0, pa1, pa2, pa3); partialSM<DQK, THRI>(pB0, pB1, m_reg, mnB, alB);
            ATT_LAND();
            if (j + 2 < NT) ATT_DMA_K(1, j + 2);
            ATT_DMA_V(0, j + 1);
            ATT_RESC(alB);
            ATT_SBAR(); qkt<DQK, QL>(pA0, pA1, K_lds, qr, ql, kb, r32, hi);
            finishSM(pB0, pB1, alB, l_reg, pa0, pa1, pa2, pa3); ATT_SBAR();
            pv_all<DV>(o, vb0 + SHM_V, pa0, pa1, pa2, pa3); partialSM<DQK, THRI>(pA0, pA1, m_reg, mnA, alA);
            ATT_LAND();
            if (j + 3 < NT) ATT_DMA_K(0, j + 3);
            ATT_DMA_V(1, j + 2);
            ATT_RESC(alA);
        }
        ATT_SBAR(); qkt<DQK, QL>(pB0, pB1, K_lds + SHM_K, qr, ql, kb, r32, hi);
        finishSM(pA0, pA1, alA, l_reg, pa0, pa1, pa2, pa3); ATT_SBAR();
        pv_all<DV>(o, vb0, pa0, pa1, pa2, pa3); partialSM<DQK, THRI>(pB0, pB1, m_reg, mnB, alB);
        ATT_LAND(); ATT_RESC(alB);
        finishSM(pB0, pB1, alB, l_reg, pa0, pa1, pa2, pa3); ATT_SBAR();
        pv_all<DV>(o, vb0 + SHM_V, pa0, pa1, pa2, pa3);
#undef ATT_DMA_K
#undef ATT_DMA_V
#undef ATT_LAND
    }
    __builtin_amdgcn_s_setprio(0);
    if (hi == 0) li_l[r32] = l_reg; asm volatile("s_waitcnt lgkmcnt(0)" ::: "memory");
    float rli[16];
#pragma unroll
    for (int r = 0; r < 16; ++r) rli[r] = __builtin_amdgcn_rcpf(li_l[crow(r, hi)]);
    int tid2 = otid(wv);
    bf16* Ow = Ob + (long)((tid2 >> 6) * QBLK) * ldo + (tid2 & 31);
#pragma unroll
    for (int r = 0; r < 16; ++r) { const int orow = crow(r, (tid2 >> 5) & 1);
#pragma unroll
        for (int d0 = 0; d0 < ND0; ++d0) Ow[(long)orow * ldo + d0 * 32] = (bf16)f2bf(o[d0][r] * rli[r]); }
    ATT_BAR();
#undef ATT_BAR
#undef ATT_KROW
#undef ATT_SLOAD
#undef ATT_SWRITE
#undef ATT_SWAIT
#undef ATT_RESC
#undef ATT_MASK
}

template <int DQK, int DV, int SD, bool WINDOW, int QL, bool DMA = false>
__device__ __forceinline__ void attn_phase(const bf16* Q, int ldq, int qhs, const bf16* Kb, int ldk, int khs, const bf16* Vb, int ldv, int vhs, bf16* O, int ldo, int ohs, int H, int G, const float* sinks, char* lds, int wv) {
    const int nlat = NB * H * 32, ntot = WINDOW ? nlat : nlat + NB * H;
    const int c0 = (gridDim.x == 256) ? (((int)blockIdx.x & 7) * 32 + ((int)blockIdx.x >> 3)) : (int)blockIdx.x;
    for (int L = c0; L < ntot; L += gridDim.x) {
        int b, h, q0row, NT, segB = NCTX, qlat0 = 0, klat0 = 0; float m0 = -1e30f, l0 = 0.f;
        if (L < nlat) { const int qb = L & 31; h = (L >> 5) % H; b = (L >> 5) / H; q0row = NCTX + qb * 256; NT = 4 + SEQ / 64;
            if constexpr (WINDOW) { qlat0 = qb * 256; klat0 = max(0, qlat0 - 128); const int hi_ = min(SEQ, qlat0 + 256 + 128); NT = 4 + (hi_ - klat0) / 64; segB = NCTX + klat0; m0 = sinks[h] / Cst<DQK>::scale(); l0 = 1.f; } }
        else { const int L2 = L - nlat; h = L2 % H; b = L2 / H; q0row = 0; NT = 4; }
        const size_t rb = (size_t)b * RPB; const int kvh = h / G;
        attn_unit<DQK, DV, SD, WINDOW, 8, QL, DMA>(Q + (rb + q0row) * ldq + h * qhs, ldq, Kb + rb * ldk + kvh * khs, ldk, Vb + rb * ldv + kvh * vhs, ldv, O + (rb + q0row) * ldo + h * ohs, ldo, NT, segB, qlat0, klat0, m0, l0, lds, wv);
    }
}
}

#define XB_TMO      128
#define XB_XCNT(j)  (256  + 64 * (j))
#define XB_XSUB(j)  (1280 + 64 * (j))
#define XB_XGEN(j)  (2304 + 64 * (j))
#define XB_TOP      3328
#define XB_TOPGEN   3392
#define XCD_BAR_WORDS 3456
#define XB_SPIN_CAP (1u << 18)
__device__ __forceinline__ unsigned xb_ld(unsigned* p)              { return __hip_atomic_load(p, __ATOMIC_RELAXED, __HIP_MEMORY_SCOPE_AGENT); }
__device__ __forceinline__ unsigned xb_add(unsigned* p, unsigned v) { return __hip_atomic_fetch_add(p, v, __ATOMIC_RELAXED, __HIP_MEMORY_SCOPE_AGENT); }
__device__ __forceinline__ unsigned xb_xcc_id() { return (unsigned)__builtin_amdgcn_s_getreg((3 << 11) | 20) & 0xFu; }
#define XB_SPIN(cond, bar) do { unsigned _sp = 0; while (cond) { __builtin_amdgcn_s_sleep(1); \
    if ((++_sp & 255u) == 0u) { if (xb_ld(&(bar)[XB_TMO])) break; if (_sp > XB_SPIN_CAP) { atomicAdd(&(bar)[XB_TMO], 1u); break; } } } } while (0)
struct XcdBarrier { unsigned* bar; unsigned x; volatile LAS unsigned* st; };
__device__ __forceinline__ XcdBarrier xcd_barrier_post(unsigned* bar, volatile LAS unsigned* st) {
    XcdBarrier b; b.bar = bar; b.x = xb_xcc_id(); b.st = st;
    if (threadIdx.x == 0) (void)xb_add(&bar[XB_XCNT(b.x)], 1u);
    return b;
}
__device__ __forceinline__ void xcd_barrier_complete(unsigned* bar, unsigned x, unsigned& nloc, unsigned& nx) {
    const unsigned G = gridDim.x * gridDim.y * gridDim.z;
    unsigned sum, cnt, mine, sp = 0u;
    for (;;) {
        sum = 0u; cnt = 0u; mine = 0u;
#pragma unroll
        for (unsigned j = 0; j < 16; ++j) { const unsigned c = xb_ld(&bar[XB_XCNT(j)]); sum += c; cnt += (c > 0u) ? 1u : 0u; mine = (j == x) ? c : mine; }
        if (sum == G) break;
        __builtin_amdgcn_s_sleep(1);
        if ((++sp & 255u) == 0u) { if (xb_ld(&bar[XB_TMO])) break; if (sp > XB_SPIN_CAP) { atomicAdd(&bar[XB_TMO], 1u); break; } }
    }
    nloc = mine > 0u ? mine : 1u; nx = cnt > 0u ? cnt : 1u;
}
__device__ __forceinline__ void xcd_barrier(const XcdBarrier& b, int wv) {
    asm volatile("s_waitcnt vmcnt(0)" ::: "memory");
    __syncthreads();
    if (otid(wv) == 0) {
        unsigned* bar = b.bar;
        __builtin_amdgcn_s_waitcnt(0);
        unsigned nloc = b.st[0], nx = b.st[1];
        if (nloc == 0u) { xcd_barrier_complete(bar, b.x, nloc, nx); b.st[0] = nloc; b.st[1] = nx; }
        const unsigned old = xb_add(&bar[XB_XSUB(b.x)], 1u);
        const unsigned gen = old / nloc;
        if (old + 1u == (gen + 1u) * nloc) {
            __builtin_amdgcn_fence(__ATOMIC_RELEASE, "agent");
            asm volatile("s_waitcnt vmcnt(0)" ::: "memory");
            const unsigned og = xb_add(&bar[XB_TOP], 1u);
            const unsigned tg = og / nx;
            if (og + 1u == (tg + 1u) * nx) xb_add(&bar[XB_TOPGEN], 1u);
            else XB_SPIN(xb_ld(&bar[XB_TOPGEN]) == tg, bar);
            __builtin_amdgcn_fence(__ATOMIC_ACQUIRE, "agent");
            xb_add(&bar[XB_XGEN(b.x)], 1u);
            asm volatile("s_waitcnt vmcnt(0)" ::: "memory");
        } else {
            XB_SPIN(xb_ld(&bar[XB_XGEN(b.x)]) == gen, bar);
            __builtin_amdgcn_fence(__ATOMIC_ACQUIRE, "agent");
            asm volatile("s_waitcnt vmcnt(0)" ::: "memory");
        }
    }
    __syncthreads();
}

constexpr int RING_OFF = 0, GT_OFF = 131072, MISC_OFF = GT_OFF + 15360, LDS_BYTES = MISC_OFF + 1024;
constexpr int MAX_UNITS_PER_WG = 30;
constexpr int NPH = 35;
__device__ __forceinline__ void grouped_setup(const P& p, int wv, int m, LAS int* tl) {
    __syncthreads();
    const int t_ = otid(wv);
    if (t_ < NE) { const unsigned* cnt = WSP(const unsigned, WS_CTL) + CW_CNT + 64 * m; tl[16 + t_] = (int)__hip_atomic_load(cnt + t_, __ATOMIC_RELAXED, __HIP_MEMORY_SCOPE_AGENT); }
    __syncthreads();
    if (t_ == 0) { int o = 0;
        for (int e = 0; e < NE; ++e) { tl[e] = o; o += (tl[16 + e] + 255) >> 8; }
        tl[8] = o; }
    __syncthreads();
}
template <int K, int N, class Epi, int SPLIT = 1, int SKIPCTX = 0, bool ATILE = false, bool BTILE = false> __device__ __forceinline__ void gemm_plain(const P& p, int wv, unsigned char* lds_, const bf16* A, const bf16* Bt, const Epi& E) {
    LAS unsigned char* lds = (LAS unsigned char*)lds_;
    constexpr int nM = SKIPCTX ? 128 : T / 256, nwg = nM * (N / 256), R = nwg % 256;
    pg8::Sched S; S.init(nM, N / 256, (int)gridDim.x, (int)blockIdx.x, (const LAS int*)(lds + MISC_OFF), 0, (SPLIT && R > 0 && 4 * R <= 256) ? 1 : 0, SKIPCTX);
    pg8::gemm_phase<Epi, false, K, false, ATILE, BTILE>(wv, lds + RING_OFF, A, Bt, 0, S, E, nullptr);
    if constexpr (SPLIT && R > 0 && 4 * R <= 256) {
        pg8::Sched S2; S2.init(nM, N / 256, (int)gridDim.x, (int)blockIdx.x, (const LAS int*)(lds + MISC_OFF), 0, 2, SKIPCTX);
        pg8::gemm_sub_unit<Epi, K, ATILE, BTILE>(wv, lds + RING_OFF, A, Bt, 0, S2, E);
    }
}
__device__ __forceinline__ void moe_w13(const P& p, int wv, unsigned char* lds_, int m) {
    LAS unsigned char* lds = (LAS unsigned char*)lds_; LAS int* tl = (LAS int*)(lds + MISC_OFF); LAS unsigned short* gtab = (LAS unsigned short*)(lds + GT_OFF);
    grouped_setup(p, wv, m, tl);
    pg8::Sched S; S.init(tl[8], 2 * FE / 256, (int)gridDim.x, (int)blockIdx.x, tl, 1);
    const int* idx = WSP(const int, WS_IDX); const int tidg = otid(wv);
    { static_assert(MAX_UNITS_PER_WG % 2 == 0, "two units per step");
      const int half = __builtin_amdgcn_readfirstlane(tidg >> 8), row = tidg & 255; int vals[MAX_UNITS_PER_WG / 2];
#pragma unroll
      for (int k = 0; k < MAX_UNITS_PER_WG / 2; ++k) { pg8::Unit u; int v = 0;
          if (S.next(2 * k + half, u)) { const int pr = (u.pm - tl[u.e]) * 256 + row; const int* ie = idx + (size_t)u.e * T; v = ie[pr < tl[16 + u.e] ? pr : 0]; }
          vals[k] = v; }
#pragma unroll
      for (int k = 0; k < MAX_UNITS_PER_WG / 2; ++k) gtab[(2 * k + half) * 256 + row] = (unsigned short)vals[k]; }
    __syncthreads();
    pg8::EpiSwiglu E{WSP(bf16, WS_ACT), FE};
    pg8::gemm_phase<pg8::EpiSwiglu, true, DM>(wv, lds + RING_OFF, WSP(const bf16, WS_A), WSP(const bf16, W_13M) + (size_t)m * NE * 2 * FE * DM, (size_t)2 * FE * DM, S, E, gtab);
}
__device__ __forceinline__ void moe_w2(const P& p, int wv, unsigned char* lds_, int m) {
    LAS unsigned char* lds = (LAS unsigned char*)lds_; LAS int* tl = (LAS int*)(lds + MISC_OFF);
    grouped_setup(p, wv, m, tl);
    pg8::Sched S; S.init(tl[8], DM / 256, (int)gridDim.x, (int)blockIdx.x, tl, 1, 1, 0);
    pg8::EpiStore E{WSP(bf16, WS_Y), DM, nullptr};
    pg8::gemm_phase<pg8::EpiStore, false, FE, false, true, true>(wv, lds + RING_OFF, WSP(const bf16, WS_ACT), WSP(const bf16, W_2M) + (size_t)m * NE * DM * FE, (size_t)DM * FE, S, E, nullptr);
    pg8::Sched S2; S2.init(tl[8], DM / 256, (int)gridDim.x, (int)blockIdx.x, tl, 1, 2, 0);
    pg8::gemm_sub_unit<pg8::EpiStore, FE, true, true>(wv, lds + RING_OFF, WSP(const bf16, WS_ACT), WSP(const bf16, W_2M) + (size_t)m * NE * DM * FE, (size_t)DM * FE, S2, E);
}
__device__ __forceinline__ void dense_w13(const P& p, int wv, unsigned char* lds, int pi) { pg8::EpiSwiglu E{WSP(bf16, WS_ACT), FF}; gemm_plain<DM, 2 * FF, pg8::EpiSwiglu, 0>(p, wv, lds, WSP(const bf16, WS_A), WSP(const bf16, W_13F) + (size_t)pi * 2 * FF * DM, E); }
__device__ __forceinline__ void dense_w2(const P& p, int wv, unsigned char* lds, int pi, int layer) { pg8::EpiResid E{p.in[0], p.in[2], p.ws, layer, 5, 0}; gemm_plain<FF, DM, pg8::EpiResid, 1, 0, true, true>(p, wv, lds, WSP(const bf16, WS_ACT), WSP(const bf16, W_2F) + (size_t)pi * DM * FF, E); }
template <int SKIPCTX = 0> __device__ __forceinline__ void wo_gemm(const P& p, int wv, unsigned char* lds, const bf16* Ain, size_t woff, int layer, int from_in) { pg8::EpiResid E{p.in[0], p.in[2], p.ws, layer, 2, from_in}; gemm_plain<DM, DM, pg8::EpiResid, 1, SKIPCTX>(p, wv, lds, Ain, WSP(const bf16, woff), E); }

template <int PH> __device__ __forceinline__ void run_phase(const P& p, int wv, unsigned char* lds) {
    const int bid = blockIdx.x, nb = gridDim.x;
    if constexpr (PH == 0) phase_prologue(p, wv, bid, nb, lds);
    if constexpr (PH == 1) phase_norm_plain<true>(p, wv, bid, nb, 0, 0);
    if constexpr (PH == 2) { pg8::EpiStore E{WSP(bf16, WS_QKV), A_NQKV, nullptr}; gemm_plain<DM, A_NQKV>(p, wv, lds, WSP(const bf16, WS_A), WSP(const bf16, W_QKVA), E); }
    if constexpr (PH == 3) phase_post_a(p, wv, bid, nb);
    if constexpr (PH == 4) att::attn_phase<128, 128, 2, false, 0, true>(WSP(const bf16, WS_QKV), A_NQKV, 128, WSP(const bf16, WS_QKV) + 1024, A_NQKV, 128, WSP(const bf16, WS_QKV) + 1280, A_NQKV, 128, WSP(bf16, WS_OB), DM, 128, 8, 4, nullptr, (char*)lds, wv);
    if constexpr (PH == 5) wo_gemm(p, wv, lds, WSP(const bf16, WS_OB), W_OA, 0, 1);
    if constexpr (PH == 6) phase_norm_plain<false>(p, wv, bid, nb, 0, 1);
    if constexpr (PH == 7) dense_w13(p, wv, lds, 0);
    if constexpr (PH == 8) dense_w2(p, wv, lds, 0, 0);
    if constexpr (PH == 9) phase_norm_plain<false>(p, wv, bid, nb, 1, 0);
    if constexpr (PH == 10) { pg8::EpiStore E{WSP(bf16, WS_DOWN), B_NDOWN_P, nullptr}; gemm_plain<DM, B_NDOWN_P>(p, wv, lds, WSP(const bf16, WS_A), WSP(const bf16, W_DOWN), E); }
    if constexpr (PH == 11) phase_post_b1(p, wv, bid, nb);
    if constexpr (PH == 12) { pg8::EpiStoreT<1> E{WSP(bf16, WS_QKV), 1536, WSP(const f32x2, WS_ROPE64)}; gemm_plain<B_QL, B_NUQ>(p, wv, lds, WSP(const bf16, WS_DQN), WSP(const bf16, W_UQ), E); }
    if constexpr (PH == 13) { pg8::EpiKV E{WSP(bf16, WS_KB), WSP(bf16, WS_VB)}; gemm_plain<B_KVL, B_NUKV>(p, wv, lds, WSP(const bf16, WS_DKVN), WSP(const bf16, W_UKV), E); }
    if constexpr (PH == 14) att::attn_phase<192, 128, 1, false, 5>(WSP(const bf16, WS_QKV), 1536, 192, WSP(const bf16, WS_KB), 1536, 192, WSP(const bf16, WS_VB), DM, 128, WSP(bf16, WS_OB), DM, 128, 8, 1, nullptr, (char*)lds, wv);
    if constexpr (PH == 15) wo_gemm(p, wv, lds, WSP(const bf16, WS_OB), W_OB, 1, 0);
    if constexpr (PH == 16) phase_norm<4>(p, wv, bid, nb, lds, 1, 1, 0, 0, 0, true);
    if constexpr (PH == 17) moe_w13(p, wv, lds, 0);
    if constexpr (PH == 18) moe_w2(p, wv, lds, 0);
    if constexpr (PH == 19) phase_combine<false>(p, wv, bid, nb, lds, 2, 0, 0, 1);
    if constexpr (PH == 20) { pg8::EpiGelu E{WSP(bf16, WS_QKV), WSP(bf16, WS_KB)}; gemm_plain<DM, C_NIN>(p, wv, lds, WSP(const bf16, WS_A), WSP(const bf16, W_IN), E); }
    if constexpr (PH == 21) phase_sgu(p, wv, bid, nb, lds);
    if constexpr (PH == 22) wo_gemm(p, wv, lds, WSP(const bf16, WS_VB), W_OUT, 2, 0);
    if constexpr (PH == 23) phase_norm_plain<false>(p, wv, bid, nb, 2, 1);
    if constexpr (PH == 24) dense_w13(p, wv, lds, 1);
    if constexpr (PH == 25) dense_w2(p, wv, lds, 1, 2);
    if constexpr (PH == 26) phase_norm_plain<false>(p, wv, bid, nb, 3, 0);
    if constexpr (PH == 27) { pg8::EpiStoreT<3> E{WSP(bf16, WS_QKV), D_NQKV, WSP(const f32x2, WS_ROPE64)}; gemm_plain<DM, D_NQKV>(p, wv, lds, WSP(const bf16, WS_A), WSP(const bf16, W_QKVD), E); }
    if constexpr (PH == 29) att::attn_phase<64, 64, 2, true, 0>(WSP(const bf16, WS_QKV), D_NQKV, 64, WSP(const bf16, WS_QKV) + 1024, D_NQKV, 64, WSP(const bf16, WS_QKV) + 1152, D_NQKV, 64, WSP(bf16, WS_OB), DM, 64, 16, 8, p.in[26], (char*)lds, wv);
    if constexpr (PH == 30) wo_gemm<1>(p, wv, lds, WSP(const bf16, WS_OB), W_OD, 3, 0);
    if constexpr (PH == 31) phase_norm<4>(p, wv, bid, nb, lds, 3, 1, 0, 0, 1, false);
    if constexpr (PH == 32) moe_w13(p, wv, lds, 1);
    if constexpr (PH == 33) moe_w2(p, wv, lds, 1);
    if constexpr (PH == 34) phase_combine<true>(p, wv, bid, nb, lds, 0, 0, 1, 3);
}
#ifndef MK_PER_PHASE
#define MK_PER_PHASE 0
#endif
template <int PH> __global__ void __launch_bounds__(512, 2) k_phase(P p) {
    extern __shared__ __attribute__((aligned(16))) unsigned char lds[];
    run_phase<PH>(p, __builtin_amdgcn_readfirstlane((int)threadIdx.x >> 6), lds);
}
#define AS4 __attribute__((address_space(4)))
#ifndef PROBE_DUP_MASK
#define PROBE_DUP_MASK 0ull
#endif
template <int PH> __device__ __forceinline__ void phase_fn(const AS4 P* pp, int wv, LAS unsigned char* lds_) {
    const AS4 P* q = pp; asm volatile("" : "+s"(q));
    P p;
#pragma unroll
    for (int i = 0; i < 33; ++i) p.in[i] = q->in[i];
    p.out = q->out; p.ws = q->ws; p.ph_lo = 0; p.ph_hi = 0;
    run_phase<PH>(p, wv, (unsigned char*)lds_);
}
template <int PH> __device__ __forceinline__ void run_all(const AS4 P* pp, int wv, LAS unsigned char* lds, const XcdBarrier& bar) {
    constexpr bool on = (PH != 28);
    if constexpr (on) phase_fn<PH>(pp, wv, lds);
    if constexpr (on && ((PROBE_DUP_MASK >> PH) & 1ull) != 0) { __syncthreads(); phase_fn<PH>(pp, wv, lds); }
    if constexpr (PH + 1 < NPH) { if constexpr (on) xcd_barrier(bar, wv); run_all<PH + 1>(pp, wv, lds, bar); }
}
__global__ void __launch_bounds__(512, 2) k_mega(P p_) {
    extern __shared__ __attribute__((aligned(16))) unsigned char lds[];
    const AS4 P* pp = (const AS4 P*)__builtin_amdgcn_kernarg_segment_ptr();
    const int wv = __builtin_amdgcn_readfirstlane((int)threadIdx.x >> 6);
    LAS unsigned* misc = (LAS unsigned*)((LAS unsigned char*)lds + MISC_OFF);
    if (threadIdx.x < 256) misc[threadIdx.x] = 0u;
    __syncthreads();
    const XcdBarrier bar = xcd_barrier_post((unsigned*)(pp->ws + WS_CTL) + CW_BAR, (volatile LAS unsigned*)(misc + 64));
    run_all<0>(pp, wv, (LAS unsigned char*)lds, bar);
}

template <int PH> static void phase(hipStream_t st, const P& p) {
    static bool attr = false; if (!attr) { (void)hipFuncSetAttribute((const void*)k_phase<PH>, hipFuncAttributeMaxDynamicSharedMemorySize, LDS_BYTES); attr = true; }
    hipLaunchKernelGGL((k_phase<PH>), dim3(256), dim3(512), LDS_BYTES, st, p);
}
template <int LO, int HI> static void phases(hipStream_t st, const P& p) { if constexpr (LO < HI) { phase<LO>(st, p); phases<LO + 1, HI>(st, p); } }

extern "C" void kernel_launch(void* const* d_in, const int* in_sizes, int n_in, void* d_out, int out_size, void* d_ws, size_t ws_size, hipStream_t stream) {
    if (n_in != 33 || ws_size < WS_END || out_size != NB * SEQ * DM) { fprintf(stderr, "kernel_launch: unexpected shapes n_in %d ws %zu (need %zu) out %d\n", n_in, ws_size, (size_t)WS_END, out_size); return; }
    P p{}; for (int i = 0; i < 33; ++i) p.in[i] = (const float*)d_in[i]; p.out = (float*)d_out; p.ws = (unsigned char*)d_ws; p.ph_lo = 0; p.ph_hi = 0;
    unsigned char* ws = (unsigned char*)d_ws;
    (void)hipMemsetAsync(ws + WS_CTL, 0, CTL_BYTES, stream);
#if MK_PER_PHASE
    phases<0, NPH>(stream, p);
#else
    static int grid = 0;
    if (grid == 0) {
        int dev = 0, cus = 0, per_cu = 0;
        (void)hipGetDevice(&dev); (void)hipDeviceGetAttribute(&cus, hipDeviceAttributeMultiprocessorCount, dev);
        if (hipFuncSetAttribute((const void*)k_mega, hipFuncAttributeMaxDynamicSharedMemorySize, LDS_BYTES) != hipSuccess) { fprintf(stderr, "kernel_launch: hipFuncSetAttribute failed\n"); grid = -1; return; }
        if (hipOccupancyMaxActiveBlocksPerMultiprocessor(&per_cu, (const void*)k_mega, 512, LDS_BYTES) != hipSuccess || per_cu < 1) { fprintf(stderr, "kernel_launch: occupancy query says %d blocks per CU\n", per_cu); (void)hipGetLastError(); }
        grid = cus;
        if (grid != 256) fprintf(stderr, "kernel_launch: %d CUs (built for 256)\n", grid);
    }
    if (grid < 0) return;
    hipLaunchKernelGGL(k_mega, dim3(grid), dim3(512), LDS_BYTES, stream, p);
#endif
    const hipError_t le = hipPeekAtLastError();
    if (le != hipSuccess) fprintf(stderr, "kernel_launch: launch failed: %s\n", hipGetErrorName(le));
}
```

```cpp
#include <hip/hip_runtime.h>
#include <cstdio>
#include <cstdint>
#include <cstring>
#include <cmath>

#define GAS __attribute__((address_space(1)))
#define LAS __attribute__((address_space(3)))
typedef unsigned short bf16;
typedef float f32x4 __attribute__((ext_vector_type(4)));
typedef float f32x2 __attribute__((ext_vector_type(2)));
typedef short bf16x8 __attribute__((ext_vector_type(8)));
typedef unsigned u32x4 __attribute__((ext_vector_type(4)));
typedef unsigned u32x2 __attribute__((ext_vector_type(2)));

constexpr int DM = 1024, NB = 4, SEQ = 8192, NCTX = 256, RPB = SEQ + NCTX  , T = NB * RPB  ;
constexpr int GRIDW = 64;
constexpr float EPS = 1e-6f;
constexpr int A_NQKV = 1536, B_NDOWN = 704, B_NDOWN_P = 768, B_QL = 384, B_KVL = 256, B_NUQ = 1536, B_NUKV = 2048, C_NIN = 2048, D_NQKV = 1280;
constexpr int FF = 2816, FE = 3584, NE = 8;
constexpr int MAXSLOT = 69632;

constexpr size_t MiB = 1u << 20;
constexpr size_t al(size_t x) { return (x + 255) & ~(size_t)255; }
constexpr size_t WS_CTL = 0, CTL_BYTES = 1 * MiB;
constexpr size_t WS_MOD = 1 * MiB;
constexpr size_t WS_ROPE128 = 2 * MiB;
constexpr size_t WS_ROPE64 = WS_ROPE128 + 128 * 32 * 8;
constexpr size_t WS_IDX = 3 * MiB;
constexpr size_t WS_GW = WS_IDX + al((size_t)NE * T * 4);
constexpr size_t WS_TOK = WS_GW + al((size_t)NE * T * 4);
constexpr size_t WS_TOKW = WS_TOK + al((size_t)T * 16);
constexpr size_t WS_W0 = 8 * MiB;
static_assert(WS_TOKW + (size_t)T * 8 <= WS_W0, "routing tables fit below the weights");
constexpr size_t W_QKVA = WS_W0;
constexpr size_t W_OA = W_QKVA + (size_t)A_NQKV * DM * 2;
constexpr size_t W_DOWN = W_OA + (size_t)DM * DM * 2;
constexpr size_t W_UQ = W_DOWN + (size_t)B_NDOWN_P * DM * 2;
constexpr size_t W_UKV = W_UQ + (size_t)B_NUQ * B_QL * 2;
constexpr size_t W_OB = W_UKV + (size_t)B_NUKV * B_KVL * 2;
constexpr size_t W_IN = W_OB + (size_t)DM * DM * 2;
constexpr size_t W_OUT = W_IN + (size_t)C_NIN * DM * 2;
constexpr size_t W_SP = W_OUT + (size_t)DM * DM * 2;
constexpr size_t W_QKVD = W_SP + (size_t)8 * 128 * 128 * 2;
constexpr size_t W_OD = W_QKVD + (size_t)D_NQKV * DM * 2;
constexpr size_t W_13F = W_OD + (size_t)DM * DM * 2;
constexpr size_t W_2F = W_13F + (size_t)2 * 2 * FF * DM * 2;
constexpr size_t W_13M = W_2F + (size_t)2 * DM * FF * 2;
constexpr size_t W_2M = W_13M + (size_t)2 * NE * 2 * FE * DM * 2;
constexpr size_t WS_WEND = W_2M + (size_t)2 * NE * DM * FE * 2;
constexpr size_t WS_H = al(WS_WEND);
constexpr size_t WS_A = WS_H + (size_t)T * DM * 2;
constexpr size_t WS_QKV = WS_A + (size_t)T * DM * 2;
constexpr size_t WS_KB = WS_QKV + (size_t)T * 1536 * 2;
constexpr size_t WS_VB = WS_KB + (size_t)T * 1536 * 2;
constexpr size_t WS_OB = WS_VB + (size_t)T * DM * 2;
constexpr size_t WS_DOWN = WS_OB + (size_t)T * DM * 2;
constexpr size_t WS_DQN = WS_DOWN + (size_t)T * B_NDOWN_P * 2;
constexpr size_t WS_DKVN = WS_DQN + (size_t)T * B_QL * 2;
constexpr size_t WS_ACT = WS_DKVN + (size_t)T * B_KVL * 2;
constexpr size_t WS_Y = WS_ACT + (size_t)MAXSLOT * FE * 2;
constexpr size_t WS_END = WS_Y + (size_t)MAXSLOT * DM * 2;
constexpr int CW_CNT = 64;
constexpr int CW_BAR = 4096;

__device__ __forceinline__ unsigned f2bf(float f) { unsigned u = __builtin_bit_cast(unsigned, f); return (u + 0x7fffu + ((u >> 16) & 1u)) >> 16; }
__device__ __forceinline__ unsigned pk2(float lo, float hi) { unsigned r; asm("v_cvt_pk_bf16_f32 %0, %1, %2" : "=v"(r) : "v"(lo), "v"(hi)); return r; }
__device__ __forceinline__ float bf2f(unsigned b) { return __builtin_bit_cast(float, b << 16); }
__device__ __forceinline__ float bflo(unsigned w) { return __builtin_bit_cast(float, w << 16); }
__device__ __forceinline__ float bfhi(unsigned w) { return __builtin_bit_cast(float, w & 0xffff0000u); }
__device__ __forceinline__ float wave_sum(float v) {
#pragma unroll
    for (int o = 1; o < 64; o <<= 1) v += __shfl_xor(v, o);
    return v;
}
__device__ __forceinline__ int otid(int wv) { int l; asm volatile("v_mbcnt_lo_u32_b32 %0, -1, 0\n\tv_mbcnt_hi_u32_b32 %0, -1, %0" : "=v"(l)); return wv * 64 + l; }
__device__ __forceinline__ float silu_f(float x) { return x / (1.f + __expf(-x)); }
__device__ __forceinline__ float gelu_erf(float x) { return 0.5f * x * (1.f + erff(x * 0.70710678118654752f)); }

struct P {
    const float* in[33];
    float* out;
    unsigned char* ws;
    int ph_lo, ph_hi;
};
#define WSP(type, off) ((type*)(p.ws + (off)))
#define SUB_SKIP(u, ai, bj) ((u).sub != 0 && (u).sub != 1 + (ai) * 2 + (bj))

__device__ __forceinline__ void row_info(int r, int& b, int& j) { b = r / RPB; j = r - b * RPB; }
__device__ __forceinline__ const float* in_row(const P& p, int r) {
    int b, j; row_info(r, b, j);
    return j < NCTX ? p.in[2] + ((size_t)b * NCTX + j) * DM : p.in[0] + ((size_t)b * SEQ + (j - NCTX)) * DM;
}
__device__ __forceinline__ const float* mod_vec(const P& p, int layer, int r, int chunk) {
    int b, j; row_info(r, b, j); const int mr = j < NCTX ? 4 : b;
    return WSP(const float, WS_MOD) + ((size_t)(layer * 5 + mr) * 6 + chunk) * DM;
}

__device__ __forceinline__ void transpose_item(const float* W, int K, int N, bf16* WT, int mode, int ffh, LAS float* scr, int item, int lane) {
    const int nblk = N / 64, kb = item / nblk, nb = item % nblk, k0 = 64 * kb, n0 = 64 * nb;
    const int lr = lane >> 4, lc = (lane & 15) * 4;
#pragma unroll 8
    for (int i = 0; i < 16; ++i) { const int kk = 4 * i + lr; const f32x4 v = *(const f32x4*)(W + (size_t)(k0 + kk) * N + n0 + lc); LAS float* d = scr + kk * 65 + lc; d[0] = v.x; d[1] = v.y; d[2] = v.z; d[3] = v.w; }
    asm volatile("s_waitcnt lgkmcnt(0)" ::: "memory");
    int d0 = n0;
    if (mode == 1) { if (n0 < ffh) d0 = (n0 / 128) * 256 + n0 % 128; else { const int j = n0 - ffh; d0 = (j / 128) * 256 + 128 + j % 128; } }
    const int c = lane & 7;
#pragma unroll
    for (int j = 0; j < 8; ++j) { const int n = (lane >> 3) + 8 * j; const LAS float* s = scr + (8 * c) * 65 + n;
        u32x4 o; o.x = pk2(s[0 * 65], s[1 * 65]); o.y = pk2(s[2 * 65], s[3 * 65]); o.z = pk2(s[4 * 65], s[5 * 65]); o.w = pk2(s[6 * 65], s[7 * 65]);
        const int dn = d0 + n;
        if (mode == 2) *(u32x4*)(WT + (((size_t)(dn >> 8) * (K >> 6) + kb) * 256 + (dn & 255)) * 64 + 8 * c) = o;
        else *(u32x4*)(WT + (size_t)dn * K + k0 + 8 * c) = o; }
    asm volatile("s_waitcnt lgkmcnt(0)" ::: "memory");
}
struct TJob { const float* W; bf16* WT; int K, N, mode, ffh, items; };

__device__ __forceinline__ void phase_prologue(const P& p, int wv, int bid, int nb, unsigned char* lds_) {
    LAS unsigned char* lds = (LAS unsigned char*)lds_;
    const int tid = otid(wv), lane = tid & 63, wave = tid >> 6;
    {
        const int g = bid * 512 + tid;
        if (g < 128 * 32) { const int pos = g >> 5, i = g & 31; const float inv = (float)pow(10000.0, -(double)i / 32.0); const float a = (float)pos * inv;
            WSP(f32x2, WS_ROPE128)[g] = (f32x2){cosf(a), sinf(a)}; }
        else if (g < 128 * 32 + 128 * 16) { const int q = g - 128 * 32, pos = q >> 4, i = q & 15; const float inv = (float)pow(10000.0, -(double)i / 16.0); const float a = (float)pos * inv;
            WSP(f32x2, WS_ROPE64)[q] = (f32x2){cosf(a), sinf(a)}; }
    }
    {
        LAS float* sc = (LAS float*)lds;
        LAS float* red = (LAS float*)(lds + 5 * 1024 * 4);
        for (int it = bid; it < 192; it += nb) {
            const int layer = it / 48, cg = it % 48;
            __syncthreads();
            for (int i = tid; i < 5 * 1024; i += 512) { const int r = i >> 10, k = i & 1023; const float v = r < 4 ? p.in[1][r * DM + k] : p.in[3][k]; sc[i] = silu_f(v); }
            __syncthreads();
            const float* W = p.in[4] + (size_t)layer * DM * 6144 + cg * 128 + lane * 2;
            f32x2 acc[5];
#pragma unroll
            for (int r = 0; r < 5; ++r) acc[r] = (f32x2){0.f, 0.f};
            for (int k = wave * 128; k < wave * 128 + 128; ++k) { const f32x2 w = *(const f32x2*)(W + (size_t)k * 6144);
#pragma unroll
                for (int r = 0; r < 5; ++r) acc[r] += w * sc[r * 1024 + k]; }
#pragma unroll
            for (int r = 0; r < 5; ++r) *(LAS f32x2*)(red + (wave * 5 + r) * 128 + lane * 2) = acc[r];
            __syncthreads();
            for (int i = tid; i < 5 * 128; i += 512) { const int r = i >> 7, c = i & 127; float s = 0.f;
#pragma unroll
                for (int w = 0; w < 8; ++w) s += red[(w * 5 + r) * 128 + c];
                const int col = cg * 128 + c;
                WSP(float, WS_MOD)[(size_t)(layer * 5 + r) * 6144 + col] = s + p.in[5][layer * 6144 + col]; }
        }
        __syncthreads();
    }
    {
        LAS float* scr = (LAS float*)(lds + wave * 16640);
        const int gw = bid * 8 + wave, NGW = nb * 8;
        int start = 0;
        auto run = [&](const float* W, bf16* WT, int K, int N, int mode, int ffh) {
            const int items = (K / 64) * (N / 64);
            int first = gw - start; if (first < 0) first += NGW;
            for (int it = first; it < items; it += NGW) transpose_item(W, K, N, WT, mode, ffh, scr, it, lane);
            start = (start + items) % NGW;
        };
        run(p.in[9], WSP(bf16, W_QKVA), DM, A_NQKV, 0, 0);
        run(p.in[12], WSP(bf16, W_OA), DM, DM, 0, 0);
        run(p.in[13], WSP(bf16, W_DOWN), DM, B_NDOWN, 0, 0);
        run(p.in[16], WSP(bf16, W_UQ), B_QL, B_NUQ, 0, 0);
        run(p.in[17], WSP(bf16, W_UKV), B_KVL, B_NUKV, 0, 0);
        run(p.in[18], WSP(bf16, W_OB), DM, DM, 0, 0);
        run(p.in[19], WSP(bf16, W_IN), DM, C_NIN, 0, 0);
        run(p.in[24], WSP(bf16, W_OUT), DM, DM, 0, 0);
        run(p.in[25], WSP(bf16, W_QKVD), DM, D_NQKV, 0, 0);
        run(p.in[27], WSP(bf16, W_OD), DM, DM, 0, 0);
        for (int l = 0; l < 2; ++l) {
            run(p.in[28] + (size_t)l * DM * 2 * FF, WSP(bf16, W_13F) + (size_t)l * 2 * FF * DM, DM, 2 * FF, 1, FF);
            run(p.in[29] + (size_t)l * FF * DM, WSP(bf16, W_2F) + (size_t)l * DM * FF, FF, DM, 2, 0);
        }
        for (int le = 0; le < 2 * NE; ++le) {
            run(p.in[31] + (size_t)le * DM * 2 * FE, WSP(bf16, W_13M) + (size_t)le * 2 * FE * DM, DM, 2 * FE, 1, FE);
            run(p.in[32] + (size_t)le * FE * DM, WSP(bf16, W_2M) + (size_t)le * DM * FE, FE, DM, 2, 0);
        }
        const int g = bid * 512 + tid, ng = nb * 512;
        for (int i = g; i < 64 * DM / 8; i += ng) *(u32x4*)(WSP(bf16, W_DOWN) + (size_t)B_NDOWN * DM + i * 8) = (u32x4){0u, 0u, 0u, 0u};
        for (int i = g; i < 8 * 128 * 128 / 4; i += ng) { const f32x4 v = *(const f32x4*)(p.in[22] + i * 4); *(u32x2*)(WSP(bf16, W_SP) + i * 4) = (u32x2){pk2(v.x, v.y), pk2(v.z, v.w)}; }
    }
}

__device__ __forceinline__ void moe_offsets_lds(const P& p, int m, LAS int* off  ) {
    const unsigned* cnt = WSP(const unsigned, WS_CTL) + CW_CNT + 64 * m; int o = 0;
    for (int e = 0; e < NE; ++e) { off[e] = o; const int c = (int)__hip_atomic_load(cnt + e, __ATOMIC_RELAXED, __HIP_MEMORY_SCOPE_AGENT); o += (c + 255) & ~255; }
    off[NE] = o;
}

template <int MODE>
__device__ __forceinline__ void phase_norm(const P& p, int wv, int bid, int nb, unsigned char* lds_, int layer, int which  , int m_prev, int prev_layer, int m_cur, bool route_ctx) {
    LAS unsigned char* lds = (LAS unsigned char*)lds_;
    const int tid = otid(wv), lane = tid & 63, wave = tid >> 6;
    const int per = (T + nb - 1) / nb, r0 = bid * per, r1 = min(T, r0 + per);
    LAS float* rt = (LAS float*)lds;
    LAS int* re = (LAS int*)(lds + 32768);
    LAS float* rw = (LAS float*)(lds + 32768 + 8192);
    LAS int* soff = (LAS int*)(lds + 32768 + 16384);
    if (MODE & 4) { const float* R = p.in[30] + (size_t)m_cur * DM * NE; for (int i = tid; i < DM * NE; i += 512) rt[i] = R[i]; }
    if (MODE & 2) { if (tid == 0) moe_offsets_lds(p, m_prev, soff); }
    __syncthreads();
    const float* gain = (MODE & 8) ? p.in[8] : (which == 0 ? p.in[6] : p.in[7]) + (size_t)layer * DM;
    int cur_mr = -1; f32x4 gm[4], shv[4], g2v[4];
#pragma unroll
    for (int q = 0; q < 4; ++q) { gm[q] = (f32x4){0.f, 0.f, 0.f, 0.f}; shv[q] = gm[q]; g2v[q] = gm[q]; }
    for (int r = r0 + wave; r < r1; r += 8) {
        int b, j; row_info(r, b, j); const bool isctx = j < NCTX;
        if ((MODE & 8) && isctx) continue;
        { const int mr = isctx ? 4 : b;
          if (mr != cur_mr) { cur_mr = mr;
            if (MODE & 2) { const float* g2 = mod_vec(p, prev_layer, r, 5);
#pragma unroll
                for (int q = 0; q < 4; ++q) g2v[q] = *(const f32x4*)(g2 + q * 256 + lane * 4); }
            if (MODE & 8) {
#pragma unroll
                for (int q = 0; q < 4; ++q) gm[q] = *(const f32x4*)(gain + q * 256 + lane * 4); }
            else { const float* sh_ = mod_vec(p, layer, r, which * 3 + 0); const float* sc_ = mod_vec(p, layer, r, which * 3 + 1);
#pragma unroll
                for (int q = 0; q < 4; ++q) { const f32x4 g = *(const f32x4*)(gain + q * 256 + lane * 4), s1 = *(const f32x4*)(sc_ + q * 256 + lane * 4); gm[q] = g * (s1 + 1.f); shv[q] = *(const f32x4*)(sh_ + q * 256 + lane * 4); } } } }
        f32x4 v[4];
        if (MODE & 1) { const float* src = in_row(p, r);
#pragma unroll
            for (int q = 0; q < 4; ++q) v[q] = *(const f32x4*)(src + q * 256 + lane * 4); }
        else { const bf16* src = WSP(const bf16, WS_H) + (size_t)r * DM;
#pragma unroll
            for (int q = 0; q < 4; ++q) { const u32x2 w = *(const u32x2*)(src + q * 256 + lane * 4); v[q] = (f32x4){bflo(w.x), bfhi(w.x), bflo(w.y), bfhi(w.y)}; } }
        if (MODE & 2) {
            const int4 tk = WSP(const int4, WS_TOK)[r];
            const bool routed = tk.x >= 0;
            if (routed) {
                const int s0 = soff[tk.x] + tk.y, s1 = soff[tk.z] + tk.w;
                const bf16* y0 = WSP(const bf16, WS_Y) + (size_t)s0 * DM; const bf16* y1 = WSP(const bf16, WS_Y) + (size_t)s1 * DM;
                const f32x2 tw = WSP(const f32x2, WS_TOKW)[r];
#pragma unroll
                for (int q = 0; q < 4; ++q) { const u32x2 a = *(const u32x2*)(y0 + q * 256 + lane * 4), c = *(const u32x2*)(y1 + q * 256 + lane * 4); const f32x4 g = g2v[q];
                    v[q].x += g.x * (tw.x * bflo(a.x) + tw.y * bflo(c.x)); v[q].y += g.y * (tw.x * bfhi(a.x) + tw.y * bfhi(c.x)); v[q].z += g.z * (tw.x * bflo(a.y) + tw.y * bflo(c.y)); v[q].w += g.w * (tw.x * bfhi(a.y) + tw.y * bfhi(c.y)); }
                if (!(MODE & 8)) {
#pragma unroll
                    for (int q = 0; q < 4; ++q) *(u32x2*)(WSP(bf16, WS_H) + (size_t)r * DM + q * 256 + lane * 4) = (u32x2){pk2(v[q].x, v[q].y), pk2(v[q].z, v[q].w)};
                }
            }
        }
        float ss = 0.f;
#pragma unroll
        for (int q = 0; q < 4; ++q) ss += (v[q].x * v[q].x + v[q].y * v[q].y) + (v[q].z * v[q].z + v[q].w * v[q].w);
        const float rs = rsqrtf(wave_sum(ss) * (1.f / DM) + EPS);
        if (MODE & 8) {
            float* o = p.out + ((size_t)b * SEQ + (j - NCTX)) * DM;
#pragma unroll
            for (int q = 0; q < 4; ++q) *(f32x4*)(o + q * 256 + lane * 4) = v[q] * rs * gm[q];
            continue;
        }
#pragma unroll
        for (int q = 0; q < 4; ++q) {
            v[q] = (v[q] * rs) * gm[q] + shv[q];
            *(u32x2*)(WSP(bf16, WS_A) + (size_t)r * DM + q * 256 + lane * 4) = (u32x2){pk2(v[q].x, v[q].y), pk2(v[q].z, v[q].w)}; }
        if (MODE & 4) {
            const int li = r - r0;
            if (isctx && !route_ctx) { if (lane == 0) { re[li * 2] = -1; re[li * 2 + 1] = -1; } }
            else {
                float lg[8];
#pragma unroll
                for (int e = 0; e < 8; ++e) lg[e] = 0.f;
#pragma unroll
                for (int q = 0; q < 4; ++q)
#pragma unroll
                    for (int c = 0; c < 4; ++c) { const int col = q * 256 + lane * 4 + c; const f32x4 w0 = *(LAS f32x4*)(rt + col * 8), w1 = *(LAS f32x4*)(rt + col * 8 + 4); const float a = v[q][c];
                        lg[0] += a * w0.x; lg[1] += a * w0.y; lg[2] += a * w0.z; lg[3] += a * w0.w; lg[4] += a * w1.x; lg[5] += a * w1.y; lg[6] += a * w1.z; lg[7] += a * w1.w; }
#pragma unroll
                for (int e = 0; e < 8; ++e) lg[e] = wave_sum(lg[e]);
                int e0 = 0; float v0 = lg[0];
#pragma unroll
                for (int e = 1; e < 8; ++e) if (lg[e] > v0) { v0 = lg[e]; e0 = e; }
                int e1 = -1; float v1 = -3.0e38f;
#pragma unroll
                for (int e = 0; e < 8; ++e) if (e != e0 && lg[e] > v1) { v1 = lg[e]; e1 = e; }
                const float w1 = 1.f / (1.f + __expf(v0 - v1)), w0 = 1.f - w1;
                if (lane == 0) { re[li * 2] = e0; re[li * 2 + 1] = e1; rw[li * 2] = w0; rw[li * 2 + 1] = w1; }
            }
        }
    }
    if (MODE & 4) {
        __syncthreads();
        if (tid < NE) {
            const int e = tid, n = r1 - r0; int c = 0;
            for (int i = 0; i < 2 * n; ++i) c += (re[i] == e);
            unsigned* cnt = WSP(unsigned, WS_CTL) + CW_CNT + 64 * m_cur + e;
            int base = c ? (int)__hip_atomic_fetch_add(cnt, (unsigned)c, __ATOMIC_RELAXED, __HIP_MEMORY_SCOPE_AGENT) : 0;
            int* idx = WSP(int, WS_IDX) + (size_t)e * T; float* gw = WSP(float, WS_GW) + (size_t)e * T; int* tok = WSP(int, WS_TOK);
            for (int i = 0; i < 2 * n; ++i) if (re[i] == e) { const int r = r0 + (i >> 1); idx[base] = r; gw[base] = rw[i]; tok[r * 4 + (i & 1) * 2] = e; tok[r * 4 + (i & 1) * 2 + 1] = base; WSP(float, WS_TOKW)[r * 2 + (i & 1)] = rw[i]; ++base; }
        }
        for (int i = tid; i < r1 - r0; i += 512) if (re[i * 2] < 0) { int* tok = WSP(int, WS_TOK); const int r = r0 + i; tok[r * 4] = -1; tok[r * 4 + 1] = 0; tok[r * 4 + 2] = -1; tok[r * 4 + 3] = 0; }
    }
}

template <bool FINAL>
__device__ __forceinline__ void phase_combine(const P& p, int wv, int bid, int nb, unsigned char* lds_, int layer, int which, int m_prev, int prev_layer) {
    LAS unsigned char* lds = (LAS unsigned char*)lds_;
    const int tid = otid(wv), lane = tid & 63, wave = tid >> 6;
    const int per = (T + nb - 1) / nb, r0 = bid * per, r1 = min(T, r0 + per);
    LAS int* soff = (LAS int*)(lds + 32768 + 16384);
    if (tid == 0) moe_offsets_lds(p, m_prev, soff);
    __syncthreads();
    const float* gain = FINAL ? p.in[8] : (which == 0 ? p.in[6] : p.in[7]) + (size_t)layer * DM;
    int cur_mr = -1; f32x4 gm[4], shv[4], g2v[4];
#pragma unroll
    for (int q = 0; q < 4; ++q) { gm[q] = (f32x4){0.f, 0.f, 0.f, 0.f}; shv[q] = gm[q]; g2v[q] = gm[q]; }
    const int4* TOK = WSP(const int4, WS_TOK); const f32x2* TOKW = WSP(const f32x2, WS_TOKW);
    const bf16* Yb = WSP(const bf16, WS_Y); bf16* Hb = WSP(bf16, WS_H);
#define CMB_LOAD(hX, aX, cX, rr, tk) do { const bool _ro = (tk).x >= 0; const int _s0 = _ro ? soff[(tk).x] + (tk).y : 0, _s1 = _ro ? soff[(tk).z] + (tk).w : 0; \
        const bf16* _h = Hb + (size_t)(rr) * DM + lane * 4; const bf16* _y0 = Yb + (size_t)_s0 * DM + lane * 4; const bf16* _y1 = Yb + (size_t)_s1 * DM + lane * 4; \
        _Pragma("unroll") for (int q = 0; q < 4; ++q) { hX[q] = *(const u32x2*)(_h + q * 256); aX[q] = *(const u32x2*)(_y0 + q * 256); cX[q] = *(const u32x2*)(_y1 + q * 256); } } while (0)
    int r = r0 + wave;
    if (r < r1) {
        int4 tk_c = TOK[r]; f32x2 tw_c = TOKW[r];
        int4 tk_n = tk_c; f32x2 tw_n = tw_c; if (r + 8 < r1) { tk_n = TOK[r + 8]; tw_n = TOKW[r + 8]; }
        u32x2 hA[4], aA[4], cA[4];
        CMB_LOAD(hA, aA, cA, r, tk_c);
        for (; r < r1; r += 8) {
            u32x2 hB[4], aB[4], cB[4];
#pragma unroll
            for (int q = 0; q < 4; ++q) { hB[q] = hA[q]; aB[q] = aA[q]; cB[q] = cA[q]; }
            if (r + 8 < r1) CMB_LOAD(hB, aB, cB, r + 8, tk_n);
            int4 tk_nn = tk_n; f32x2 tw_nn = tw_n; if (r + 16 < r1) { tk_nn = TOK[r + 16]; tw_nn = TOKW[r + 16]; }
            int b, j; row_info(r, b, j); const bool isctx = j < NCTX;
            if (!(FINAL && isctx)) {
                const int mr = isctx ? 4 : b;
                if (mr != cur_mr) { cur_mr = mr; const float* g2 = mod_vec(p, prev_layer, r, 5);
#pragma unroll
                    for (int q = 0; q < 4; ++q) g2v[q] = *(const f32x4*)(g2 + q * 256 + lane * 4);
                    if (FINAL) {
#pragma unroll
                        for (int q = 0; q < 4; ++q) gm[q] = *(const f32x4*)(gain + q * 256 + lane * 4); }
                    else { const float* sh_ = mod_vec(p, layer, r, which * 3 + 0); const float* sc_ = mod_vec(p, layer, r, which * 3 + 1);
#pragma unroll
                        for (int q = 0; q < 4; ++q) { const f32x4 g = *(const f32x4*)(gain + q * 256 + lane * 4), s1 = *(const f32x4*)(sc_ + q * 256 + lane * 4); gm[q] = g * (s1 + 1.f); shv[q] = *(const f32x4*)(sh_ + q * 256 + lane * 4); } } }
                f32x4 v[4];
#pragma unroll
                for (int q = 0; q < 4; ++q) v[q] = (f32x4){bflo(hA[q].x), bfhi(hA[q].x), bflo(hA[q].y), bfhi(hA[q].y)};
                if (tk_c.x >= 0) {
#pragma unroll
                    for (int q = 0; q < 4; ++q) { const u32x2 a = aA[q], c = cA[q]; const f32x4 g = g2v[q];
                        v[q].x += g.x * (tw_c.x * bflo(a.x) + tw_c.y * bflo(c.x)); v[q].y += g.y * (tw_c.x * bfhi(a.x) + tw_c.y * bfhi(c.x)); v[q].z += g.z * (tw_c.x * bflo(a.y) + tw_c.y * bflo(c.y)); v[q].w += g.w * (tw_c.x * bfhi(a.y) + tw_c.y * bfhi(c.y)); }
                    if (!FINAL) {
#pragma unroll
                        for (int q = 0; q < 4; ++q) *(u32x2*)(Hb + (size_t)r * DM + q * 256 + lane * 4) = (u32x2){pk2(v[q].x, v[q].y), pk2(v[q].z, v[q].w)}; }
                }
                float ss = 0.f;
#pragma unroll
                for (int q = 0; q < 4; ++q) ss += (v[q].x * v[q].x + v[q].y * v[q].y) + (v[q].z * v[q].z + v[q].w * v[q].w);
                const float rs = rsqrtf(wave_sum(ss) * (1.f / DM) + EPS);
                if (FINAL) { float* o = p.out + ((size_t)b * SEQ + (j - NCTX)) * DM;
#pragma unroll
                    for (int q = 0; q < 4; ++q) *(f32x4*)(o + q * 256 + lane * 4) = v[q] * rs * gm[q]; }
                else {
#pragma unroll
                    for (int q = 0; q < 4; ++q) { const f32x4 o = (v[q] * rs) * gm[q] + shv[q]; *(u32x2*)(WSP(bf16, WS_A) + (size_t)r * DM + q * 256 + lane * 4) = (u32x2){pk2(o.x, o.y), pk2(o.z, o.w)}; } }
            }
#pragma unroll
            for (int q = 0; q < 4; ++q) { hA[q] = hB[q]; aA[q] = aB[q]; cA[q] = cB[q]; }
            tk_c = tk_n; tw_c = tw_n; tk_n = tk_nn; tw_n = tw_nn;
        }
    }
#undef CMB_LOAD
}

template <bool FROM_IN>
__device__ __forceinline__ void phase_norm_plain(const P& p, int wv, int bid, int nb, int layer, int which) {
    const int tid = otid(wv), lane = tid & 63, wave = tid >> 6;
    const int per = (T + nb - 1) / nb, r0 = bid * per, r1 = min(T, r0 + per);
    const float* gain = (which == 0 ? p.in[6] : p.in[7]) + (size_t)layer * DM;
    int cur_mr = -1; f32x4 gm[4], shv[4];
#pragma unroll
    for (int q = 0; q < 4; ++q) { gm[q] = (f32x4){0.f, 0.f, 0.f, 0.f}; shv[q] = gm[q]; }
    for (int r = r0 + wave; r < r1; r += 16) {
        const int ra = r, rb = (r + 8 < r1) ? r + 8 : r;
        f32x4 va[4], vb[4];
        if (FROM_IN) { const float* sa = in_row(p, ra); const float* sb = in_row(p, rb);
#pragma unroll
            for (int q = 0; q < 4; ++q) { va[q] = *(const f32x4*)(sa + q * 256 + lane * 4); vb[q] = *(const f32x4*)(sb + q * 256 + lane * 4); } }
        else { const bf16* sa = WSP(const bf16, WS_H) + (size_t)ra * DM; const bf16* sb = WSP(const bf16, WS_H) + (size_t)rb * DM; u32x2 wa[4], wb[4];
#pragma unroll
            for (int q = 0; q < 4; ++q) { wa[q] = *(const u32x2*)(sa + q * 256 + lane * 4); wb[q] = *(const u32x2*)(sb + q * 256 + lane * 4); }
#pragma unroll
            for (int q = 0; q < 4; ++q) { va[q] = (f32x4){bflo(wa[q].x), bfhi(wa[q].x), bflo(wa[q].y), bfhi(wa[q].y)}; vb[q] = (f32x4){bflo(wb[q].x), bfhi(wb[q].x), bflo(wb[q].y), bfhi(wb[q].y)}; } }
        float sa2 = 0.f, sb2 = 0.f;
#pragma unroll
        for (int q = 0; q < 4; ++q) { sa2 += (va[q].x * va[q].x + va[q].y * va[q].y) + (va[q].z * va[q].z + va[q].w * va[q].w); sb2 += (vb[q].x * vb[q].x + vb[q].y * vb[q].y) + (vb[q].z * vb[q].z + vb[q].w * vb[q].w); }
        const float rsa = rsqrtf(wave_sum(sa2) * (1.f / DM) + EPS), rsb = rsqrtf(wave_sum(sb2) * (1.f / DM) + EPS);
#pragma unroll
        for (int half = 0; half < 2; ++half) {
            const int rr = half ? rb : ra; int b, j; row_info(rr, b, j); const int mr = (j < NCTX) ? 4 : b;
            if (mr != cur_mr) { cur_mr = mr; const float* sh_ = mod_vec(p, layer, rr, which * 3 + 0); const float* sc_ = mod_vec(p, layer, rr, which * 3 + 1);
#pragma unroll
                for (int q = 0; q < 4; ++q) { const f32x4 g = *(const f32x4*)(gain + q * 256 + lane * 4), s1 = *(const f32x4*)(sc_ + q * 256 + lane * 4); gm[q] = g * (s1 + 1.f); shv[q] = *(const f32x4*)(sh_ + q * 256 + lane * 4); } }
            const float rs = half ? rsb : rsa;
#pragma unroll
            for (int q = 0; q < 4; ++q) { const f32x4 o = ((half ? vb[q] : va[q]) * rs) * gm[q] + shv[q];
                *(u32x2*)(WSP(bf16, WS_A) + (size_t)rr * DM + q * 256 + lane * 4) = (u32x2){pk2(o.x, o.y), pk2(o.z, o.w)}; }
        }
    }
}

__device__ __forceinline__ void phase_post_a(const P& p, int wv, int bid, int nb) {
    const int tid = otid(wv), hw = (bid * 512 + tid) >> 5, nhw = nb * 16, l = tid & 31;
    const f32x2* cs = WSP(const f32x2, WS_ROPE128);
    for (int it = hw; it < T * 10; it += nhw) {
        const int r = it / 10, h = it - r * 10; int b, j; row_info(r, b, j);
        bf16* ptr = WSP(bf16, WS_QKV) + (size_t)r * A_NQKV + h * 128 + l * 4;
        const u32x2 raw = *(const u32x2*)ptr; float x[4] = {bflo(raw.x), bfhi(raw.x), bflo(raw.y), bfhi(raw.y)};
        float ss = x[0] * x[0] + x[1] * x[1] + x[2] * x[2] + x[3] * x[3];
#pragma unroll
        for (int o = 1; o < 32; o <<= 1) ss += __shfl_xor(ss, o);
        const float rs = rsqrtf(ss * (1.f / 128.f) + EPS);
        const float* w = (h < 8 ? p.in[10] : p.in[11]) + l * 4;
#pragma unroll
        for (int e = 0; e < 4; ++e) x[e] = x[e] * rs * w[e];
        float y[4];
        if (j >= NCTX) {
            const int s = j - NCTX, pos = (l < 16) ? (s / GRIDW) : (s % GRIDW);
            const bool second = (l & 8) != 0;
#pragma unroll
            for (int e = 0; e < 4; ++e) { const float o = __shfl_xor(x[e], 8); const int f = ((l & 7) * 4 + e); const f32x2 c = cs[pos * 32 + f];
                y[e] = second ? (x[e] * c.x + o * c.y) : (x[e] * c.x - o * c.y); }
        } else {
#pragma unroll
            for (int e = 0; e < 4; ++e) y[e] = x[e];
        }
        *(u32x2*)ptr = (u32x2){pk2(y[0], y[1]), pk2(y[2], y[3])};
    }
}
__device__ __forceinline__ void phase_post_b1(const P& p, int wv, int bid, int nb) {
    const int tid = otid(wv), lane = tid & 63, gw = bid * 8 + (tid >> 6), ngw = nb * 8;
    const f32x2* cs = WSP(const f32x2, WS_ROPE64);
    for (int r = gw; r < T; r += ngw) {
        int b, j; row_info(r, b, j);
        const bf16* d = WSP(const bf16, WS_DOWN) + (size_t)r * B_NDOWN_P;
        float q[6], kv[4];
        float s1 = 0.f, s2 = 0.f;
#pragma unroll
        for (int i = 0; i < 6; ++i) { q[i] = bf2f(d[i * 64 + lane]); s1 += q[i] * q[i]; }
#pragma unroll
        for (int i = 0; i < 4; ++i) { kv[i] = bf2f(d[384 + i * 64 + lane]); s2 += kv[i] * kv[i]; }
        float kr = bf2f(d[640 + lane]);
        const float r1 = rsqrtf(wave_sum(s1) * (1.f / 384.f) + EPS), r2 = rsqrtf(wave_sum(s2) * (1.f / 256.f) + EPS);
#pragma unroll
        for (int i = 0; i < 6; ++i) WSP(bf16, WS_DQN)[(size_t)r * B_QL + i * 64 + lane] = (bf16)f2bf(q[i] * r1 * p.in[14][i * 64 + lane]);
#pragma unroll
        for (int i = 0; i < 4; ++i) WSP(bf16, WS_DKVN)[(size_t)r * B_KVL + i * 64 + lane] = (bf16)f2bf(kv[i] * r2 * p.in[15][i * 64 + lane]);
        if (j >= NCTX) {
            const int s = j - NCTX, pos = (lane < 32) ? (s / GRIDW) : (s % GRIDW); const float o = __shfl_xor(kr, 16); const f32x2 c = cs[pos * 16 + (lane & 15)];
            kr = (lane & 16) ? (kr * c.x + o * c.y) : (kr * c.x - o * c.y);
        }
        const bf16 krb = (bf16)f2bf(kr);
#pragma unroll
        for (int h = 0; h < 8; ++h) WSP(bf16, WS_KB)[(size_t)r * 1536 + h * 192 + 128 + lane] = krb;
    }
}
__device__ __forceinline__ void phase_rope64(const P& p, int wv, int bid, int nb, bf16* buf, int ld, int nh, int hs, int off) {
    const int tid = otid(wv), lane = tid & 63, gw = bid * 8 + (tid >> 6), ngw = nb * 8;
    const f32x2* cs = WSP(const f32x2, WS_ROPE64);
    for (int r = gw; r < T; r += ngw) {
        int b, j; row_info(r, b, j); if (j < NCTX) continue;
        const int s = j - NCTX, pos = (lane < 32) ? (s / GRIDW) : (s % GRIDW); const f32x2 c = cs[pos * 16 + (lane & 15)];
        for (int h = 0; h < nh; ++h) { bf16* q = buf + (size_t)r * ld + h * hs + off + lane; const float x = bf2f(*q), o = __shfl_xor(x, 16);
            *q = (bf16)f2bf((lane & 16) ? (x * c.x + o * c.y) : (x * c.x - o * c.y)); }
    }
}

__device__ __forceinline__ void phase_sgu_simple(const P& p, int wv, int bid, int nb, unsigned char* lds_) {
    LAS unsigned char* lds = (LAS unsigned char*)lds_;
    const int tid = otid(wv), lane = tid & 63, wave = tid >> 6;
    LAS float* mean = (LAS float*)lds; LAS float* rstd = mean + 128; LAS float* vl = (LAS float*)(lds + 1024);
    const bf16* U = WSP(const bf16, WS_QKV); const bf16* V = WSP(const bf16, WS_KB); bf16* Mo = WSP(bf16, WS_VB);
    const float* Wsp = p.in[22]; const float* bsp = p.in[23];
    for (int ch = bid; ch < T / 128; ch += nb) {
        const int row0 = ch * 128;
        __syncthreads();
        for (int rr = wave; rr < 128; rr += 8) { const bf16* vr = V + (size_t)(row0 + rr) * DM; float x[16]; float s = 0.f;
#pragma unroll
            for (int i = 0; i < 16; ++i) { x[i] = bf2f(vr[i * 64 + lane]); s += x[i]; }
            const float mu = wave_sum(s) * (1.f / 1024.f); float q = 0.f;
#pragma unroll
            for (int i = 0; i < 16; ++i) { const float d = x[i] - mu; q += d * d; }
            const float var = wave_sum(q) * (1.f / 1024.f);
            if (lane == 0) { mean[rr] = mu; rstd[rr] = rsqrtf(var + EPS); } }
        for (int g = 0; g < 8; ++g) {
            __syncthreads();
            for (int i = tid; i < 128 * 128; i += 512) { const int q = i >> 7, c = i & 127, col = g * 128 + c;
                const float x = bf2f(V[(size_t)(row0 + q) * DM + col]); vl[i] = bf2f(f2bf((x - mean[q]) * rstd[q] * p.in[20][col] + p.in[21][col])); }
            __syncthreads();
            const int pp = tid >> 2, c0 = (tid & 3) * 32;
            float acc[32];
#pragma unroll
            for (int i = 0; i < 32; ++i) acc[i] = 0.f;
            const float* wrow = Wsp + ((size_t)g * 128 + pp) * 128;
            for (int q = 0; q < 128; ++q) { const float w = bf2f(f2bf(wrow[q]));
#pragma unroll
                for (int i = 0; i < 32; ++i) acc[i] += w * vl[q * 128 + c0 + i]; }
            const float bb = bsp[g * 128 + pp];
#pragma unroll
            for (int i = 0; i < 32; ++i) { const size_t o = (size_t)(row0 + pp) * DM + g * 128 + c0 + i; Mo[o] = (bf16)f2bf(bf2f(U[o]) * (acc[i] + bb)); }
        }
    }
}

__device__ __forceinline__ void phase_sgu(const P& p, int wv, int bid, int nb, unsigned char* lds_) {
    using f32x16 = __attribute__((ext_vector_type(16))) float;
    LAS unsigned char* lds = (LAS unsigned char*)lds_;
    const int tid = otid(wv), lane = tid & 63, wave = tid >> 6, r32 = lane & 31, hi = lane >> 5;
    constexpr int VT_ROW = 272, VT_BYTES = 128 * VT_ROW;
    LAS unsigned char* vT = lds; LAS unsigned char* oT = lds + 2 * VT_BYTES;
    const bf16* U = WSP(const bf16, WS_QKV); const bf16* V = WSP(const bf16, WS_KB); bf16* Mo = WSP(bf16, WS_VB);
    const bf16* Wsp = WSP(const bf16, W_SP); const float* bsp = p.in[23]; const float* lng = p.in[20]; const float* lnb = p.in[21];
    const int pb = wave & 3, cbh = wave >> 2;
    const int sq = tid >> 2, sc0 = (tid & 3) * 32;
    const int nch = T / 128, nfull = (nch / nb) * nb, ntail = (nch - nfull) * 8;
    for (int ui = bid; ui < nfull + ntail; ui += nb) {
        int ch, g0, g1; if (ui < nfull) { ch = ui; g0 = 0; g1 = 8; } else { ch = nfull + ((ui - nfull) >> 3); g0 = (ui - nfull) & 7; g1 = g0 + 1; }
        const int row0 = ch * 128;
        const bf16* vrow = V + (size_t)(row0 + sq) * DM; const bf16* urow = U + (size_t)(row0 + sq) * DM; bf16* mrow = Mo + (size_t)(row0 + sq) * DM;
        float s1 = 0.f, s2 = 0.f;
#pragma unroll
        for (int hb = 0; hb < 2; ++hb) { u32x4 w[16];
#pragma unroll
            for (int j = 0; j < 16; ++j) w[j] = *(const u32x4*)(vrow + (tid & 3) * 256 + hb * 128 + j * 8);
#pragma unroll
            for (int j = 0; j < 16; ++j) { const float x0 = bflo(w[j].x), x1 = bfhi(w[j].x), x2 = bflo(w[j].y), x3 = bfhi(w[j].y), x4 = bflo(w[j].z), x5 = bfhi(w[j].z), x6 = bflo(w[j].w), x7 = bfhi(w[j].w);
                s1 += ((x0 + x1) + (x2 + x3)) + ((x4 + x5) + (x6 + x7)); s2 += ((x0 * x0 + x1 * x1) + (x2 * x2 + x3 * x3)) + ((x4 * x4 + x5 * x5) + (x6 * x6 + x7 * x7)); } }
        s1 += __shfl_xor(s1, 1); s2 += __shfl_xor(s2, 1); s1 += __shfl_xor(s1, 2); s2 += __shfl_xor(s2, 2);
        const float mq = s1 * (1.f / 1024.f), rq = rsqrtf(fmaxf(s2 * (1.f / 1024.f) - mq * mq, 0.f) + EPS);
        u32x4 vreg[4], ureg[4];
#pragma unroll
        for (int j = 0; j < 4; ++j) { vreg[j] = *(const u32x4*)(vrow + g0 * 128 + sc0 + j * 8); ureg[j] = *(const u32x4*)(urow + g0 * 128 + sc0 + j * 8); }
#pragma unroll 1
        for (int g = g0; g < g1; ++g) {
            LAS unsigned char* buf = vT + (g & 1) * VT_BYTES;
            { const float* gg = lng + g * 128 + sc0; const float* gb = lnb + g * 128 + sc0;
#pragma unroll
              for (int j = 0; j < 4; ++j) { const u32x4 w = vreg[j]; const f32x4 ga = *(const f32x4*)(gg + j * 8), gc = *(const f32x4*)(gg + j * 8 + 4), ba = *(const f32x4*)(gb + j * 8), bc = *(const f32x4*)(gb + j * 8 + 4);
                  const float xv[8] = {bflo(w.x), bfhi(w.x), bflo(w.y), bfhi(w.y), bflo(w.z), bfhi(w.z), bflo(w.w), bfhi(w.w)}; const float gv[8] = {ga.x, ga.y, ga.z, ga.w, gc.x, gc.y, gc.z, gc.w}; const float bv[8] = {ba.x, ba.y, ba.z, ba.w, bc.x, bc.y, bc.z, bc.w};
#pragma unroll
                  for (int e = 0; e < 8; ++e) *(LAS bf16*)(buf + (sc0 + j * 8 + e) * VT_ROW + sq * 2) = (bf16)f2bf((xv[e] - mq) * rq * gv[e] + bv[e]); } }
            const u32x4 u0 = ureg[0], u1 = ureg[1], u2 = ureg[2], u3 = ureg[3];
            if (g + 1 < g1) {
#pragma unroll
                for (int j = 0; j < 4; ++j) { vreg[j] = *(const u32x4*)(vrow + (g + 1) * 128 + sc0 + j * 8); ureg[j] = *(const u32x4*)(urow + (g + 1) * 128 + sc0 + j * 8); } }
            bf16x8 af[8];
            { const bf16* wr = Wsp + ((size_t)g * 128 + pb * 32 + r32) * 128 + hi * 8;
#pragma unroll
              for (int ks = 0; ks < 8; ++ks) af[ks] = *(const bf16x8*)(wr + ks * 16); }
            float bias[16];
#pragma unroll
            for (int r = 0; r < 16; ++r) bias[r] = bsp[g * 128 + pb * 32 + (r & 3) + 8 * (r >> 2) + 4 * hi];
            __syncthreads();
#pragma unroll
            for (int t = 0; t < 2; ++t) { f32x16 acc = f32x16{}; const LAS unsigned char* br = buf + ((cbh * 2 + t) * 32 + r32) * VT_ROW + hi * 16;
#pragma unroll
                for (int ks = 0; ks < 8; ++ks) { const bf16x8 bfr = *(const LAS bf16x8*)(br + ks * 32); acc = __builtin_amdgcn_mfma_f32_32x32x16_bf16(af[ks], bfr, acc, 0, 0, 0); }
#pragma unroll
                for (int r = 0; r < 16; ++r) { const int pr = pb * 32 + (r & 3) + 8 * (r >> 2) + 4 * hi; *(LAS bf16*)(oT + pr * VT_ROW + ((cbh * 2 + t) * 32 + r32) * 2) = (bf16)f2bf(acc[r] + bias[r]); } }
            __syncthreads();
            { const u32x4 uu[4] = {u0, u1, u2, u3};
#pragma unroll
              for (int j = 0; j < 4; ++j) { const u32x4 mx = *(const LAS u32x4*)(oT + sq * VT_ROW + (sc0 + j * 8) * 2); u32x4 o;
                  o.x = pk2(bflo(uu[j].x) * bflo(mx.x), bfhi(uu[j].x) * bfhi(mx.x)); o.y = pk2(bflo(uu[j].y) * bflo(mx.y), bfhi(uu[j].y) * bfhi(mx.y));
                  o.z = pk2(bflo(uu[j].z) * bflo(mx.z), bfhi(uu[j].z) * bfhi(mx.z)); o.w = pk2(bflo(uu[j].w) * bflo(mx.w), bfhi(uu[j].w) * bfhi(mx.w));
                  *(u32x4*)(mrow + g * 128 + sc0 + j * 8) = o; } }
        }
        __syncthreads();
    }
}

namespace pg8 {
constexpr int BM = 256, BK = 64, HALF = 128, HTB = HALF * BK * 2, STAGE_BYTES = 8 * HTB, NXCD = 8, WGM = 4;
__host__ __device__ __forceinline__ int lds_byte(int r, int c) { const int st = (r >> 4) * 2 + (c >> 5), rr = r & 15, cc = c & 31, ob = rr * 64 + cc * 2; return st * 1024 + (ob ^ (((ob >> 9) & 1) << 5)); }
__host__ __device__ __forceinline__ void stage_rc(int b, int& R, int& C) { const int st = b / 1024, sb = b % 1024, swz = sb ^ (((sb >> 9) & 1) << 5); R = (st >> 1) * 16 + swz / 64; C = (st & 1) * 32 + (swz % 64) / 2; }
__host__ __device__ __forceinline__ int perm32(int rho) { const int n = rho >> 4, i = rho & 15; return 8 * (i >> 2) + 4 * n + (i & 3); }
struct Unit { int pm, pn, e, sub; };
struct Sched {
    int nM, nN, nwg, G, c; const LAS int* tl; int grouped, part, skipctx;
    __device__ __forceinline__ void init(int nM_, int nN_, int G_, int c_, const LAS int* tl_, int grouped_, int part_ = 0, int skipctx_ = 0) { nM = nM_; nN = nN_; nwg = nM * nN; G = G_; c = c_; tl = tl_; grouped = grouped_; part = part_; skipctx = skipctx_; }
    __device__ __forceinline__ bool next(int i, Unit& u) const {
        long L = (long)i * G + c; int sub = 0;
        const int full = (nwg / G) * G, R = nwg - full;
        if (part == 1 && L >= full) return false;
        if (part == 2) { if (i > 0 || R == 0) return false;
            if (4 * R <= G) { const int uu = (c >> 5) * 8 + (c & 7); if (uu >= R) return false; L = full + uu; sub = 1 + ((c >> 3) & 3); }
            else { if (c >= R) return false; L = full + c; } }
        if (L >= nwg) return false;
        int wgid = (int)L; { const int q = nwg / NXCD, r = nwg % NXCD, xcd = wgid % NXCD, off = wgid / NXCD; wgid = (xcd < r ? xcd * (q + 1) : r * (q + 1) + (xcd - r) * q) + off; }
        const int nig = WGM * nN, gid = wgid / nig, fm = gid * WGM, gsz = (nM - fm) < WGM ? (nM - fm) : WGM;
        u.pm = fm + ((wgid % nig) % gsz); u.pn = (wgid % nig) / gsz; int e = 0;
        if (grouped) {
#pragma unroll
            for (int x = 1; x < 8; ++x) e += (u.pm >= tl[x]) ? 1 : 0; }
        if (skipctx) u.pm = u.pm + (u.pm >> 5) + 1;
        u.e = e; u.sub = sub; return true;
    }
};
__device__ __forceinline__ unsigned cvt_pk_bf16(float lo, float hi) { unsigned r; asm volatile("v_cvt_pk_bf16_f32 %0, %1, %2" : "=v"(r) : "v"(lo), "v"(hi)); return r; }
__device__ __forceinline__ f32x2 gelu_pk(f32x2 v) {
    const f32x2 av = __builtin_elementwise_abs(v), d = av * 0.2316418882f + 1.0f;
    f32x2 t; t.x = __builtin_amdgcn_rcpf(d.x); t.y = __builtin_amdgcn_rcpf(d.y);
    f32x2 q = t * 0.5307027145f + (-0.7265760135f); q = q * t + 0.7107068705f; q = q * t + (-0.142248368f); q = q * t + 0.127414796f; q = q * t;
    const f32x2 s = (v * v) * (-0.72134752044f);
    f32x2 e; e.x = __builtin_amdgcn_exp2f(s.x); e.y = __builtin_amdgcn_exp2f(s.y);
    const f32x2 m = v * (q * e), r = v - m;
    f32x2 o; o.x = v.x < 0.f ? m.x : r.x; o.y = v.y < 0.f ? m.y : r.y; return o;
}
typedef f32x4 Acc[2][2][4][2];
__device__ __forceinline__ u32x4 pack8(f32x4 v0, f32x4 v1) { u32x4 w; w.x = cvt_pk_bf16(v0[0], v0[1]); w.y = cvt_pk_bf16(v0[2], v0[3]); w.z = cvt_pk_bf16(v1[0], v1[1]); w.w = cvt_pk_bf16(v1[2], v1[3]); return w; }
template <int ROPE>
struct EpiStoreT {
    static constexpr bool PERM = true;
    bf16* O; int ld; const f32x2* cs;
    __device__ __forceinline__ void operator()(const Acc& acc, const Unit& u, int wr, int wc, int fr, int fq) const {
        const int row0 = u.pm * BM + wr * 64 + fr, col0 = u.pn * BM + wc * 32 + 8 * fq;
        const int tb = (u.pm * BM) / RPB, tj = u.pm * BM - tb * RPB; const bool lat = tj >= NCTX;
#pragma unroll
        for (int ai = 0; ai < 2; ++ai)
#pragma unroll
            for (int m = 0; m < 4; ++m) { const int row = row0 + ai * HALF + m * 16; bf16* rowp = O + (size_t)row * ld + col0;
                const int spos = row - tb * RPB - NCTX;
#pragma unroll
                for (int bj = 0; bj < 2; ++bj) { if (SUB_SKIP(u, ai, bj)) continue;
                    f32x4 v0 = acc[ai][bj][m][0], v1 = acc[ai][bj][m][1];
                    if constexpr (ROPE != 0) {
                        const int slab = u.pn * 8 + bj * 4 + wc; bool rot; int axis;
                        if (ROPE == 1) { const int sm = slab % 6; rot = sm >= 4; axis = sm - 4; } else { rot = slab < 36; axis = slab & 1; }
                        if (rot && lat) {
                            const int pos = axis ? (spos & (GRIDW - 1)) : (spos / GRIDW); const f32x2* c = cs + pos * 16 + 8 * (fq & 1);
                            const f32x4 c0 = *(const f32x4*)(c), c1 = *(const f32x4*)(c + 2), c2 = *(const f32x4*)(c + 4), c3 = *(const f32x4*)(c + 6);
                            const float cc[8] = {c0.x, c0.z, c1.x, c1.z, c2.x, c2.z, c3.x, c3.z}, sn[8] = {c0.y, c0.w, c1.y, c1.w, c2.y, c2.w, c3.y, c3.w};
                            const float sg = (fq & 2) ? 1.f : -1.f;
                            float x[8] = {v0[0], v0[1], v0[2], v0[3], v1[0], v1[1], v1[2], v1[3]};
#pragma unroll
                            for (int e = 0; e < 8; ++e) { const auto rr = __builtin_amdgcn_permlane32_swap(__float_as_uint(x[e]), __float_as_uint(x[e]), false, false);
                                const float o = __uint_as_float((fq & 2) ? rr[0] : rr[1]); x[e] = x[e] * cc[e] + sg * o * sn[e]; }
                            v0 = (f32x4){x[0], x[1], x[2], x[3]}; v1 = (f32x4){x[4], x[5], x[6], x[7]};
                        }
                    }
                    *(u32x4*)(rowp + bj * HALF) = pack8(v0, v1); } }
    }
};
typedef EpiStoreT<0> EpiStore;
struct EpiKV {
    static constexpr bool PERM = true;
    bf16* Kb; bf16* Vb;
    __device__ __forceinline__ void operator()(const Acc& acc, const Unit& u, int wr, int wc, int fr, int fq) const {
        const int row0 = u.pm * BM + wr * 64 + fr, c0 = wc * 32 + 8 * fq;
#pragma unroll
        for (int ai = 0; ai < 2; ++ai)
#pragma unroll
            for (int m = 0; m < 4; ++m) { const size_t r = (size_t)(row0 + ai * HALF + m * 16);
                if (!SUB_SKIP(u, ai, 0)) *(u32x4*)(Kb + r * 1536 + u.pn * 192 + c0) = pack8(acc[ai][0][m][0], acc[ai][0][m][1]);
                if (!SUB_SKIP(u, ai, 1)) *(u32x4*)(Vb + r * DM + u.pn * 128 + c0) = pack8(acc[ai][1][m][0], acc[ai][1][m][1]); }
    }
};
struct EpiGelu {
    static constexpr bool PERM = true;
    bf16* U; bf16* V;
    __device__ __forceinline__ void operator()(const Acc& acc, const Unit& u, int wr, int wc, int fr, int fq) const {
        const int row0 = u.pm * BM + wr * 64 + fr; bf16* base = u.pn < 4 ? U : V; const int col0 = (u.pn & 3) * BM + wc * 32 + 8 * fq;
#pragma unroll
        for (int ai = 0; ai < 2; ++ai)
#pragma unroll
            for (int m = 0; m < 4; ++m) { bf16* rowp = base + (size_t)(row0 + ai * HALF + m * 16) * DM + col0;
#pragma unroll
                for (int bj = 0; bj < 2; ++bj) { if (SUB_SKIP(u, ai, bj)) continue; const f32x4 v0 = acc[ai][bj][m][0], v1 = acc[ai][bj][m][1];
                    const f32x2 a = gelu_pk((f32x2){v0[0], v0[1]}), b = gelu_pk((f32x2){v0[2], v0[3]}), c = gelu_pk((f32x2){v1[0], v1[1]}), d = gelu_pk((f32x2){v1[2], v1[3]});
                    *(u32x4*)(rowp + bj * HALF) = pack8((f32x4){a.x, a.y, b.x, b.y}, (f32x4){c.x, c.y, d.x, d.y}); } }
    }
};
struct EpiSwiglu {
    static constexpr bool PERM = true;
    bf16* O; int ld;
    __device__ __forceinline__ void operator()(const Acc& acc, const Unit& u, int wr, int wc, int fr, int fq) const {
        const int rl0 = wr * 64 + fr, nkt = ld >> 6;
        bf16* base = O + ((size_t)u.pm * nkt + (u.pn * 2 + (wc >> 1))) * (BM * BK) + (wc & 1) * 32 + 8 * fq;
#pragma unroll
        for (int ai = 0; ai < 2; ++ai)
#pragma unroll
            for (int m = 0; m < 4; ++m) { f32x4 o[2];
#pragma unroll
                for (int n = 0; n < 2; ++n) { const f32x4 a = acc[ai][0][m][n], b = acc[ai][1][m][n];
#pragma unroll
                    for (int k = 0; k < 4; ++k) o[n][k] = a[k] * __builtin_amdgcn_rcpf(1.f + __builtin_amdgcn_exp2f(-1.4426950408889634f * a[k])) * b[k]; }
                *(u32x4*)(base + (size_t)(rl0 + ai * HALF + m * 16) * BK) = pack8(o[0], o[1]); }
    }
};
struct EpiResid {
    static constexpr bool PERM = true;
    const float* x; const float* ctx; unsigned char* ws; int layer, chunk, from_in;
    __device__ __forceinline__ void operator()(const Acc& acc, const Unit& u, int wr, int wc, int fr, int fq) const {
        P p; p.in[0] = x; p.in[2] = ctx; p.ws = ws;
        const int r0 = u.pm * BM; const float* gate = mod_vec(p, layer, r0, chunk);
        const float* xin0 = in_row(p, r0); bf16* h0 = (bf16*)(ws + WS_H) + (size_t)r0 * DM;
        const int rl0 = wr * 64 + fr, col0 = u.pn * BM + wc * 32 + 8 * fq;
        f32x4 g0v[2], g1v[2];
#pragma unroll
        for (int bj = 0; bj < 2; ++bj) { g0v[bj] = *(const f32x4*)(gate + col0 + bj * HALF); g1v[bj] = *(const f32x4*)(gate + col0 + bj * HALF + 4); }
        u32x4 nx[2] = {(u32x4){0u, 0u, 0u, 0u}, (u32x4){0u, 0u, 0u, 0u}};
        if (!from_in) {
#pragma unroll
            for (int bj = 0; bj < 2; ++bj) { if (SUB_SKIP(u, 0, bj)) continue; nx[bj] = *(const u32x4*)(h0 + (size_t)rl0 * DM + col0 + bj * HALF); } }
#pragma unroll
        for (int it = 0; it < 8; ++it) { const int ai = it >> 2, m = it & 3; const size_t off = (size_t)(rl0 + ai * HALF + m * 16) * DM + col0;
            const u32x4 cu0 = nx[0], cu1 = nx[1];
            if (!from_in && it + 1 < 8) { const int ai2 = (it + 1) >> 2, m2 = (it + 1) & 3; const size_t off2 = (size_t)(rl0 + ai2 * HALF + m2 * 16) * DM + col0;
#pragma unroll
                for (int bj = 0; bj < 2; ++bj) { if (SUB_SKIP(u, ai2, bj)) continue; nx[bj] = *(const u32x4*)(h0 + off2 + bj * HALF); } }
#pragma unroll
            for (int bj = 0; bj < 2; ++bj) { if (SUB_SKIP(u, ai, bj)) continue; const f32x4 g0 = g0v[bj], g1 = g1v[bj]; f32x4 s0, s1;
                if (from_in) { s0 = *(const f32x4*)(xin0 + off + bj * HALF); s1 = *(const f32x4*)(xin0 + off + bj * HALF + 4); }
                else { const u32x4 w = bj ? cu1 : cu0; s0 = (f32x4){bflo(w.x), bfhi(w.x), bflo(w.y), bfhi(w.y)}; s1 = (f32x4){bflo(w.z), bfhi(w.z), bflo(w.w), bfhi(w.w)}; }
                *(u32x4*)(h0 + off + bj * HALF) = pack8(s0 + g0 * acc[ai][bj][m][0], s1 + g1 * acc[ai][bj][m][1]); }
            asm volatile("" ::: "memory"); }
    }
};

template <class Epi, bool GATHER, int K, bool SUB = false, bool ATILE = false, bool BTILE = false>
__device__ __forceinline__ void gemm_phase(int wv, LAS unsigned char* lds, const bf16* A, const bf16* Bt, size_t bstride, const Sched& S, const Epi& E, const LAS unsigned short* gtab) {
    const int tid = otid(wv), wid = __builtin_amdgcn_readfirstlane(tid >> 6), lane = tid & 63, wr = wid >> 2, wc = wid & 3, fr = lane & 15, fq = lane >> 4;
    constexpr int nt = K / BK;
    unsigned voffA[2], voffB[2]; int RA[2], CA[2];
#pragma unroll
    for (int i = 0; i < 2; ++i) { int R, C; stage_rc(tid * 16 + i * 8192, R, C); const int Rb = Epi::PERM ? ((R & ~31) + perm32(R & 31)) : R;
        RA[i] = R; CA[i] = C; voffA[i] = (unsigned)(R * (ATILE ? BK : K) + C) * 2u; voffB[i] = (unsigned)(Rb * (BTILE ? BK : K) + C) * 2u; }
    constexpr size_t kstepA = ATILE ? (size_t)BM * BK * 2 : (size_t)(BK * 2), hstepA = ATILE ? (size_t)HALF * BK * 2 : (size_t)HALF * K * 2, tstepA = (size_t)BM * K * 2;
    constexpr size_t kstepB = BTILE ? (size_t)BM * BK * 2 : (size_t)(BK * 2), hstepB = BTILE ? (size_t)HALF * BK * 2 : (size_t)HALF * K * 2, tstepB = (size_t)BM * K * 2;
    const unsigned ldsw = (unsigned)wid * 1024u;
    const int aoff = lds_byte(wr * 64 + fr, fq * 8), boff = lds_byte(wc * 32 + fr, fq * 8);
    const char* Ab = (const char*)A;
    unsigned cg[2][2], ng[2][2];
#define PG8_SA(b, h) (((b) * 2 + (h)) * HTB)
#define PG8_SB(b, h) ((4 + (b) * 2 + (h)) * HTB)
#define PG8_GLDS(gp, bufoff, i) __builtin_amdgcn_global_load_lds((const unsigned*)(gp), (LAS unsigned*)(lds + (bufoff) + ldsw + (i) * 8192), 16, 0, 0)
#define PG8_STAGE_B(bufoff, gbase) do { _Pragma("unroll") for (int _i = 0; _i < 2; ++_i) PG8_GLDS((const char*)(gbase) + voffB[_i], bufoff, _i); } while (0)
#define PG8_STAGE_A(bufoff, nxtsel, h, kt) do { \
        if constexpr (GATHER) { const char* _b = Ab + (size_t)(kt) * kstepA; _Pragma("unroll") for (int _i = 0; _i < 2; ++_i) { const unsigned _o = (nxtsel) ? ng[h][_i] : cg[h][_i]; PG8_GLDS(_b + _o, bufoff, _i); } } \
        else { const char* _b = ((nxtsel) ? nA : cA) + (size_t)(h) * hstepA + (size_t)(kt) * kstepA; _Pragma("unroll") for (int _i = 0; _i < 2; ++_i) PG8_GLDS(_b + voffA[_i], bufoff, _i); } } while (0)
#define PG8_LDA(dst, b, h) do { _Pragma("unroll") for (int m = 0; m < 4; ++m) _Pragma("unroll") for (int k = 0; k < 2; ++k) dst[m][k] = *(const LAS bf16x8*)(lds + PG8_SA(b, h) + aoff + m * 2048 + k * 1024); } while (0)
#define PG8_LDB(dst, b, h) do { _Pragma("unroll") for (int n = 0; n < 2; ++n) _Pragma("unroll") for (int k = 0; k < 2; ++k) dst[n][k] = *(const LAS bf16x8*)(lds + PG8_SB(b, h) + boff + n * 2048 + k * 1024); } while (0)
#define PG8_MMA(ai, bj, At, Bt_) do { if constexpr (SUB) { if (csub != 0 && csub != 1 + (ai) * 2 + (bj)) break; } __builtin_amdgcn_s_setprio(1); _Pragma("unroll") for (int m = 0; m < 4; ++m) _Pragma("unroll") for (int n = 0; n < 2; ++n) _Pragma("unroll") for (int k = 0; k < 2; ++k) \
        acc[ai][bj][m][n] = __builtin_amdgcn_mfma_f32_16x16x32_bf16(Bt_[n][k], At[m][k], acc[ai][bj][m][n], 0, 0, 0); __builtin_amdgcn_s_setprio(0); } while (0)
#define PG8_WAIT_V(n) asm volatile("s_waitcnt vmcnt(" #n ")" ::: "memory")
#define PG8_WAIT_L(n) asm volatile("s_waitcnt lgkmcnt(" #n ")" ::: "memory")
#define PG8_BAR __builtin_amdgcn_s_barrier()
#define PG8_SCHED __builtin_amdgcn_sched_barrier(0)
#define PG8_GOFF(dst, ui_) do { _Pragma("unroll") for (int _h = 0; _h < 2; ++_h) _Pragma("unroll") for (int _i = 0; _i < 2; ++_i) \
        dst[_h][_i] = ((unsigned)gtab[(ui_) * 256 + _h * HALF + RA[_i]] * (unsigned)K + (unsigned)CA[_i]) * 2u; } while (0)
    Unit cur, nxt; int ui = 0;
    if (!S.next(0, cur)) return;
    f32x4 acc[2][2][4][2];
#pragma unroll
    for (int a = 0; a < 2; ++a)
#pragma unroll
        for (int b = 0; b < 2; ++b)
#pragma unroll
            for (int m = 0; m < 4; ++m)
#pragma unroll
                for (int n = 0; n < 2; ++n) acc[a][b][m][n] = (f32x4){0.f, 0.f, 0.f, 0.f};
    bf16x8 At[4][2], B0[2][2], B1[2][2];
    const char* cA = Ab + (size_t)cur.pm * tstepA; const char* cB = (const char*)(Bt + (size_t)cur.e * bstride) + (size_t)cur.pn * tstepB;
    const char* nA = cA; int csub = cur.sub;
    if constexpr (GATHER) { PG8_GOFF(cg, 0); PG8_GOFF(ng, 0); }
    PG8_STAGE_B(PG8_SB(0, 0), cB); PG8_STAGE_B(PG8_SB(0, 1), cB + hstepB); PG8_STAGE_A(PG8_SA(0, 0), false, 0, 0); PG8_STAGE_A(PG8_SA(0, 1), false, 1, 0);
    if (wr == 1) PG8_BAR;
    PG8_WAIT_V(2); PG8_BAR;
    PG8_STAGE_B(PG8_SB(1, 0), cB + kstepB); PG8_STAGE_A(PG8_SA(1, 0), false, 0, 1); PG8_STAGE_B(PG8_SB(1, 1), cB + hstepB + kstepB);
    PG8_WAIT_V(6); PG8_BAR;
    for (;;) {
        const bool has_next = S.next(ui + 1, nxt);
        nA = has_next ? Ab + (size_t)nxt.pm * tstepA : cA; const char* nB = has_next ? (const char*)(Bt + (size_t)nxt.e * bstride) + (size_t)nxt.pn * tstepB : cB;
        if constexpr (GATHER) { if (has_next) PG8_GOFF(ng, ui + 1); else { _Pragma("unroll") for (int _h = 0; _h < 2; ++_h) _Pragma("unroll") for (int _i = 0; _i < 2; ++_i) ng[_h][_i] = cg[_h][_i]; } }
#pragma nounroll
        for (int t = 0; t < nt; t += 2) {
            const bool last = (t == nt - 2);
            const int t1 = t + 1, t2 = last ? 0 : t + 2, t3 = t2 + 1;
            const char* b2 = (last ? nB : cB) + (size_t)t2 * kstepB; const char* b3 = b2 + kstepB;
            PG8_LDB(B0, 0, 0); PG8_LDB(B1, 0, 1); PG8_SCHED; PG8_LDA(At, 0, 0); PG8_STAGE_A(PG8_SA(1, 1), false, 1, t1);
            PG8_WAIT_V(8); PG8_WAIT_L(0); PG8_BAR; PG8_MMA(0, 0, At, B0); PG8_MMA(0, 1, At, B1); PG8_BAR; PG8_SCHED;
            PG8_LDA(At, 0, 1); PG8_STAGE_B(PG8_SB(0, 0), b2); PG8_STAGE_B(PG8_SB(0, 1), b2 + hstepB); PG8_STAGE_A(PG8_SA(0, 0), last, 0, t2);
            PG8_WAIT_V(8); PG8_WAIT_L(0); PG8_BAR; PG8_MMA(1, 0, At, B0); PG8_MMA(1, 1, At, B1); PG8_BAR; PG8_SCHED;
            PG8_LDB(B0, 1, 0); PG8_LDB(B1, 1, 1); PG8_SCHED; PG8_LDA(At, 1, 0); PG8_STAGE_A(PG8_SA(0, 1), last, 1, t2);
            PG8_WAIT_V(8); PG8_WAIT_L(0); PG8_BAR; PG8_MMA(0, 0, At, B0); PG8_MMA(0, 1, At, B1); PG8_BAR; PG8_SCHED;
            PG8_LDA(At, 1, 1); PG8_STAGE_B(PG8_SB(1, 0), b3); PG8_STAGE_B(PG8_SB(1, 1), b3 + hstepB); PG8_STAGE_A(PG8_SA(1, 0), last, 0, t3);
            PG8_WAIT_V(8); PG8_WAIT_L(0); PG8_BAR; PG8_MMA(1, 0, At, B0); PG8_MMA(1, 1, At, B1); PG8_BAR; PG8_SCHED;
        }
        if (wr == 0) PG8_BAR;
        E(acc, cur, wr, wc, fr, fq);
        if (!has_next) break;
#pragma unroll
        for (int a = 0; a < 2; ++a)
#pragma unroll
            for (int b = 0; b < 2; ++b)
#pragma unroll
                for (int m = 0; m < 4; ++m)
#pragma unroll
                    for (int n = 0; n < 2; ++n) acc[a][b][m][n] = (f32x4){0.f, 0.f, 0.f, 0.f};
        cur = nxt; cA = nA; cB = nB; ++ui; csub = cur.sub;
        if constexpr (GATHER) { _Pragma("unroll") for (int _h = 0; _h < 2; ++_h) _Pragma("unroll") for (int _i = 0; _i < 2; ++_i) cg[_h][_i] = ng[_h][_i]; }
        if (wr == 1) PG8_BAR;
    }
    PG8_WAIT_V(0);
    PG8_BAR;
#undef PG8_SA
#undef PG8_SB
#undef PG8_GLDS
#undef PG8_STAGE_A
#undef PG8_STAGE_B
#undef PG8_LDA
#undef PG8_LDB
#undef PG8_MMA
#undef PG8_WAIT_V
#undef PG8_WAIT_L
#undef PG8_BAR
#undef PG8_SCHED
#undef PG8_GOFF
}

template <class Epi, int K, bool ATILE, bool BTILE>
__device__ __forceinline__ void gemm_sub_unit(int wv, LAS unsigned char* lds, const bf16* A, const bf16* Bt, size_t bstride, const Sched& S, const Epi& E) {
    Unit u; if (!S.next(0, u)) return;
    const int tid = otid(wv), wid = __builtin_amdgcn_readfirstlane(tid >> 6), lane = tid & 63, wr = wid >> 2, wc = wid & 3, fr = lane & 15, fq = lane >> 4;
    constexpr int nt = K / BK;
    unsigned voffA[2], voffB[2];
#pragma unroll
    for (int i = 0; i < 2; ++i) { int R, C; stage_rc(tid * 16 + i * 8192, R, C); const int Rb = Epi::PERM ? ((R & ~31) + perm32(R & 31)) : R;
        voffA[i] = (unsigned)(R * (ATILE ? BK : K) + C) * 2u; voffB[i] = (unsigned)(Rb * (BTILE ? BK : K) + C) * 2u; }
    constexpr size_t kstepA = ATILE ? (size_t)BM * BK * 2 : (size_t)(BK * 2), hstepA = ATILE ? (size_t)HALF * BK * 2 : (size_t)HALF * K * 2, tstepA = (size_t)BM * K * 2;
    constexpr size_t kstepB = BTILE ? (size_t)BM * BK * 2 : (size_t)(BK * 2), hstepB = BTILE ? (size_t)HALF * BK * 2 : (size_t)HALF * K * 2, tstepB = (size_t)BM * K * 2;
    const unsigned ldsw = (unsigned)wid * 1024u;
    const int aoff = lds_byte(wr * 64 + fr, fq * 8), boff = lds_byte(wc * 32 + fr, fq * 8);
#pragma nounroll
    for (int sq = (u.sub ? u.sub - 1 : 0); sq < (u.sub ? u.sub : 4); ++sq) {
    const int ai = sq >> 1, bj = sq & 1; Unit uq = u; uq.sub = sq + 1;
    const char* cA = (const char*)A + (size_t)u.pm * tstepA + (size_t)ai * hstepA;
    const char* cB = (const char*)(Bt + (size_t)u.e * bstride) + (size_t)u.pn * tstepB + (size_t)bj * hstepB;
#define SU_SA(b) ((b) * 2 * HTB)
#define SU_SB(b) ((4 + (b) * 2) * HTB)
#define SU_STAGE(b, kt) do { _Pragma("unroll") for (int _i = 0; _i < 2; ++_i) { \
        __builtin_amdgcn_global_load_lds((const unsigned*)(cA + (size_t)(kt) * kstepA + voffA[_i]), (LAS unsigned*)(lds + SU_SA(b) + ldsw + _i * 8192), 16, 0, 0); \
        __builtin_amdgcn_global_load_lds((const unsigned*)(cB + (size_t)(kt) * kstepB + voffB[_i]), (LAS unsigned*)(lds + SU_SB(b) + ldsw + _i * 8192), 16, 0, 0); } } while (0)
    f32x4 a1[4][2];
#pragma unroll
    for (int m = 0; m < 4; ++m)
#pragma unroll
        for (int n = 0; n < 2; ++n) a1[m][n] = (f32x4){0.f, 0.f, 0.f, 0.f};
#define SU_READ(At, Bf, b) do { _Pragma("unroll") for (int _m = 0; _m < 4; ++_m) { _Pragma("unroll") for (int _k = 0; _k < 2; ++_k) At[_m][_k] = *(const LAS bf16x8*)(lds + SU_SA(b) + aoff + _m * 2048 + _k * 1024); } \
        _Pragma("unroll") for (int _n = 0; _n < 2; ++_n) { _Pragma("unroll") for (int _k = 0; _k < 2; ++_k) Bf[_n][_k] = *(const LAS bf16x8*)(lds + SU_SB(b) + boff + _n * 2048 + _k * 1024); } } while (0)
#define SU_MMA(At, Bf) do { __builtin_amdgcn_s_setprio(1); _Pragma("unroll") for (int _m = 0; _m < 4; ++_m) { _Pragma("unroll") for (int _n = 0; _n < 2; ++_n) { _Pragma("unroll") for (int _k = 0; _k < 2; ++_k) \
        a1[_m][_n] = __builtin_amdgcn_mfma_f32_16x16x32_bf16(Bf[_n][_k], At[_m][_k], a1[_m][_n], 0, 0, 0); } } __builtin_amdgcn_s_setprio(0); } while (0)
#define SU_HALF(Fa, Fb, Ga, Gb, b, t2) do { \
        asm volatile("s_waitcnt lgkmcnt(0)" ::: "memory"); __builtin_amdgcn_s_barrier();        \
        SU_STAGE(b, t2); \
        asm volatile("s_waitcnt vmcnt(4)" ::: "memory"); __builtin_amdgcn_s_barrier();           \
        __builtin_amdgcn_sched_barrier(0); \
        SU_READ(Ga, Gb, (b) ^ 1); \
        __builtin_amdgcn_sched_barrier(0); \
        SU_MMA(Fa, Fb); \
        __builtin_amdgcn_sched_barrier(0); } while (0)
    bf16x8 A0[4][2], B0[2][2], A1[4][2], B1[2][2];
    SU_STAGE(0, 0); SU_STAGE(1, 1);
    asm volatile("s_waitcnt vmcnt(4)" ::: "memory"); __builtin_amdgcn_s_barrier();
    SU_READ(A0, B0, 0);
    static_assert(nt % 2 == 0, "K tiles come in pairs");
#pragma nounroll
    for (int t = 0; t < nt; t += 2) {
        { const int t2 = (t + 2 < nt) ? t + 2 : 0; SU_HALF(A0, B0, A1, B1, 0, t2); }
        { const int t3 = (t + 3 < nt) ? t + 3 : 1; SU_HALF(A1, B1, A0, B0, 1, t3); }
    }
    asm volatile("s_waitcnt vmcnt(0) lgkmcnt(0)" ::: "memory");
    __builtin_amdgcn_s_barrier();
#undef SU_READ
#undef SU_MMA
#undef SU_HALF
    f32x4 acc[2][2][4][2];
#pragma unroll
    for (int a = 0; a < 2; ++a)
#pragma unroll
        for (int bb = 0; bb < 2; ++bb)
#pragma unroll
            for (int m = 0; m < 4; ++m)
#pragma unroll
                for (int n = 0; n < 2; ++n) acc[a][bb][m][n] = a1[m][n];
    E(acc, uq, wr, wc, fr, fq);
    }
#undef SU_SA
#undef SU_SB
#undef SU_STAGE
}
}

namespace att {
using f32x16 = __attribute__((ext_vector_type(16))) float;
using s16x4 = __attribute__((ext_vector_type(4))) short;
constexpr int NW = 8, QBLK = 32, KVBLK = 64;
#define ATT_SBAR() __builtin_amdgcn_sched_barrier(0)
__device__ __forceinline__ int crow(int r, int hi) { return (r & 3) + 8 * (r >> 2) + 4 * hi; }
__device__ __forceinline__ unsigned cvtpk(float lo, float hi) { unsigned r; asm volatile("v_cvt_pk_bf16_f32 %0, %1, %2" : "=v"(r) : "v"(lo), "v"(hi)); return r; }
template <int DQK> struct Cst { static constexpr float scale() { return DQK == 128 ? 0.088388347648318440f : (DQK == 192 ? 0.072168783648703220f : 0.125f); } };
template <int DQK> __device__ __forceinline__ int kswz(int row, int colB) { constexpr int RS = DQK * 2; return row * RS + (colB ^ ((RS == 256 ? (row & 15) : ((row >> 1) & 7)) << 4)); }
template <int DV> __device__ __forceinline__ int v_st(int k, int c) { const int kk = (k & ~0xC) | ((k & 4) << 1) | ((k & 8) >> 1); return ((kk >> 3) * (DV / 32) + (c >> 5)) * 512 + ((kk & 7) * 32 + (c & 31)) * 2; }
__device__ __forceinline__ int v_rd_base(int lane) { return ((lane & 3) << 3) | (((lane >> 2) & 3) << 6) | (((lane >> 4) & 1) << 5) | (((lane >> 5) & 1) << 8); }
typedef short v4i16_t __attribute__((ext_vector_type(4)));
typedef __attribute__((address_space(3))) v4i16_t lds_v4i16_t;
template <int OFF> __device__ __forceinline__ s16x4 tr_read(int vb) { return __builtin_bit_cast(s16x4, __builtin_amdgcn_ds_read_tr16_b64_v4i16((lds_v4i16_t*)(unsigned)(vb + OFF))); }

template <int DQK, int THRI> __device__ __forceinline__ void partialSM(f32x16& p0, f32x16& p1, float& m_reg, float& mn, float& alpha) {
    constexpr float SC = Cst<DQK>::scale(), C = SC * 1.4426950408889634f, THR = (float)THRI;
    float pmax = p0[0];
#pragma unroll
    for (int r = 1; r < 16; ++r) pmax = fmaxf(pmax, p0[r]);
#pragma unroll
    for (int r = 0; r < 16; ++r) pmax = fmaxf(pmax, p1[r]);
    { auto rr = __builtin_amdgcn_permlane32_swap(__float_as_uint(pmax), __float_as_uint(pmax), false, false); pmax = fmaxf(__uint_as_float(rr[0]), __uint_as_float(rr[1])); }
    if (__builtin_expect(__all(pmax - m_reg <= THR / SC), 1)) { mn = m_reg; alpha = 1.f; }
    else { mn = fmaxf(m_reg, pmax); alpha = __builtin_amdgcn_exp2f((m_reg - mn) * C); m_reg = mn; }
    const float mnC = -mn * C;
#pragma unroll
    for (int r = 0; r < 16; ++r) p0[r] = fmaf(p0[r], C, mnC);
#pragma unroll
    for (int r = 0; r < 16; ++r) p1[r] = fmaf(p1[r], C, mnC);
#pragma unroll
    for (int r = 0; r < 16; ++r) p0[r] = __builtin_amdgcn_exp2f(p0[r]);
}
__device__ __forceinline__ void finishSM(f32x16& p0, f32x16& p1, float alpha, float& l_reg, bf16x8& pa0, bf16x8& pa1, bf16x8& pa2, bf16x8& pa3) {
#pragma unroll
    for (int r = 0; r < 16; ++r) p1[r] = __builtin_amdgcn_exp2f(p1[r]);
    float ps = 0;
#pragma unroll
    for (int r = 0; r < 16; ++r) ps += p0[r];
#pragma unroll
    for (int r = 0; r < 16; ++r) ps += p1[r];
    { auto rr = __builtin_amdgcn_permlane32_swap(__float_as_uint(ps), __float_as_uint(ps), false, false); ps = __uint_as_float(rr[0]) + __uint_as_float(rr[1]); }
    l_reg = l_reg * alpha + ps;
#define ATT_PK4(Pv, BASE, OUT) do { unsigned a0 = cvtpk(Pv[BASE + 0], Pv[BASE + 1]), a1 = cvtpk(Pv[BASE + 2], Pv[BASE + 3]); \
    unsigned b0 = cvtpk(Pv[BASE + 4], Pv[BASE + 5]), b1 = cvtpk(Pv[BASE + 6], Pv[BASE + 7]); \
    auto r0 = __builtin_amdgcn_permlane32_swap(a0, b0, false, false); auto r1 = __builtin_amdgcn_permlane32_swap(a1, b1, false, false); \
    u32x4 w = {r0[0], r1[0], r0[1], r1[1]}; OUT = *reinterpret_cast<bf16x8*>(&w); } while (0)
    ATT_PK4(p0, 0, pa0); ATT_PK4(p0, 8, pa1); ATT_PK4(p1, 0, pa2); ATT_PK4(p1, 8, pa3);
#undef ATT_PK4
}
template <int DQK, int QL> __device__ __forceinline__ void qkt(f32x16& p0, f32x16& p1, const char* Ks, const bf16x8* qr, const char* ql, const int* kb, int r32, int hi) {
    p0 = f32x16{}; p1 = f32x16{};
#pragma unroll
    for (int d0 = 0; d0 < DQK / 16; ++d0) {
        bf16x8 b0, b1;
        if constexpr (DQK == 192) { b0 = *reinterpret_cast<const bf16x8*>(Ks + kb[d0 & 3] + 128 * (d0 >> 2)); b1 = *reinterpret_cast<const bf16x8*>(Ks + kb[d0 & 3] + 128 * (d0 >> 2) + 32 * DQK * 2); }
        else { const int cb = (d0 * 16 + hi * 8) * 2; b0 = *reinterpret_cast<const bf16x8*>(Ks + kswz<DQK>(r32, cb)); b1 = *reinterpret_cast<const bf16x8*>(Ks + kswz<DQK>(32 + r32, cb)); }
        bf16x8 q; if constexpr (QL > 0) { if (d0 >= DQK / 16 - QL) q = *reinterpret_cast<const bf16x8*>(ql + (d0 - (DQK / 16 - QL)) * 1024); else q = qr[d0]; } else q = qr[d0];
        p0 = __builtin_amdgcn_mfma_f32_32x32x16_bf16(b0, q, p0, 0, 0, 0);
        p1 = __builtin_amdgcn_mfma_f32_32x32x16_bf16(b1, q, p1, 0, 0, 0); }
}
template <int DV, int D0> __device__ __forceinline__ void pv_one(f32x16& od, int vb, bf16x8 pa0, bf16x8 pa1, bf16x8 pa2, bf16x8 pa3) {
    constexpr int KS = (DV / 32) * 1024, HF = (DV / 32) * 512;
    const s16x4 l0 = tr_read<D0 * 512 + 0 * KS>(vb), h0 = tr_read<D0 * 512 + 0 * KS + HF>(vb), l1 = tr_read<D0 * 512 + 1 * KS>(vb), h1 = tr_read<D0 * 512 + 1 * KS + HF>(vb);
    const s16x4 l2 = tr_read<D0 * 512 + 2 * KS>(vb), h2 = tr_read<D0 * 512 + 2 * KS + HF>(vb), l3 = tr_read<D0 * 512 + 3 * KS>(vb), h3 = tr_read<D0 * 512 + 3 * KS + HF>(vb);
#define ATT_PK(L, H) (bf16x8){L[0], L[1], L[2], L[3], H[0], H[1], H[2], H[3]}
    od = __builtin_amdgcn_mfma_f32_32x32x16_bf16(pa0, ATT_PK(l0, h0), od, 0, 0, 0);
    od = __builtin_amdgcn_mfma_f32_32x32x16_bf16(pa1, ATT_PK(l1, h1), od, 0, 0, 0);
    od = __builtin_amdgcn_mfma_f32_32x32x16_bf16(pa2, ATT_PK(l2, h2), od, 0, 0, 0);
    od = __builtin_amdgcn_mfma_f32_32x32x16_bf16(pa3, ATT_PK(l3, h3), od, 0, 0, 0);
#undef ATT_PK
}
template <int DV> __device__ __forceinline__ void pv_all(f32x16* o, int vb, bf16x8 pa0, bf16x8 pa1, bf16x8 pa2, bf16x8 pa3) {
    pv_one<DV, 0>(o[0], vb, pa0, pa1, pa2, pa3); pv_one<DV, 1>(o[1], vb, pa0, pa1, pa2, pa3);
    if constexpr (DV == 128) { pv_one<DV, 2>(o[2], vb, pa0, pa1, pa2, pa3); pv_one<DV, 3>(o[3], vb, pa0, pa1, pa2, pa3); }
}
template <int DQK, int DV> struct Shm { static constexpr int V = KVBLK * DV * 2, K = KVBLK * DQK * 2, WSO = 2 * V + 2 * K, QLO = WSO + NW * 64 * 4; };

template <int DQK, int DV, int SD, bool WINDOW, int THRI, int QL, bool DMA = false>
__device__ __forceinline__ void attn_unit(const bf16* __restrict__ Qb, int ldq, const bf16* __restrict__ Kh, int ldk, const bf16* __restrict__ Vh, int ldv, bf16* __restrict__ Ob, int ldo,
                                          int NT, int segB, int qlat0, int klat0, float m_init, float l_init, char* lds, int wv) {
    constexpr int SHM_V = Shm<DQK, DV>::V, SHM_K = Shm<DQK, DV>::K, NKP = DQK / 64, NVP = DV / 64, ND0 = DV / 32;
    int tid_ = otid(wv);
    const int tid = tid_, wid = tid >> 6, lane = tid & 63, r32 = lane & 31, hi = lane >> 5;
    char* V_lds = lds; char* K_lds = lds + 2 * SHM_V;
    float* wsf = (float*)(lds + Shm<DQK, DV>::WSO) + wid * 64; float* li_l = wsf; float* al_l = wsf + 32;
    float m_reg = m_init, l_reg = l_init; f32x16 o[ND0]; bf16x8 qr[DQK / 16 - QL > 0 ? DQK / 16 - QL : 1];
    char* ql = lds + Shm<DQK, DV>::QLO + wid * (QL > 0 ? QL : 1) * 1024 + lane * 16;
#pragma unroll
    for (int d = 0; d < ND0; ++d) o[d] = f32x16{};
    const bf16* Qw = Qb + (long)(wid * QBLK + r32) * ldq + hi * 8;
#pragma unroll
    for (int d0 = 0; d0 < DQK / 16; ++d0) { const bf16x8 q = *reinterpret_cast<const bf16x8*>(Qw + d0 * 16); if (d0 < DQK / 16 - QL) qr[d0 < DQK / 16 - QL ? d0 : 0] = q; else *reinterpret_cast<bf16x8*>(ql + (d0 - (DQK / 16 - QL)) * 1024) = q; }
    const int srow = tid >> 3, sch = tid & 7;
    const int kflip = (DQK == 128) ? ((srow >> 3) & 1) * 128 : 0;
    const int kgo = srow * ldk + sch * 8, klo = kswz<DQK>(srow, sch * 16) & ~kflip, vgo = srow * ldv + sch * 8, vlo = v_st<DV>(srow, sch * 8);
    const int vb0 = (int)(uintptr_t)V_lds + v_rd_base(lane);
    int kb[4];
#pragma unroll
    for (int j = 0; j < 4; ++j) kb[j] = kswz<DQK>(r32, 32 * j + 16 * hi);
    bf16x8 ks[SD][NKP], vs[SD][NVP];
#define ATT_BAR() asm volatile("s_waitcnt lgkmcnt(0)\n\ts_barrier" ::: "memory")
#define ATT_KROW(t) ((t) < 4 ? 64 * (t) : segB + 64 * ((t) - 4))
#define ATT_SLOAD(i, t) do { const long _kr = ATT_KROW(t); _Pragma("unroll") for (int _x = 0; _x < NVP; ++_x) vs[i][_x] = *reinterpret_cast<const bf16x8*>(Vh + _kr * ldv + vgo + 64 * _x); \
        _Pragma("unroll") for (int _x = 0; _x < NKP; ++_x) ks[i][_x] = *reinterpret_cast<const bf16x8*>(Kh + _kr * ldk + kgo + 64 * _x); } while (0)
#define ATT_SWRITE(b, i) do { _Pragma("unroll") for (int _x = 0; _x < NVP; ++_x) *(bf16x8*)(V_lds + (b) * SHM_V + vlo + 1024 * _x) = vs[i][_x]; \
        _Pragma("unroll") for (int _x = 0; _x < NKP; ++_x) *(bf16x8*)(K_lds + (b) * SHM_K + klo + ((128 * _x) ^ kflip)) = ks[i][_x]; } while (0)
#define ATT_SWAIT() do { if constexpr (SD == 2) { if constexpr (NKP + NVP == 4) asm volatile("s_waitcnt vmcnt(4)" ::: "memory"); else if constexpr (NKP + NVP == 2) asm volatile("s_waitcnt vmcnt(2)" ::: "memory"); else asm volatile("s_waitcnt vmcnt(5)" ::: "memory"); } \
        else asm volatile("s_waitcnt vmcnt(0)" ::: "memory"); } while (0)
#define ATT_RESC(a) do { if (__any((a) < 1.f)) { if (hi == 0) al_l[r32] = (a); asm volatile("s_waitcnt lgkmcnt(0)" ::: "memory"); \
        _Pragma("unroll") for (int d = 0; d < ND0; ++d) _Pragma("unroll") for (int r = 0; r < 16; ++r) o[d][r] *= al_l[crow(r, hi)]; } } while (0)
#define ATT_MASK(P0, P1, t) do { if constexpr (WINDOW) { if ((t) >= 4) { const int _d0 = klat0 + 64 * ((t) - 4) - (qlat0 + wid * QBLK + r32); \
        _Pragma("unroll") for (int r = 0; r < 16; ++r) { const int _d = _d0 + crow(r, hi); P0[r] = (_d > 128 || _d < -128) ? -1e30f : P0[r]; P1[r] = (_d + 32 > 128 || _d + 32 < -128) ? -1e30f : P1[r]; } } } } while (0)
    f32x16 pA0, pA1, pB0, pB1; float mnA, mnB, alA, alB; bf16x8 pa0, pa1, pa2, pa3;
    constexpr int SE = 0, SO = SD - 1;
    if (wv >= 4) __builtin_amdgcn_s_setprio(1);
    if constexpr (!DMA) {
    ATT_SLOAD(SE, 0); asm volatile("s_waitcnt vmcnt(0)" ::: "memory"); ATT_SWRITE(0, SE); ATT_BAR();
    qkt<DQK, QL>(pA0, pA1, K_lds, qr, ql, kb, r32, hi); partialSM<DQK, THRI>(pA0, pA1, m_reg, mnA, alA);
    ATT_SLOAD(SO, 1); if constexpr (SD == 2) { if (2 < NT) ATT_SLOAD(SE, 2); }
    ATT_SWAIT(); ATT_SWRITE(1, SO); ATT_BAR();
    for (int j = 1; j + 1 < NT; j += 2) {
        ATT_SBAR(); qkt<DQK, QL>(pB0, pB1, K_lds + SHM_K, qr, ql, kb, r32, hi); ATT_MASK(pB0, pB1, j);
        finishSM(pA0, pA1, alA, l_reg, pa0, pa1, pa2, pa3); ATT_SBAR();
        ATT_SLOAD(SO, j + SD); ATT_SBAR();
        pv_all<DV>(o, vb0, pa0, pa1, pa2, pa3); partialSM<DQK, THRI>(pB0, pB1, m_reg, mnB, alB);
        ATT_BAR(); ATT_SWAIT(); ATT_SWRITE(0, SE);
        ATT_RESC(alB); ATT_BAR();
        ATT_SBAR(); qkt<DQK, QL>(pA0, pA1, K_lds, qr, ql, kb, r32, hi); ATT_MASK(pA0, pA1, j + 1);
        finishSM(pB0, pB1, alB, l_reg, pa0, pa1, pa2, pa3); ATT_SBAR();
        if (SD == 1 || j + 3 < NT) ATT_SLOAD(SE, j + 1 + SD); ATT_SBAR();
        pv_all<DV>(o, vb0 + SHM_V, pa0, pa1, pa2, pa3); partialSM<DQK, THRI>(pA0, pA1, m_reg, mnA, alA);
        ATT_BAR(); ATT_SWAIT(); ATT_SWRITE(1, SO);
        ATT_RESC(alA); ATT_BAR();
    }
    ATT_SBAR(); qkt<DQK, QL>(pB0, pB1, K_lds + SHM_K, qr, ql, kb, r32, hi); ATT_MASK(pB0, pB1, NT - 1);
    finishSM(pA0, pA1, alA, l_reg, pa0, pa1, pa2, pa3); ATT_SBAR();
    pv_all<DV>(o, vb0, pa0, pa1, pa2, pa3); partialSM<DQK, THRI>(pB0, pB1, m_reg, mnB, alB);
    ATT_BAR(); ATT_RESC(alB);
    finishSM(pB0, pB1, alB, l_reg, pa0, pa1, pa2, pa3); ATT_SBAR();
    pv_all<DV>(o, vb0 + SHM_V, pa0, pa1, pa2, pa3);
    } else {
        static_assert(!DMA || (DQK == 128 && DV == 128 && !WINDOW), "DMA staging: D = 128 dense only");
        LAS char* ldsL = (LAS char*)lds;
        const int krow = 4 * wid + ((lane >> 4) & 3);
        const int kgo_d = krow * ldk + (((lane & 15) ^ (krow & 15)) << 3);
        const int vsub = 2 * wid + (lane >> 5), w32 = lane & 31, vkk = ((vsub >> 2) << 3) | (w32 >> 2), vk = (vkk & ~0xC) | ((vkk & 4) << 1) | ((vkk & 8) >> 1);
        const int vgo_d = vk * ldv + (vsub & 3) * 32 + (w32 & 3) * 8;
#define ATT_DMA_K(b, t) do { const bf16* _g = Kh + (long)ATT_KROW(t) * ldk + kgo_d; \
        __builtin_amdgcn_global_load_lds((const unsigned*)_g, (LAS unsigned*)(ldsL + 2 * SHM_V + (b) * SHM_K + wv * 1024), 16, 0, 0); \
        __builtin_amdgcn_global_load_lds((const unsigned*)(_g + 32 * ldk), (LAS unsigned*)(ldsL + 2 * SHM_V + (b) * SHM_K + wv * 1024 + 8192), 16, 0, 0); } while (0)
#define ATT_DMA_V(b, t) do { const bf16* _g = Vh + (long)ATT_KROW(t) * ldv + vgo_d; \
        __builtin_amdgcn_global_load_lds((const unsigned*)_g, (LAS unsigned*)(ldsL + (b) * SHM_V + wv * 1024), 16, 0, 0); \
        __builtin_amdgcn_global_load_lds((const unsigned*)(_g + 32 * ldv), (LAS unsigned*)(ldsL + (b) * SHM_V + wv * 1024 + 8192), 16, 0, 0); } while (0)
#define ATT_LAND() asm volatile("s_waitcnt vmcnt(0) lgkmcnt(0)\n\ts_barrier" ::: "memory")
        ATT_DMA_K(0, 0); ATT_DMA_V(0, 0); ATT_DMA_K(1, 1);
        ATT_LAND();
        qkt<DQK, QL>(pA0, pA1, K_lds, qr, ql, kb, r32, hi); partialSM<DQK, THRI>(pA0, pA1, m_reg, mnA, alA);
        ATT_BAR();
        ATT_DMA_K(0, 2); ATT_DMA_V(1, 1);
        for (int j = 1; j + 1 < NT; j += 2) {
            ATT_SBAR(); qkt<DQK, QL>(pB0, pB1, K_lds + SHM_K, qr, ql, kb, r32, hi);
            finishSM(pA0, pA1, alA, l_reg, pa0, pa1, pa2, pa3); ATT_SBAR();
            pv_all<DV>(o, vb0, pa0, pa1, pa2, pa3); partialSM<DQK, THRI>(pB0, pB1, m_reg, mnB, alB);
            ATT_LAND();
            if (j + 2 < NT) ATT_DMA_K(1, j + 2);
            ATT_DMA_V(0, j + 1);
            ATT_RESC(alB);
            ATT_SBAR(); qkt<DQK, QL>(pA0, pA1, K_lds, qr, ql, kb, r32, hi);
            finishSM(pB0, pB1, alB, l_reg, pa0, pa1, pa2, pa3); ATT_SBAR();
            pv_all<DV>(o, vb0 + SHM_V, pa0, pa1, pa2, pa3); partialSM<DQK, THRI>(pA0, pA1, m_reg, mnA, alA);
            ATT_LAND();
            if (j + 3 < NT) ATT_DMA_K(0, j + 3);
            ATT_DMA_V(1, j + 2);
            ATT_RESC(alA);
        }
        ATT_SBAR(); qkt<DQK, QL>(pB0, pB1, K_lds + SHM_K, qr, ql, kb, r32, hi);
        finishSM(pA0, pA1, alA, l_reg, pa0, pa1, pa2, pa3); ATT_SBAR();
        pv_all<DV>(o, vb0, pa0, pa1, pa2, pa3); partialSM<DQK, THRI>(pB0, pB1, m_reg, mnB, alB);
        ATT_LAND(); ATT_RESC(alB);
        finishSM(pB0, pB1, alB, l_reg, pa0, pa1, pa2, pa3); ATT_SBAR();
        pv_all<DV>(o, vb0 + SHM_V, pa0, pa1, pa2, pa3);
#undef ATT_DMA_K
#undef ATT_DMA_V
#undef ATT_LAND
    }
    __builtin_amdgcn_s_setprio(0);
    if (hi == 0) li_l[r32] = l_reg; asm volatile("s_waitcnt lgkmcnt(0)" ::: "memory");
    float rli[16];
#pragma unroll
    for (int r = 0; r < 16; ++r) rli[r] = __builtin_amdgcn_rcpf(li_l[crow(r, hi)]);
    int tid2 = otid(wv);
    bf16* Ow = Ob + (long)((tid2 >> 6) * QBLK) * ldo + (tid2 & 31);
#pragma unroll
    for (int r = 0; r < 16; ++r) { const int orow = crow(r, (tid2 >> 5) & 1);
#pragma unroll
        for (int d0 = 0; d0 < ND0; ++d0) Ow[(long)orow * ldo + d0 * 32] = (bf16)f2bf(o[d0][r] * rli[r]); }
    ATT_BAR();
#undef ATT_BAR
#undef ATT_KROW
#undef ATT_SLOAD
#undef ATT_SWRITE
#undef ATT_SWAIT
#undef ATT_RESC
#undef ATT_MASK
}

template <int DQK, int DV, int SD, bool WINDOW, int QL, bool DMA = false>
__device__ __forceinline__ void attn_phase(const bf16* Q, int ldq, int qhs, const bf16* Kb, int ldk, int khs, const bf16* Vb, int ldv, int vhs, bf16* O, int ldo, int ohs, int H, int G, const float* sinks, char* lds, int wv) {
    const int nlat = NB * H * 32, ntot = WINDOW ? nlat : nlat + NB * H;
    const int c0 = (gridDim.x == 256) ? (((int)blockIdx.x & 7) * 32 + ((int)blockIdx.x >> 3)) : (int)blockIdx.x;
    for (int L = c0; L < ntot; L += gridDim.x) {
        int b, h, q0row, NT, segB = NCTX, qlat0 = 0, klat0 = 0; float m0 = -1e30f, l0 = 0.f;
        if (L < nlat) { const int qb = L & 31; h = (L >> 5) % H; b = (L >> 5) / H; q0row = NCTX + qb * 256; NT = 4 + SEQ / 64;
            if constexpr (WINDOW) { qlat0 = qb * 256; klat0 = max(0, qlat0 - 128); const int hi_ = min(SEQ, qlat0 + 256 + 128); NT = 4 + (hi_ - klat0) / 64; segB = NCTX + klat0; m0 = sinks[h] / Cst<DQK>::scale(); l0 = 1.f; } }
        else { const int L2 = L - nlat; h = L2 % H; b = L2 / H; q0row = 0; NT = 4; }
        const size_t rb = (size_t)b * RPB; const int kvh = h / G;
        attn_unit<DQK, DV, SD, WINDOW, 8, QL, DMA>(Q + (rb + q0row) * ldq + h * qhs, ldq, Kb + rb * ldk + kvh * khs, ldk, Vb + rb * ldv + kvh * vhs, ldv, O + (rb + q0row) * ldo + h * ohs, ldo, NT, segB, qlat0, klat0, m0, l0, lds, wv);
    }
}
}

#define XB_TMO      128
#define XB_XCNT(j)  (256  + 64 * (j))
#define XB_XSUB(j)  (1280 + 64 * (j))
#define XB_XGEN(j)  (2304 + 64 * (j))
#define XB_TOP      3328
#define XB_TOPGEN   3392
#define XCD_BAR_WORDS 3456
#define XB_SPIN_CAP (1u << 18)
__device__ __forceinline__ unsigned xb_ld(unsigned* p)              { return __hip_atomic_load(p, __ATOMIC_RELAXED, __HIP_MEMORY_SCOPE_AGENT); }
__device__ __forceinline__ unsigned xb_add(unsigned* p, unsigned v) { return __hip_atomic_fetch_add(p, v, __ATOMIC_RELAXED, __HIP_MEMORY_SCOPE_AGENT); }
__device__ __forceinline__ unsigned xb_xcc_id() { return (unsigned)__builtin_amdgcn_s_getreg((3 << 11) | 20) & 0xFu; }
#define XB_SPIN(cond, bar) do { unsigned _sp = 0; while (cond) { __builtin_amdgcn_s_sleep(1); \
    if ((++_sp & 255u) == 0u) { if (xb_ld(&(bar)[XB_TMO])) break; if (_sp > XB_SPIN_CAP) { atomicAdd(&(bar)[XB_TMO], 1u); break; } } } } while (0)
struct XcdBarrier { unsigned* bar; unsigned x; volatile LAS unsigned* st; };
__device__ __forceinline__ XcdBarrier xcd_barrier_post(unsigned* bar, volatile LAS unsigned* st) {
    XcdBarrier b; b.bar = bar; b.x = xb_xcc_id(); b.st = st;
    if (threadIdx.x == 0) (void)xb_add(&bar[XB_XCNT(b.x)], 1u);
    return b;
}
__device__ __forceinline__ void xcd_barrier_complete(unsigned* bar, unsigned x, unsigned& nloc, unsigned& nx) {
    const unsigned G = gridDim.x * gridDim.y * gridDim.z;
    unsigned sum, cnt, mine, sp = 0u;
    for (;;) {
        sum = 0u; cnt = 0u; mine = 0u;
#pragma unroll
        for (unsigned j = 0; j < 16; ++j) { const unsigned c = xb_ld(&bar[XB_XCNT(j)]); sum += c; cnt += (c > 0u) ? 1u : 0u; mine = (j == x) ? c : mine; }
        if (sum == G) break;
        __builtin_amdgcn_s_sleep(1);
        if ((++sp & 255u) == 0u) { if (xb_ld(&bar[XB_TMO])) break; if (sp > XB_SPIN_CAP) { atomicAdd(&bar[XB_TMO], 1u); break; } }
    }
    nloc = mine > 0u ? mine : 1u; nx = cnt > 0u ? cnt : 1u;
}
__device__ __forceinline__ void xcd_barrier(const XcdBarrier& b, int wv) {
    asm volatile("s_waitcnt vmcnt(0)" ::: "memory");
    __syncthreads();
    if (otid(wv) == 0) {
        unsigned* bar = b.bar;
        __builtin_amdgcn_s_waitcnt(0);
        unsigned nloc = b.st[0], nx = b.st[1];
        if (nloc == 0u) { xcd_barrier_complete(bar, b.x, nloc, nx); b.st[0] = nloc; b.st[1] = nx; }
        const unsigned old = xb_add(&bar[XB_XSUB(b.x)], 1u);
        const unsigned gen = old / nloc;
        if (old + 1u == (gen + 1u) * nloc) {
            __builtin_amdgcn_fence(__ATOMIC_RELEASE, "agent");
            asm volatile("s_waitcnt vmcnt(0)" ::: "memory");
            const unsigned og = xb_add(&bar[XB_TOP], 1u);
            const unsigned tg = og / nx;
            if (og + 1u == (tg + 1u) * nx) xb_add(&bar[XB_TOPGEN], 1u);
            else XB_SPIN(xb_ld(&bar[XB_TOPGEN]) == tg, bar);
            __builtin_amdgcn_fence(__ATOMIC_ACQUIRE, "agent");
            xb_add(&bar[XB_XGEN(b.x)], 1u);
            asm volatile("s_waitcnt vmcnt(0)" ::: "memory");
        } else {
            XB_SPIN(xb_ld(&bar[XB_XGEN(b.x)]) == gen, bar);
            __builtin_amdgcn_fence(__ATOMIC_ACQUIRE, "agent");
            asm volatile("s_waitcnt vmcnt(0)" ::: "memory");
        }
    }
    __syncthreads();
}

constexpr int RING_OFF = 0, GT_OFF = 131072, MISC_OFF = GT_OFF + 15360, LDS_BYTES = MISC_OFF + 1024;
constexpr int MAX_UNITS_PER_WG = 30;
constexpr int NPH = 35;
__device__ __forceinline__ void grouped_setup(const P& p, int wv, int m, LAS int* tl) {
    __syncthreads();
    if (otid(wv) == 0) { const unsigned* cnt = WSP(const unsigned, WS_CTL) + CW_CNT + 64 * m; int o = 0;
        for (int e = 0; e < NE; ++e) { tl[e] = o; const int c = (int)__hip_atomic_load(cnt + e, __ATOMIC_RELAXED, __HIP_MEMORY_SCOPE_AGENT); tl[16 + e] = c; o += (c + 255) >> 8; }
        tl[8] = o; }
    __syncthreads();
}
template <int K, int N, class Epi, int SPLIT = 1, int SKIPCTX = 0, bool ATILE = false, bool BTILE = false> __device__ __forceinline__ void gemm_plain(const P& p, int wv, unsigned char* lds_, const bf16* A, const bf16* Bt, const Epi& E) {
    LAS unsigned char* lds = (LAS unsigned char*)lds_;
    constexpr int nM = SKIPCTX ? 128 : T / 256, nwg = nM * (N / 256), R = nwg % 256;
    pg8::Sched S; S.init(nM, N / 256, (int)gridDim.x, (int)blockIdx.x, (const LAS int*)(lds + MISC_OFF), 0, (SPLIT && R > 0 && 4 * R <= 256) ? 1 : 0, SKIPCTX);
    pg8::gemm_phase<Epi, false, K, false, ATILE, BTILE>(wv, lds + RING_OFF, A, Bt, 0, S, E, nullptr);
    if constexpr (SPLIT && R > 0 && 4 * R <= 256) {
        pg8::Sched S2; S2.init(nM, N / 256, (int)gridDim.x, (int)blockIdx.x, (const LAS int*)(lds + MISC_OFF), 0, 2, SKIPCTX);
        pg8::gemm_sub_unit<Epi, K, ATILE, BTILE>(wv, lds + RING_OFF, A, Bt, 0, S2, E);
    }
}
__device__ __forceinline__ void moe_w13(const P& p, int wv, unsigned char* lds_, int m) {
    LAS unsigned char* lds = (LAS unsigned char*)lds_; LAS int* tl = (LAS int*)(lds + MISC_OFF); LAS unsigned short* gtab = (LAS unsigned short*)(lds + GT_OFF);
    grouped_setup(p, wv, m, tl);
    pg8::Sched S; S.init(tl[8], 2 * FE / 256, (int)gridDim.x, (int)blockIdx.x, tl, 1);
    const int* idx = WSP(const int, WS_IDX); const int tidg = otid(wv);
    { static_assert(MAX_UNITS_PER_WG % 2 == 0, "two units per step");
      const int half = __builtin_amdgcn_readfirstlane(tidg >> 8), row = tidg & 255; int vals[MAX_UNITS_PER_WG / 2];
#pragma unroll
      for (int k = 0; k < MAX_UNITS_PER_WG / 2; ++k) { pg8::Unit u; int v = 0;
          if (S.next(2 * k + half, u)) { const int pr = (u.pm - tl[u.e]) * 256 + row; const int* ie = idx + (size_t)u.e * T; v = ie[pr < tl[16 + u.e] ? pr : 0]; }
          vals[k] = v; }
#pragma unroll
      for (int k = 0; k < MAX_UNITS_PER_WG / 2; ++k) gtab[(2 * k + half) * 256 + row] = (unsigned short)vals[k]; }
    __syncthreads();
    pg8::EpiSwiglu E{WSP(bf16, WS_ACT), FE};
    pg8::gemm_phase<pg8::EpiSwiglu, true, DM>(wv, lds + RING_OFF, WSP(const bf16, WS_A), WSP(const bf16, W_13M) + (size_t)m * NE * 2 * FE * DM, (size_t)2 * FE * DM, S, E, gtab);
}
__device__ __forceinline__ void moe_w2(const P& p, int wv, unsigned char* lds_, int m) {
    LAS unsigned char* lds = (LAS unsigned char*)lds_; LAS int* tl = (LAS int*)(lds + MISC_OFF);
    grouped_setup(p, wv, m, tl);
    pg8::Sched S; S.init(tl[8], DM / 256, (int)gridDim.x, (int)blockIdx.x, tl, 1, 1, 0);
    pg8::EpiStore E{WSP(bf16, WS_Y), DM, nullptr};
    pg8::gemm_phase<pg8::EpiStore, false, FE, false, true, true>(wv, lds + RING_OFF, WSP(const bf16, WS_ACT), WSP(const bf16, W_2M) + (size_t)m * NE * DM * FE, (size_t)DM * FE, S, E, nullptr);
    pg8::Sched S2; S2.init(tl[8], DM / 256, (int)gridDim.x, (int)blockIdx.x, tl, 1, 2, 0);
    pg8::gemm_sub_unit<pg8::EpiStore, FE, true, true>(wv, lds + RING_OFF, WSP(const bf16, WS_ACT), WSP(const bf16, W_2M) + (size_t)m * NE * DM * FE, (size_t)DM * FE, S2, E);
}
__device__ __forceinline__ void dense_w13(const P& p, int wv, unsigned char* lds, int pi) { pg8::EpiSwiglu E{WSP(bf16, WS_ACT), FF}; gemm_plain<DM, 2 * FF, pg8::EpiSwiglu, 0>(p, wv, lds, WSP(const bf16, WS_A), WSP(const bf16, W_13F) + (size_t)pi * 2 * FF * DM, E); }
__device__ __forceinline__ void dense_w2(const P& p, int wv, unsigned char* lds, int pi, int layer) { pg8::EpiResid E{p.in[0], p.in[2], p.ws, layer, 5, 0}; gemm_plain<FF, DM, pg8::EpiResid, 1, 0, true, true>(p, wv, lds, WSP(const bf16, WS_ACT), WSP(const bf16, W_2F) + (size_t)pi * DM * FF, E); }
template <int SKIPCTX = 0> __device__ __forceinline__ void wo_gemm(const P& p, int wv, unsigned char* lds, const bf16* Ain, size_t woff, int layer, int from_in) { pg8::EpiResid E{p.in[0], p.in[2], p.ws, layer, 2, from_in}; gemm_plain<DM, DM, pg8::EpiResid, 1, SKIPCTX>(p, wv, lds, Ain, WSP(const bf16, woff), E); }

template <int PH> __device__ __forceinline__ void run_phase(const P& p, int wv, unsigned char* lds) {
    const int bid = blockIdx.x, nb = gridDim.x;
    if constexpr (PH == 0) phase_prologue(p, wv, bid, nb, lds);
    if constexpr (PH == 1) phase_norm_plain<true>(p, wv, bid, nb, 0, 0);
    if constexpr (PH == 2) { pg8::EpiStore E{WSP(bf16, WS_QKV), A_NQKV, nullptr}; gemm_plain<DM, A_NQKV>(p, wv, lds, WSP(const bf16, WS_A), WSP(const bf16, W_QKVA), E); }
    if constexpr (PH == 3) phase_post_a(p, wv, bid, nb);
    if constexpr (PH == 4) att::attn_phase<128, 128, 2, false, 0, true>(WSP(const bf16, WS_QKV), A_NQKV, 128, WSP(const bf16, WS_QKV) + 1024, A_NQKV, 128, WSP(const bf16, WS_QKV) + 1280, A_NQKV, 128, WSP(bf16, WS_OB), DM, 128, 8, 4, nullptr, (char*)lds, wv);
    if constexpr (PH == 5) wo_gemm(p, wv, lds, WSP(const bf16, WS_OB), W_OA, 0, 1);
    if constexpr (PH == 6) phase_norm_plain<false>(p, wv, bid, nb, 0, 1);
    if constexpr (PH == 7) dense_w13(p, wv, lds, 0);
    if constexpr (PH == 8) dense_w2(p, wv, lds, 0, 0);
    if constexpr (PH == 9) phase_norm_plain<false>(p, wv, bid, nb, 1, 0);
    if constexpr (PH == 10) { pg8::EpiStore E{WSP(bf16, WS_DOWN), B_NDOWN_P, nullptr}; gemm_plain<DM, B_NDOWN_P>(p, wv, lds, WSP(const bf16, WS_A), WSP(const bf16, W_DOWN), E); }
    if constexpr (PH == 11) phase_post_b1(p, wv, bid, nb);
    if constexpr (PH == 12) { pg8::EpiStoreT<1> E{WSP(bf16, WS_QKV), 1536, WSP(const f32x2, WS_ROPE64)}; gemm_plain<B_QL, B_NUQ>(p, wv, lds, WSP(const bf16, WS_DQN), WSP(const bf16, W_UQ), E); }
    if constexpr (PH == 13) { pg8::EpiKV E{WSP(bf16, WS_KB), WSP(bf16, WS_VB)}; gemm_plain<B_KVL, B_NUKV>(p, wv, lds, WSP(const bf16, WS_DKVN), WSP(const bf16, W_UKV), E); }
    if constexpr (PH == 14) att::attn_phase<192, 128, 1, false, 5>(WSP(const bf16, WS_QKV), 1536, 192, WSP(const bf16, WS_KB), 1536, 192, WSP(const bf16, WS_VB), DM, 128, WSP(bf16, WS_OB), DM, 128, 8, 1, nullptr, (char*)lds, wv);
    if constexpr (PH == 15) wo_gemm(p, wv, lds, WSP(const bf16, WS_OB), W_OB, 1, 0);
    if constexpr (PH == 16) phase_norm<4>(p, wv, bid, nb, lds, 1, 1, 0, 0, 0, true);
    if constexpr (PH == 17) moe_w13(p, wv, lds, 0);
    if constexpr (PH == 18) moe_w2(p, wv, lds, 0);
    if constexpr (PH == 19) phase_combine<false>(p, wv, bid, nb, lds, 2, 0, 0, 1);
    if constexpr (PH == 20) { pg8::EpiGelu E{WSP(bf16, WS_QKV), WSP(bf16, WS_KB)}; gemm_plain<DM, C_NIN>(p, wv, lds, WSP(const bf16, WS_A), WSP(const bf16, W_IN), E); }
    if constexpr (PH == 21) phase_sgu(p, wv, bid, nb, lds);
    if constexpr (PH == 22) wo_gemm(p, wv, lds, WSP(const bf16, WS_VB), W_OUT, 2, 0);
    if constexpr (PH == 23) phase_norm_plain<false>(p, wv, bid, nb, 2, 1);
    if constexpr (PH == 24) dense_w13(p, wv, lds, 1);
    if constexpr (PH == 25) dense_w2(p, wv, lds, 1, 2);
    if constexpr (PH == 26) phase_norm_plain<false>(p, wv, bid, nb, 3, 0);
    if constexpr (PH == 27) { pg8::EpiStoreT<3> E{WSP(bf16, WS_QKV), D_NQKV, WSP(const f32x2, WS_ROPE64)}; gemm_plain<DM, D_NQKV>(p, wv, lds, WSP(const bf16, WS_A), WSP(const bf16, W_QKVD), E); }
    if constexpr (PH == 29) att::attn_phase<64, 64, 2, true, 0>(WSP(const bf16, WS_QKV), D_NQKV, 64, WSP(const bf16, WS_QKV) + 1024, D_NQKV, 64, WSP(const bf16, WS_QKV) + 1152, D_NQKV, 64, WSP(bf16, WS_OB), DM, 64, 16, 8, p.in[26], (char*)lds, wv);
    if constexpr (PH == 30) wo_gemm<1>(p, wv, lds, WSP(const bf16, WS_OB), W_OD, 3, 0);
    if constexpr (PH == 31) phase_norm<4>(p, wv, bid, nb, lds, 3, 1, 0, 0, 1, false);
    if constexpr (PH == 32) moe_w13(p, wv, lds, 1);
    if constexpr (PH == 33) moe_w2(p, wv, lds, 1);
    if constexpr (PH == 34) phase_combine<true>(p, wv, bid, nb, lds, 0, 0, 1, 3);
}
#ifndef MK_PER_PHASE
#define MK_PER_PHASE 0
#endif
template <int PH> __global__ void __launch_bounds__(512, 2) k_phase(P p) {
    extern __shared__ __attribute__((aligned(16))) unsigned char lds[];
    run_phase<PH>(p, __builtin_amdgcn_readfirstlane((int)threadIdx.x >> 6), lds);
}
#define AS4 __attribute__((address_space(4)))
#ifndef PROBE_DUP_MASK
#define PROBE_DUP_MASK 0ull
#endif
template <int PH> __device__ __forceinline__ void phase_fn(const AS4 P* pp, int wv, LAS unsigned char* lds_) {
    const AS4 P* q = pp; asm volatile("" : "+s"(q));
    P p;
#pragma unroll
    for (int i = 0; i < 33; ++i) p.in[i] = q->in[i];
    p.out = q->out; p.ws = q->ws; p.ph_lo = 0; p.ph_hi = 0;
    run_phase<PH>(p, wv, (unsigned char*)lds_);
}
template <int PH> __device__ __forceinline__ void run_all(const AS4 P* pp, int wv, LAS unsigned char* lds, const XcdBarrier& bar) {
    constexpr bool on = (PH != 28);
    if constexpr (on) phase_fn<PH>(pp, wv, lds);
    if constexpr (on && ((PROBE_DUP_MASK >> PH) & 1ull) != 0) { __syncthreads(); phase_fn<PH>(pp, wv, lds); }
    if constexpr (PH + 1 < NPH) { if constexpr (on) xcd_barrier(bar, wv); run_all<PH + 1>(pp, wv, lds, bar); }
}
__global__ void __launch_bounds__(512, 2) k_mega(P p_) {
    extern __shared__ __attribute__((aligned(16))) unsigned char lds[];
    const AS4 P* pp = (const AS4 P*)__builtin_amdgcn_kernarg_segment_ptr();
    const int wv = __builtin_amdgcn_readfirstlane((int)threadIdx.x >> 6);
    LAS unsigned* misc = (LAS unsigned*)((LAS unsigned char*)lds + MISC_OFF);
    if (threadIdx.x < 256) misc[threadIdx.x] = 0u;
    __syncthreads();
    const XcdBarrier bar = xcd_barrier_post((unsigned*)(pp->ws + WS_CTL) + CW_BAR, (volatile LAS unsigned*)(misc + 64));
    run_all<0>(pp, wv, (LAS unsigned char*)lds, bar);
}

template <int PH> static void phase(hipStream_t st, const P& p) {
    static bool attr = false; if (!attr) { (void)hipFuncSetAttribute((const void*)k_phase<PH>, hipFuncAttributeMaxDynamicSharedMemorySize, LDS_BYTES); attr = true; }
    hipLaunchKernelGGL((k_phase<PH>), dim3(256), dim3(512), LDS_BYTES, st, p);
}
template <int LO, int HI> static void phases(hipStream_t st, const P& p) { if constexpr (LO < HI) { phase<LO>(st, p); phases<LO + 1, HI>(st, p); } }

extern "C" void kernel_launch(void* const* d_in, const int* in_sizes, int n_in, void* d_out, int out_size, void* d_ws, size_t ws_size, hipStream_t stream) {
    if (n_in != 33 || ws_size < WS_END || out_size != NB * SEQ * DM) { fprintf(stderr, "kernel_launch: unexpected shapes n_in %d ws %zu (need %zu) out %d\n", n_in, ws_size, (size_t)WS_END, out_size); return; }
    P p{}; for (int i = 0; i < 33; ++i) p.in[i] = (const float*)d_in[i]; p.out = (float*)d_out; p.ws = (unsigned char*)d_ws; p.ph_lo = 0; p.ph_hi = 0;
    unsigned char* ws = (unsigned char*)d_ws;
    (void)hipMemsetAsync(ws + WS_CTL, 0, CTL_BYTES, stream);
#if MK_PER_PHASE
    phases<0, NPH>(stream, p);
#else
    static int grid = 0;
    if (grid == 0) {
        int dev = 0, cus = 0, per_cu = 0;
        (void)hipGetDevice(&dev); (void)hipDeviceGetAttribute(&cus, hipDeviceAttributeMultiprocessorCount, dev);
        if (hipFuncSetAttribute((const void*)k_mega, hipFuncAttributeMaxDynamicSharedMemorySize, LDS_BYTES) != hipSuccess) { fprintf(stderr, "kernel_launch: hipFuncSetAttribute failed\n"); grid = -1; return; }
        if (hipOccupancyMaxActiveBlocksPerMultiprocessor(&per_cu, (const void*)k_mega, 512, LDS_BYTES) != hipSuccess || per_cu < 1) { fprintf(stderr, "kernel_launch: occupancy query says %d blocks per CU\n", per_cu); (void)hipGetLastError(); }
        grid = cus;
        if (grid != 256) fprintf(stderr, "kernel_launch: %d CUs (built for 256)\n", grid);
    }
    if (grid < 0) return;
    hipLaunchKernelGGL(k_mega, dim3(grid), dim3(512), LDS_BYTES, stream, p);
#endif
    const hipError_t le = hipPeekAtLastError();
    if (le != hipSuccess) fprintf(stderr, "kernel_launch: launch failed: %s\n", hipGetErrorName(le));
}
```

```cpp
#include <hip/hip_runtime.h>
#include <cstdio>
#include <cstdint>
#include <cstring>
#include <cmath>

#define GAS __attribute__((address_space(1)))
#define LAS __attribute__((address_space(3)))
typedef unsigned short bf16;
typedef float f32x4 __attribute__((ext_vector_type(4)));
typedef float f32x2 __attribute__((ext_vector_type(2)));
typedef short bf16x8 __attribute__((ext_vector_type(8)));
typedef unsigned u32x4 __attribute__((ext_vector_type(4)));
typedef unsigned u32x2 __attribute__((ext_vector_type(2)));

constexpr int DM = 1024, NB = 4, SEQ = 8192, NCTX = 256, RPB = SEQ + NCTX  , T = NB * RPB  ;
constexpr int GRIDW = 64;
constexpr float EPS = 1e-6f;
constexpr int A_NQKV = 1536, B_NDOWN = 704, B_NDOWN_P = 768, B_QL = 384, B_KVL = 256, B_NUQ = 1536, B_NUKV = 2048, C_NIN = 2048, D_NQKV = 1280;
constexpr int FF = 2816, FE = 3584, NE = 8;
constexpr int MAXSLOT = 69632;

constexpr size_t MiB = 1u << 20;
constexpr size_t al(size_t x) { return (x + 255) & ~(size_t)255; }
constexpr size_t WS_CTL = 0, CTL_BYTES = 1 * MiB;
constexpr size_t WS_MOD = 1 * MiB;
constexpr size_t WS_ROPE128 = 2 * MiB;
constexpr size_t WS_ROPE64 = WS_ROPE128 + 128 * 32 * 8;
constexpr size_t WS_IDX = 3 * MiB;
constexpr size_t WS_GW = WS_IDX + al((size_t)NE * T * 4);
constexpr size_t WS_TOK = WS_GW + al((size_t)NE * T * 4);
constexpr size_t WS_TOKW = WS_TOK + al((size_t)T * 16);
constexpr size_t WS_W0 = 8 * MiB;
static_assert(WS_TOKW + (size_t)T * 8 <= WS_W0, "routing tables fit below the weights");
constexpr size_t W_QKVA = WS_W0;
constexpr size_t W_OA = W_QKVA + (size_t)A_NQKV * DM * 2;
constexpr size_t W_DOWN = W_OA + (size_t)DM * DM * 2;
constexpr size_t W_UQ = W_DOWN + (size_t)B_NDOWN_P * DM * 2;
constexpr size_t W_UKV = W_UQ + (size_t)B_NUQ * B_QL * 2;
constexpr size_t W_OB = W_UKV + (size_t)B_NUKV * B_KVL * 2;
constexpr size_t W_IN = W_OB + (size_t)DM * DM * 2;
constexpr size_t W_OUT = W_IN + (size_t)C_NIN * DM * 2;
constexpr size_t W_SP = W_OUT + (size_t)DM * DM * 2;
constexpr size_t W_QKVD = W_SP + (size_t)8 * 128 * 128 * 2;
constexpr size_t W_OD = W_QKVD + (size_t)D_NQKV * DM * 2;
constexpr size_t W_13F = W_OD + (size_t)DM * DM * 2;
constexpr size_t W_2F = W_13F + (size_t)2 * 2 * FF * DM * 2;
constexpr size_t W_13M = W_2F + (size_t)2 * DM * FF * 2;
constexpr size_t W_2M = W_13M + (size_t)2 * NE * 2 * FE * DM * 2;
constexpr size_t WS_WEND = W_2M + (size_t)2 * NE * DM * FE * 2;
constexpr size_t WS_H = al(WS_WEND);
constexpr size_t WS_A = WS_H + (size_t)T * DM * 2;
constexpr size_t WS_QKV = WS_A + (size_t)T * DM * 2;
constexpr size_t WS_KB = WS_QKV + (size_t)T * 1536 * 2;
constexpr size_t WS_VB = WS_KB + (size_t)T * 1536 * 2;
constexpr size_t WS_OB = WS_VB + (size_t)T * DM * 2;
constexpr size_t WS_DOWN = WS_OB + (size_t)T * DM * 2;
constexpr size_t WS_DQN = WS_DOWN + (size_t)T * B_NDOWN_P * 2;
constexpr size_t WS_DKVN = WS_DQN + (size_t)T * B_QL * 2;
constexpr size_t WS_ACT = WS_DKVN + (size_t)T * B_KVL * 2;
constexpr size_t WS_Y = WS_ACT + (size_t)MAXSLOT * FE * 2;
constexpr size_t WS_END = WS_Y + (size_t)MAXSLOT * DM * 2;
constexpr int CW_CNT = 64;
constexpr int CW_BAR = 4096;

__device__ __forceinline__ unsigned f2bf(float f) { unsigned u = __builtin_bit_cast(unsigned, f); return (u + 0x7fffu + ((u >> 16) & 1u)) >> 16; }
__device__ __forceinline__ unsigned pk2(float lo, float hi) { unsigned r; asm("v_cvt_pk_bf16_f32 %0, %1, %2" : "=v"(r) : "v"(lo), "v"(hi)); return r; }
__device__ __forceinline__ float bf2f(unsigned b) { return __builtin_bit_cast(float, b << 16); }
__device__ __forceinline__ float bflo(unsigned w) { return __builtin_bit_cast(float, w << 16); }
__device__ __forceinline__ float bfhi(unsigned w) { return __builtin_bit_cast(float, w & 0xffff0000u); }
__device__ __forceinline__ float wave_sum(float v) {
#pragma unroll
    for (int o = 1; o < 64; o <<= 1) v += __shfl_xor(v, o);
    return v;
}
__device__ __forceinline__ int otid(int wv) { int l; asm volatile("v_mbcnt_lo_u32_b32 %0, -1, 0\n\tv_mbcnt_hi_u32_b32 %0, -1, %0" : "=v"(l)); return wv * 64 + l; }
__device__ __forceinline__ float silu_f(float x) { return x / (1.f + __expf(-x)); }
__device__ __forceinline__ float gelu_erf(float x) { return 0.5f * x * (1.f + erff(x * 0.70710678118654752f)); }

struct P {
    const float* in[33];
    float* out;
    unsigned char* ws;
    int ph_lo, ph_hi;
};
#define WSP(type, off) ((type*)(p.ws + (off)))
#define SUB_SKIP(u, ai, bj) ((u).sub != 0 && (u).sub != 1 + (ai) * 2 + (bj))

__device__ __forceinline__ void row_info(int r, int& b, int& j) { b = r / RPB; j = r - b * RPB; }
__device__ __forceinline__ const float* in_row(const P& p, int r) {
    int b, j; row_info(r, b, j);
    return j < NCTX ? p.in[2] + ((size_t)b * NCTX + j) * DM : p.in[0] + ((size_t)b * SEQ + (j - NCTX)) * DM;
}
__device__ __forceinline__ const float* mod_vec(const P& p, int layer, int r, int chunk) {
    int b, j; row_info(r, b, j); const int mr = j < NCTX ? 4 : b;
    return WSP(const float, WS_MOD) + ((size_t)(layer * 5 + mr) * 6 + chunk) * DM;
}

__device__ __forceinline__ void transpose_item(const float* W, int K, int N, bf16* WT, int mode, int ffh, LAS float* scr, int item, int lane) {
    const int nblk = N / 64, kb = item / nblk, nb = item % nblk, k0 = 64 * kb, n0 = 64 * nb;
    const int lr = lane >> 4, lc = (lane & 15) * 4;
#pragma unroll 8
    for (int i = 0; i < 16; ++i) { const int kk = 4 * i + lr; const f32x4 v = *(const f32x4*)(W + (size_t)(k0 + kk) * N + n0 + lc); LAS float* d = scr + kk * 65 + lc; d[0] = v.x; d[1] = v.y; d[2] = v.z; d[3] = v.w; }
    asm volatile("s_waitcnt lgkmcnt(0)" ::: "memory");
    int d0 = n0;
    if (mode == 1) { if (n0 < ffh) d0 = (n0 / 128) * 256 + n0 % 128; else { const int j = n0 - ffh; d0 = (j / 128) * 256 + 128 + j % 128; } }
    const int c = lane & 7;
#pragma unroll
    for (int j = 0; j < 8; ++j) { const int n = (lane >> 3) + 8 * j; const LAS float* s = scr + (8 * c) * 65 + n;
        u32x4 o; o.x = pk2(s[0 * 65], s[1 * 65]); o.y = pk2(s[2 * 65], s[3 * 65]); o.z = pk2(s[4 * 65], s[5 * 65]); o.w = pk2(s[6 * 65], s[7 * 65]);
        const int dn = d0 + n;
        if (mode == 2) *(u32x4*)(WT + (((size_t)(dn >> 8) * (K >> 6) + kb) * 256 + (dn & 255)) * 64 + 8 * c) = o;
        else *(u32x4*)(WT + (size_t)dn * K + k0 + 8 * c) = o; }
    asm volatile("s_waitcnt lgkmcnt(0)" ::: "memory");
}
struct TJob { const float* W; bf16* WT; int K, N, mode, ffh, items; };

__device__ __forceinline__ void phase_prologue(const P& p, int wv, int bid, int nb, unsigned char* lds_) {
    LAS unsigned char* lds = (LAS unsigned char*)lds_;
    const int tid = otid(wv), lane = tid & 63, wave = tid >> 6;
    {
        const int g = bid * 512 + tid;
        if (g < 128 * 32) { const int pos = g >> 5, i = g & 31; const float inv = (float)pow(10000.0, -(double)i / 32.0); const float a = (float)pos * inv;
            WSP(f32x2, WS_ROPE128)[g] = (f32x2){cosf(a), sinf(a)}; }
        else if (g < 128 * 32 + 128 * 16) { const int q = g - 128 * 32, pos = q >> 4, i = q & 15; const float inv = (float)pow(10000.0, -(double)i / 16.0); const float a = (float)pos * inv;
            WSP(f32x2, WS_ROPE64)[q] = (f32x2){cosf(a), sinf(a)}; }
    }
    {
        LAS float* sc = (LAS float*)lds;
        LAS float* red = (LAS float*)(lds + 5 * 1024 * 4);
        for (int it = bid; it < 192; it += nb) {
            const int layer = it / 48, cg = it % 48;
            __syncthreads();
            for (int i = tid; i < 5 * 1024; i += 512) { const int r = i >> 10, k = i & 1023; const float v = r < 4 ? p.in[1][r * DM + k] : p.in[3][k]; sc[i] = silu_f(v); }
            __syncthreads();
            const float* W = p.in[4] + (size_t)layer * DM * 6144 + cg * 128 + lane * 2;
            f32x2 acc[5];
#pragma unroll
            for (int r = 0; r < 5; ++r) acc[r] = (f32x2){0.f, 0.f};
            for (int k = wave * 128; k < wave * 128 + 128; ++k) { const f32x2 w = *(const f32x2*)(W + (size_t)k * 6144);
#pragma unroll
                for (int r = 0; r < 5; ++r) acc[r] += w * sc[r * 1024 + k]; }
#pragma unroll
            for (int r = 0; r < 5; ++r) *(LAS f32x2*)(red + (wave * 5 + r) * 128 + lane * 2) = acc[r];
            __syncthreads();
            for (int i = tid; i < 5 * 128; i += 512) { const int r = i >> 7, c = i & 127; float s = 0.f;
#pragma unroll
                for (int w = 0; w < 8; ++w) s += red[(w * 5 + r) * 128 + c];
                const int col = cg * 128 + c;
                WSP(float, WS_MOD)[(size_t)(layer * 5 + r) * 6144 + col] = s + p.in[5][layer * 6144 + col]; }
        }
        __syncthreads();
    }
    {
        LAS float* scr = (LAS float*)(lds + wave * 16640);
        const int gw = bid * 8 + wave, NGW = nb * 8;
        int start = 0;
        auto run = [&](const float* W, bf16* WT, int K, int N, int mode, int ffh) {
            const int items = (K / 64) * (N / 64);
            int first = gw - start; if (first < 0) first += NGW;
            for (int it = first; it < items; it += NGW) transpose_item(W, K, N, WT, mode, ffh, scr, it, lane);
            start = (start + items) % NGW;
        };
        run(p.in[9], WSP(bf16, W_QKVA), DM, A_NQKV, 0, 0);
        run(p.in[12], WSP(bf16, W_OA), DM, DM, 0, 0);
        run(p.in[13], WSP(bf16, W_DOWN), DM, B_NDOWN, 0, 0);
        run(p.in[16], WSP(bf16, W_UQ), B_QL, B_NUQ, 0, 0);
        run(p.in[17], WSP(bf16, W_UKV), B_KVL, B_NUKV, 0, 0);
        run(p.in[18], WSP(bf16, W_OB), DM, DM, 0, 0);
        run(p.in[19], WSP(bf16, W_IN), DM, C_NIN, 0, 0);
        run(p.in[24], WSP(bf16, W_OUT), DM, DM, 0, 0);
        run(p.in[25], WSP(bf16, W_QKVD), DM, D_NQKV, 0, 0);
        run(p.in[27], WSP(bf16, W_OD), DM, DM, 0, 0);
        for (int l = 0; l < 2; ++l) {
            run(p.in[28] + (size_t)l * DM * 2 * FF, WSP(bf16, W_13F) + (size_t)l * 2 * FF * DM, DM, 2 * FF, 1, FF);
            run(p.in[29] + (size_t)l * FF * DM, WSP(bf16, W_2F) + (size_t)l * DM * FF, FF, DM, 2, 0);
        }
        for (int le = 0; le < 2 * NE; ++le) {
            run(p.in[31] + (size_t)le * DM * 2 * FE, WSP(bf16, W_13M) + (size_t)le * 2 * FE * DM, DM, 2 * FE, 1, FE);
            run(p.in[32] + (size_t)le * FE * DM, WSP(bf16, W_2M) + (size_t)le * DM * FE, FE, DM, 2, 0);
        }
        const int g = bid * 512 + tid, ng = nb * 512;
        for (int i = g; i < 64 * DM / 8; i += ng) *(u32x4*)(WSP(bf16, W_DOWN) + (size_t)B_NDOWN * DM + i * 8) = (u32x4){0u, 0u, 0u, 0u};
        for (int i = g; i < 8 * 128 * 128 / 4; i += ng) { const f32x4 v = *(const f32x4*)(p.in[22] + i * 4); *(u32x2*)(WSP(bf16, W_SP) + i * 4) = (u32x2){pk2(v.x, v.y), pk2(v.z, v.w)}; }
    }
}

__device__ __forceinline__ void moe_offsets_lds(const P& p, int m, LAS int* off  ) {
    const unsigned* cnt = WSP(const unsigned, WS_CTL) + CW_CNT + 64 * m; int o = 0;
    for (int e = 0; e < NE; ++e) { off[e] = o; const int c = (int)__hip_atomic_load(cnt + e, __ATOMIC_RELAXED, __HIP_MEMORY_SCOPE_AGENT); o += (c + 255) & ~255; }
    off[NE] = o;
}

template <int MODE>
__device__ __forceinline__ void phase_norm(const P& p, int wv, int bid, int nb, unsigned char* lds_, int layer, int which  , int m_prev, int prev_layer, int m_cur, bool route_ctx) {
    LAS unsigned char* lds = (LAS unsigned char*)lds_;
    const int tid = otid(wv), lane = tid & 63, wave = tid >> 6;
    const int per = (T + nb - 1) / nb, r0 = bid * per, r1 = min(T, r0 + per);
    LAS float* rt = (LAS float*)lds;
    LAS int* re = (LAS int*)(lds + 32768);
    LAS float* rw = (LAS float*)(lds + 32768 + 8192);
    LAS int* soff = (LAS int*)(lds + 32768 + 16384);
    if (MODE & 4) { const float* R = p.in[30] + (size_t)m_cur * DM * NE; for (int i = tid; i < DM * NE; i += 512) rt[i] = R[i]; }
    if (MODE & 2) { if (tid == 0) moe_offsets_lds(p, m_prev, soff); }
    __syncthreads();
    const float* gain = (MODE & 8) ? p.in[8] : (which == 0 ? p.in[6] : p.in[7]) + (size_t)layer * DM;
    int cur_mr = -1; f32x4 gm[4], shv[4], g2v[4];
#pragma unroll
    for (int q = 0; q < 4; ++q) { gm[q] = (f32x4){0.f, 0.f, 0.f, 0.f}; shv[q] = gm[q]; g2v[q] = gm[q]; }
    for (int r = r0 + wave; r < r1; r += 8) {
        int b, j; row_info(r, b, j); const bool isctx = j < NCTX;
        if ((MODE & 8) && isctx) continue;
        { const int mr = isctx ? 4 : b;
          if (mr != cur_mr) { cur_mr = mr;
            if (MODE & 2) { const float* g2 = mod_vec(p, prev_layer, r, 5);
#pragma unroll
                for (int q = 0; q < 4; ++q) g2v[q] = *(const f32x4*)(g2 + q * 256 + lane * 4); }
            if (MODE & 8) {
#pragma unroll
                for (int q = 0; q < 4; ++q) gm[q] = *(const f32x4*)(gain + q * 256 + lane * 4); }
            else { const float* sh_ = mod_vec(p, layer, r, which * 3 + 0); const float* sc_ = mod_vec(p, layer, r, which * 3 + 1);
#pragma unroll
                for (int q = 0; q < 4; ++q) { const f32x4 g = *(const f32x4*)(gain + q * 256 + lane * 4), s1 = *(const f32x4*)(sc_ + q * 256 + lane * 4); gm[q] = g * (s1 + 1.f); shv[q] = *(const f32x4*)(sh_ + q * 256 + lane * 4); } } } }
        f32x4 v[4];
        if (MODE & 1) { const float* src = in_row(p, r);
#pragma unroll
            for (int q = 0; q < 4; ++q) v[q] = *(const f32x4*)(src + q * 256 + lane * 4); }
        else { const bf16* src = WSP(const bf16, WS_H) + (size_t)r * DM;
#pragma unroll
            for (int q = 0; q < 4; ++q) { const u32x2 w = *(const u32x2*)(src + q * 256 + lane * 4); v[q] = (f32x4){bflo(w.x), bfhi(w.x), bflo(w.y), bfhi(w.y)}; } }
        if (MODE & 2) {
            const int4 tk = WSP(const int4, WS_TOK)[r];
            const bool routed = tk.x >= 0;
            if (routed) {
                const int s0 = soff[tk.x] + tk.y, s1 = soff[tk.z] + tk.w;
                const bf16* y0 = WSP(const bf16, WS_Y) + (size_t)s0 * DM; const bf16* y1 = WSP(const bf16, WS_Y) + (size_t)s1 * DM;
                const f32x2 tw = WSP(const f32x2, WS_TOKW)[r];
#pragma unroll
                for (int q = 0; q < 4; ++q) { const u32x2 a = *(const u32x2*)(y0 + q * 256 + lane * 4), c = *(const u32x2*)(y1 + q * 256 + lane * 4); const f32x4 g = g2v[q];
                    v[q].x += g.x * (tw.x * bflo(a.x) + tw.y * bflo(c.x)); v[q].y += g.y * (tw.x * bfhi(a.x) + tw.y * bfhi(c.x)); v[q].z += g.z * (tw.x * bflo(a.y) + tw.y * bflo(c.y)); v[q].w += g.w * (tw.x * bfhi(a.y) + tw.y * bfhi(c.y)); }
                if (!(MODE & 8)) {
#pragma unroll
                    for (int q = 0; q < 4; ++q) *(u32x2*)(WSP(bf16, WS_H) + (size_t)r * DM + q * 256 + lane * 4) = (u32x2){pk2(v[q].x, v[q].y), pk2(v[q].z, v[q].w)};
                }
            }
        }
        float ss = 0.f;
#pragma unroll
        for (int q = 0; q < 4; ++q) ss += (v[q].x * v[q].x + v[q].y * v[q].y) + (v[q].z * v[q].z + v[q].w * v[q].w);
        const float rs = rsqrtf(wave_sum(ss) * (1.f / DM) + EPS);
        if (MODE & 8) {
            float* o = p.out + ((size_t)b * SEQ + (j - NCTX)) * DM;
#pragma unroll
            for (int q = 0; q < 4; ++q) *(f32x4*)(o + q * 256 + lane * 4) = v[q] * rs * gm[q];
            continue;
        }
#pragma unroll
        for (int q = 0; q < 4; ++q) {
            v[q] = (v[q] * rs) * gm[q] + shv[q];
            *(u32x2*)(WSP(bf16, WS_A) + (size_t)r * DM + q * 256 + lane * 4) = (u32x2){pk2(v[q].x, v[q].y), pk2(v[q].z, v[q].w)}; }
        if (MODE & 4) {
            const int li = r - r0;
            if (isctx && !route_ctx) { if (lane == 0) { re[li * 2] = -1; re[li * 2 + 1] = -1; } }
            else {
                float lg[8];
#pragma unroll
                for (int e = 0; e < 8; ++e) lg[e] = 0.f;
#pragma unroll
                for (int q = 0; q < 4; ++q)
#pragma unroll
                    for (int c = 0; c < 4; ++c) { const int col = q * 256 + lane * 4 + c; const f32x4 w0 = *(LAS f32x4*)(rt + col * 8), w1 = *(LAS f32x4*)(rt + col * 8 + 4); const float a = v[q][c];
                        lg[0] += a * w0.x; lg[1] += a * w0.y; lg[2] += a * w0.z; lg[3] += a * w0.w; lg[4] += a * w1.x; lg[5] += a * w1.y; lg[6] += a * w1.z; lg[7] += a * w1.w; }
#pragma unroll
                for (int e = 0; e < 8; ++e) lg[e] = wave_sum(lg[e]);
                int e0 = 0; float v0 = lg[0];
#pragma unroll
                for (int e = 1; e < 8; ++e) if (lg[e] > v0) { v0 = lg[e]; e0 = e; }
                int e1 = -1; float v1 = -3.0e38f;
#pragma unroll
                for (int e = 0; e < 8; ++e) if (e != e0 && lg[e] > v1) { v1 = lg[e]; e1 = e; }
                const float w1 = 1.f / (1.f + __expf(v0 - v1)), w0 = 1.f - w1;
                if (lane == 0) { re[li * 2] = e0; re[li * 2 + 1] = e1; rw[li * 2] = w0; rw[li * 2 + 1] = w1; }
            }
        }
    }
    if (MODE & 4) {
        __syncthreads();
        { LAS int* wcnt = (LAS int*)(lds + 32768 + 16384 + 256); LAS int* woff = wcnt + 64;
          const int n2 = 2 * (r1 - r0);
          int* idxb = WSP(int, WS_IDX); float* gwb = WSP(float, WS_GW); int* tok = WSP(int, WS_TOK);
          for (int ib = 0; ib < n2; ib += 512) {
              const int i = ib + tid; const int ei = (i < n2) ? re[i] : -1; int rank = 0;
#pragma unroll
              for (int e = 0; e < NE; ++e) { const unsigned long long mk = __ballot(ei == e); if (ei == e) rank = __popcll(mk & ((1ull << lane) - 1ull)); if (lane == 0) wcnt[wave * 8 + e] = __popcll(mk); }
              __syncthreads();
              if (tid < NE) { int c = 0;
                  for (int w = 0; w < 8; ++w) c += wcnt[w * 8 + tid];
                  unsigned* cnt = WSP(unsigned, WS_CTL) + CW_CNT + 64 * m_cur + tid;
                  int base = c ? (int)__hip_atomic_fetch_add(cnt, (unsigned)c, __ATOMIC_RELAXED, __HIP_MEMORY_SCOPE_AGENT) : 0;
                  for (int w = 0; w < 8; ++w) { woff[w * 8 + tid] = base; base += wcnt[w * 8 + tid]; } }
              __syncthreads();
              if (ei >= 0) { const int pos = woff[wave * 8 + ei] + rank, r = r0 + (i >> 1); const float wgt = rw[i];
                  idxb[(size_t)ei * T + pos] = r; gwb[(size_t)ei * T + pos] = wgt; tok[r * 4 + (i & 1) * 2] = ei; tok[r * 4 + (i & 1) * 2 + 1] = pos; WSP(float, WS_TOKW)[r * 2 + (i & 1)] = wgt; }
              __syncthreads();
          } }
        for (int i = tid; i < r1 - r0; i += 512) if (re[i * 2] < 0) { int* tok = WSP(int, WS_TOK); const int r = r0 + i; tok[r * 4] = -1; tok[r * 4 + 1] = 0; tok[r * 4 + 2] = -1; tok[r * 4 + 3] = 0; }
    }
}

template <bool FINAL>
__device__ __forceinline__ void phase_combine(const P& p, int wv, int bid, int nb, unsigned char* lds_, int layer, int which, int m_prev, int prev_layer) {
    LAS unsigned char* lds = (LAS unsigned char*)lds_;
    const int tid = otid(wv), lane = tid & 63, wave = tid >> 6;
    const int per = (T + nb - 1) / nb, r0 = bid * per, r1 = min(T, r0 + per);
    LAS int* soff = (LAS int*)(lds + 32768 + 16384);
    if (tid == 0) moe_offsets_lds(p, m_prev, soff);
    __syncthreads();
    const float* gain = FINAL ? p.in[8] : (which == 0 ? p.in[6] : p.in[7]) + (size_t)layer * DM;
    int cur_mr = -1; f32x4 gm[4], shv[4], g2v[4];
#pragma unroll
    for (int q = 0; q < 4; ++q) { gm[q] = (f32x4){0.f, 0.f, 0.f, 0.f}; shv[q] = gm[q]; g2v[q] = gm[q]; }
    const int4* TOK = WSP(const int4, WS_TOK); const f32x2* TOKW = WSP(const f32x2, WS_TOKW);
    const bf16* Yb = WSP(const bf16, WS_Y); bf16* Hb = WSP(bf16, WS_H);
#define CMB_LOAD(hX, aX, cX, rr, tk) do { const bool _ro = (tk).x >= 0; const int _s0 = _ro ? soff[(tk).x] + (tk).y : 0, _s1 = _ro ? soff[(tk).z] + (tk).w : 0; \
        const bf16* _h = Hb + (size_t)(rr) * DM + lane * 4; const bf16* _y0 = Yb + (size_t)_s0 * DM + lane * 4; const bf16* _y1 = Yb + (size_t)_s1 * DM + lane * 4; \
        _Pragma("unroll") for (int q = 0; q < 4; ++q) { hX[q] = *(const u32x2*)(_h + q * 256); aX[q] = *(const u32x2*)(_y0 + q * 256); cX[q] = *(const u32x2*)(_y1 + q * 256); } } while (0)
    int r = r0 + wave;
    if (r < r1) {
        int4 tk_c = TOK[r]; f32x2 tw_c = TOKW[r];
        int4 tk_n = tk_c; f32x2 tw_n = tw_c; if (r + 8 < r1) { tk_n = TOK[r + 8]; tw_n = TOKW[r + 8]; }
        u32x2 hA[4], aA[4], cA[4];
        CMB_LOAD(hA, aA, cA, r, tk_c);
        for (; r < r1; r += 8) {
            u32x2 hB[4], aB[4], cB[4];
#pragma unroll
            for (int q = 0; q < 4; ++q) { hB[q] = hA[q]; aB[q] = aA[q]; cB[q] = cA[q]; }
            if (r + 8 < r1) CMB_LOAD(hB, aB, cB, r + 8, tk_n);
            int4 tk_nn = tk_n; f32x2 tw_nn = tw_n; if (r + 16 < r1) { tk_nn = TOK[r + 16]; tw_nn = TOKW[r + 16]; }
            int b, j; row_info(r, b, j); const bool isctx = j < NCTX;
            if (!(FINAL && isctx)) {
                const int mr = isctx ? 4 : b;
                if (mr != cur_mr) { cur_mr = mr; const float* g2 = mod_vec(p, prev_layer, r, 5);
#pragma unroll
                    for (int q = 0; q < 4; ++q) g2v[q] = *(const f32x4*)(g2 + q * 256 + lane * 4);
                    if (FINAL) {
#pragma unroll
                        for (int q = 0; q < 4; ++q) gm[q] = *(const f32x4*)(gain + q * 256 + lane * 4); }
                    else { const float* sh_ = mod_vec(p, layer, r, which * 3 + 0); const float* sc_ = mod_vec(p, layer, r, which * 3 + 1);
#pragma unroll
                        for (int q = 0; q < 4; ++q) { const f32x4 g = *(const f32x4*)(gain + q * 256 + lane * 4), s1 = *(const f32x4*)(sc_ + q * 256 + lane * 4); gm[q] = g * (s1 + 1.f); shv[q] = *(const f32x4*)(sh_ + q * 256 + lane * 4); } } }
                f32x4 v[4];
#pragma unroll
                for (int q = 0; q < 4; ++q) v[q] = (f32x4){bflo(hA[q].x), bfhi(hA[q].x), bflo(hA[q].y), bfhi(hA[q].y)};
                if (tk_c.x >= 0) {
#pragma unroll
                    for (int q = 0; q < 4; ++q) { const u32x2 a = aA[q], c = cA[q]; const f32x4 g = g2v[q];
                        v[q].x += g.x * (tw_c.x * bflo(a.x) + tw_c.y * bflo(c.x)); v[q].y += g.y * (tw_c.x * bfhi(a.x) + tw_c.y * bfhi(c.x)); v[q].z += g.z * (tw_c.x * bflo(a.y) + tw_c.y * bflo(c.y)); v[q].w += g.w * (tw_c.x * bfhi(a.y) + tw_c.y * bfhi(c.y)); }
                    if (!FINAL) {
#pragma unroll
                        for (int q = 0; q < 4; ++q) *(u32x2*)(Hb + (size_t)r * DM + q * 256 + lane * 4) = (u32x2){pk2(v[q].x, v[q].y), pk2(v[q].z, v[q].w)}; }
                }
                float ss = 0.f;
#pragma unroll
                for (int q = 0; q < 4; ++q) ss += (v[q].x * v[q].x + v[q].y * v[q].y) + (v[q].z * v[q].z + v[q].w * v[q].w);
                const float rs = rsqrtf(wave_sum(ss) * (1.f / DM) + EPS);
                if (FINAL) { float* o = p.out + ((size_t)b * SEQ + (j - NCTX)) * DM;
#pragma unroll
                    for (int q = 0; q < 4; ++q) *(f32x4*)(o + q * 256 + lane * 4) = v[q] * rs * gm[q]; }
                else {
#pragma unroll
                    for (int q = 0; q < 4; ++q) { const f32x4 o = (v[q] * rs) * gm[q] + shv[q]; *(u32x2*)(WSP(bf16, WS_A) + (size_t)r * DM + q * 256 + lane * 4) = (u32x2){pk2(o.x, o.y), pk2(o.z, o.w)}; } }
            }
#pragma unroll
            for (int q = 0; q < 4; ++q) { hA[q] = hB[q]; aA[q] = aB[q]; cA[q] = cB[q]; }
            tk_c = tk_n; tw_c = tw_n; tk_n = tk_nn; tw_n = tw_nn;
        }
    }
#undef CMB_LOAD
}

template <bool FROM_IN>
__device__ __forceinline__ void phase_norm_plain(const P& p, int wv, int bid, int nb, int layer, int which) {
    const int tid = otid(wv), lane = tid & 63, wave = tid >> 6;
    const int per = (T + nb - 1) / nb, r0 = bid * per, r1 = min(T, r0 + per);
    const float* gain = (which == 0 ? p.in[6] : p.in[7]) + (size_t)layer * DM;
    int cur_mr = -1; f32x4 gm[4], shv[4];
#pragma unroll
    for (int q = 0; q < 4; ++q) { gm[q] = (f32x4){0.f, 0.f, 0.f, 0.f}; shv[q] = gm[q]; }
    for (int r = r0 + wave; r < r1; r += 16) {
        const int ra = r, rb = (r + 8 < r1) ? r + 8 : r;
        f32x4 va[4], vb[4];
        if (FROM_IN) { const float* sa = in_row(p, ra); const float* sb = in_row(p, rb);
#pragma unroll
            for (int q = 0; q < 4; ++q) { va[q] = *(const f32x4*)(sa + q * 256 + lane * 4); vb[q] = *(const f32x4*)(sb + q * 256 + lane * 4); } }
        else { const bf16* sa = WSP(const bf16, WS_H) + (size_t)ra * DM; const bf16* sb = WSP(const bf16, WS_H) + (size_t)rb * DM; u32x2 wa[4], wb[4];
#pragma unroll
            for (int q = 0; q < 4; ++q) { wa[q] = *(const u32x2*)(sa + q * 256 + lane * 4); wb[q] = *(const u32x2*)(sb + q * 256 + lane * 4); }
#pragma unroll
            for (int q = 0; q < 4; ++q) { va[q] = (f32x4){bflo(wa[q].x), bfhi(wa[q].x), bflo(wa[q].y), bfhi(wa[q].y)}; vb[q] = (f32x4){bflo(wb[q].x), bfhi(wb[q].x), bflo(wb[q].y), bfhi(wb[q].y)}; } }
        float sa2 = 0.f, sb2 = 0.f;
#pragma unroll
        for (int q = 0; q < 4; ++q) { sa2 += (va[q].x * va[q].x + va[q].y * va[q].y) + (va[q].z * va[q].z + va[q].w * va[q].w); sb2 += (vb[q].x * vb[q].x + vb[q].y * vb[q].y) + (vb[q].z * vb[q].z + vb[q].w * vb[q].w); }
        const float rsa = rsqrtf(wave_sum(sa2) * (1.f / DM) + EPS), rsb = rsqrtf(wave_sum(sb2) * (1.f / DM) + EPS);
#pragma unroll
        for (int half = 0; half < 2; ++half) {
            const int rr = half ? rb : ra; int b, j; row_info(rr, b, j); const int mr = (j < NCTX) ? 4 : b;
            if (mr != cur_mr) { cur_mr = mr; const float* sh_ = mod_vec(p, layer, rr, which * 3 + 0); const float* sc_ = mod_vec(p, layer, rr, which * 3 + 1);
#pragma unroll
                for (int q = 0; q < 4; ++q) { const f32x4 g = *(const f32x4*)(gain + q * 256 + lane * 4), s1 = *(const f32x4*)(sc_ + q * 256 + lane * 4); gm[q] = g * (s1 + 1.f); shv[q] = *(const f32x4*)(sh_ + q * 256 + lane * 4); } }
            const float rs = half ? rsb : rsa;
#pragma unroll
            for (int q = 0; q < 4; ++q) { const f32x4 o = ((half ? vb[q] : va[q]) * rs) * gm[q] + shv[q];
                *(u32x2*)(WSP(bf16, WS_A) + (size_t)rr * DM + q * 256 + lane * 4) = (u32x2){pk2(o.x, o.y), pk2(o.z, o.w)}; }
        }
    }
}

__device__ __forceinline__ void phase_post_a(const P& p, int wv, int bid, int nb) {
    const int tid = otid(wv), hw = (bid * 512 + tid) >> 5, nhw = nb * 16, l = tid & 31;
    const f32x2* cs = WSP(const f32x2, WS_ROPE128);
    for (int it = hw; it < T * 10; it += nhw) {
        const int r = it / 10, h = it - r * 10; int b, j; row_info(r, b, j);
        bf16* ptr = WSP(bf16, WS_QKV) + (size_t)r * A_NQKV + h * 128 + l * 4;
        const u32x2 raw = *(const u32x2*)ptr; float x[4] = {bflo(raw.x), bfhi(raw.x), bflo(raw.y), bfhi(raw.y)};
        float ss = x[0] * x[0] + x[1] * x[1] + x[2] * x[2] + x[3] * x[3];
#pragma unroll
        for (int o = 1; o < 32; o <<= 1) ss += __shfl_xor(ss, o);
        const float rs = rsqrtf(ss * (1.f / 128.f) + EPS);
        const float* w = (h < 8 ? p.in[10] : p.in[11]) + l * 4;
#pragma unroll
        for (int e = 0; e < 4; ++e) x[e] = x[e] * rs * w[e];
        float y[4];
        if (j >= NCTX) {
            const int s = j - NCTX, pos = (l < 16) ? (s / GRIDW) : (s % GRIDW);
            const bool second = (l & 8) != 0;
#pragma unroll
            for (int e = 0; e < 4; ++e) { const float o = __shfl_xor(x[e], 8); const int f = ((l & 7) * 4 + e); const f32x2 c = cs[pos * 32 + f];
                y[e] = second ? (x[e] * c.x + o * c.y) : (x[e] * c.x - o * c.y); }
        } else {
#pragma unroll
            for (int e = 0; e < 4; ++e) y[e] = x[e];
        }
        *(u32x2*)ptr = (u32x2){pk2(y[0], y[1]), pk2(y[2], y[3])};
    }
}
__device__ __forceinline__ void phase_post_b1(const P& p, int wv, int bid, int nb) {
    const int tid = otid(wv), lane = tid & 63, gw = bid * 8 + (tid >> 6), ngw = nb * 8;
    const f32x2* cs = WSP(const f32x2, WS_ROPE64);
    for (int r = gw; r < T; r += ngw) {
        int b, j; row_info(r, b, j);
        const bf16* d = WSP(const bf16, WS_DOWN) + (size_t)r * B_NDOWN_P;
        float q[6], kv[4];
        float s1 = 0.f, s2 = 0.f;
#pragma unroll
        for (int i = 0; i < 6; ++i) { q[i] = bf2f(d[i * 64 + lane]); s1 += q[i] * q[i]; }
#pragma unroll
        for (int i = 0; i < 4; ++i) { kv[i] = bf2f(d[384 + i * 64 + lane]); s2 += kv[i] * kv[i]; }
        float kr = bf2f(d[640 + lane]);
        const float r1 = rsqrtf(wave_sum(s1) * (1.f / 384.f) + EPS), r2 = rsqrtf(wave_sum(s2) * (1.f / 256.f) + EPS);
#pragma unroll
        for (int i = 0; i < 6; ++i) WSP(bf16, WS_DQN)[(size_t)r * B_QL + i * 64 + lane] = (bf16)f2bf(q[i] * r1 * p.in[14][i * 64 + lane]);
#pragma unroll
        for (int i = 0; i < 4; ++i) WSP(bf16, WS_DKVN)[(size_t)r * B_KVL + i * 64 + lane] = (bf16)f2bf(kv[i] * r2 * p.in[15][i * 64 + lane]);
        if (j >= NCTX) {
            const int s = j - NCTX, pos = (lane < 32) ? (s / GRIDW) : (s % GRIDW); const float o = __shfl_xor(kr, 16); const f32x2 c = cs[pos * 16 + (lane & 15)];
            kr = (lane & 16) ? (kr * c.x + o * c.y) : (kr * c.x - o * c.y);
        }
        const bf16 krb = (bf16)f2bf(kr);
#pragma unroll
        for (int h = 0; h < 8; ++h) WSP(bf16, WS_KB)[(size_t)r * 1536 + h * 192 + 128 + lane] = krb;
    }
}
__device__ __forceinline__ void phase_rope64(const P& p, int wv, int bid, int nb, bf16* buf, int ld, int nh, int hs, int off) {
    const int tid = otid(wv), lane = tid & 63, gw = bid * 8 + (tid >> 6), ngw = nb * 8;
    const f32x2* cs = WSP(const f32x2, WS_ROPE64);
    for (int r = gw; r < T; r += ngw) {
        int b, j; row_info(r, b, j); if (j < NCTX) continue;
        const int s = j - NCTX, pos = (lane < 32) ? (s / GRIDW) : (s % GRIDW); const f32x2 c = cs[pos * 16 + (lane & 15)];
        for (int h = 0; h < nh; ++h) { bf16* q = buf + (size_t)r * ld + h * hs + off + lane; const float x = bf2f(*q), o = __shfl_xor(x, 16);
            *q = (bf16)f2bf((lane & 16) ? (x * c.x + o * c.y) : (x * c.x - o * c.y)); }
    }
}

__device__ __forceinline__ void phase_sgu_simple(const P& p, int wv, int bid, int nb, unsigned char* lds_) {
    LAS unsigned char* lds = (LAS unsigned char*)lds_;
    const int tid = otid(wv), lane = tid & 63, wave = tid >> 6;
    LAS float* mean = (LAS float*)lds; LAS float* rstd = mean + 128; LAS float* vl = (LAS float*)(lds + 1024);
    const bf16* U = WSP(const bf16, WS_QKV); const bf16* V = WSP(const bf16, WS_KB); bf16* Mo = WSP(bf16, WS_VB);
    const float* Wsp = p.in[22]; const float* bsp = p.in[23];
    for (int ch = bid; ch < T / 128; ch += nb) {
        const int row0 = ch * 128;
        __syncthreads();
        for (int rr = wave; rr < 128; rr += 8) { const bf16* vr = V + (size_t)(row0 + rr) * DM; float x[16]; float s = 0.f;
#pragma unroll
            for (int i = 0; i < 16; ++i) { x[i] = bf2f(vr[i * 64 + lane]); s += x[i]; }
            const float mu = wave_sum(s) * (1.f / 1024.f); float q = 0.f;
#pragma unroll
            for (int i = 0; i < 16; ++i) { const float d = x[i] - mu; q += d * d; }
            const float var = wave_sum(q) * (1.f / 1024.f);
            if (lane == 0) { mean[rr] = mu; rstd[rr] = rsqrtf(var + EPS); } }
        for (int g = 0; g < 8; ++g) {
            __syncthreads();
            for (int i = tid; i < 128 * 128; i += 512) { const int q = i >> 7, c = i & 127, col = g * 128 + c;
                const float x = bf2f(V[(size_t)(row0 + q) * DM + col]); vl[i] = bf2f(f2bf((x - mean[q]) * rstd[q] * p.in[20][col] + p.in[21][col])); }
            __syncthreads();
            const int pp = tid >> 2, c0 = (tid & 3) * 32;
            float acc[32];
#pragma unroll
            for (int i = 0; i < 32; ++i) acc[i] = 0.f;
            const float* wrow = Wsp + ((size_t)g * 128 + pp) * 128;
            for (int q = 0; q < 128; ++q) { const float w = bf2f(f2bf(wrow[q]));
#pragma unroll
                for (int i = 0; i < 32; ++i) acc[i] += w * vl[q * 128 + c0 + i]; }
            const float bb = bsp[g * 128 + pp];
#pragma unroll
            for (int i = 0; i < 32; ++i) { const size_t o = (size_t)(row0 + pp) * DM + g * 128 + c0 + i; Mo[o] = (bf16)f2bf(bf2f(U[o]) * (acc[i] + bb)); }
        }
    }
}

__device__ __forceinline__ void phase_sgu(const P& p, int wv, int bid, int nb, unsigned char* lds_) {
    using f32x16 = __attribute__((ext_vector_type(16))) float;
    LAS unsigned char* lds = (LAS unsigned char*)lds_;
    const int tid = otid(wv), lane = tid & 63, wave = tid >> 6, r32 = lane & 31, hi = lane >> 5;
    constexpr int VT_ROW = 272, VT_BYTES = 128 * VT_ROW;
    LAS unsigned char* vT = lds; LAS unsigned char* oT = lds + 2 * VT_BYTES;
    const bf16* U = WSP(const bf16, WS_QKV); const bf16* V = WSP(const bf16, WS_KB); bf16* Mo = WSP(bf16, WS_VB);
    const bf16* Wsp = WSP(const bf16, W_SP); const float* bsp = p.in[23]; const float* lng = p.in[20]; const float* lnb = p.in[21];
    const int pb = wave & 3, cbh = wave >> 2;
    const int sq = tid >> 2, sc0 = (tid & 3) * 32;
    const int nch = T / 128, nfull = (nch / nb) * nb, ntail = (nch - nfull) * 8;
    for (int ui = bid; ui < nfull + ntail; ui += nb) {
        int ch, g0, g1; if (ui < nfull) { ch = ui; g0 = 0; g1 = 8; } else { ch = nfull + ((ui - nfull) >> 3); g0 = (ui - nfull) & 7; g1 = g0 + 1; }
        const int row0 = ch * 128;
        const bf16* vrow = V + (size_t)(row0 + sq) * DM; const bf16* urow = U + (size_t)(row0 + sq) * DM; bf16* mrow = Mo + (size_t)(row0 + sq) * DM;
        float s1 = 0.f, s2 = 0.f;
#pragma unroll
        for (int hb = 0; hb < 2; ++hb) { u32x4 w[16];
#pragma unroll
            for (int j = 0; j < 16; ++j) w[j] = *(const u32x4*)(vrow + (tid & 3) * 256 + hb * 128 + j * 8);
#pragma unroll
            for (int j = 0; j < 16; ++j) { const float x0 = bflo(w[j].x), x1 = bfhi(w[j].x), x2 = bflo(w[j].y), x3 = bfhi(w[j].y), x4 = bflo(w[j].z), x5 = bfhi(w[j].z), x6 = bflo(w[j].w), x7 = bfhi(w[j].w);
                s1 += ((x0 + x1) + (x2 + x3)) + ((x4 + x5) + (x6 + x7)); s2 += ((x0 * x0 + x1 * x1) + (x2 * x2 + x3 * x3)) + ((x4 * x4 + x5 * x5) + (x6 * x6 + x7 * x7)); } }
        s1 += __shfl_xor(s1, 1); s2 += __shfl_xor(s2, 1); s1 += __shfl_xor(s1, 2); s2 += __shfl_xor(s2, 2);
        const float mq = s1 * (1.f / 1024.f), rq = rsqrtf(fmaxf(s2 * (1.f / 1024.f) - mq * mq, 0.f) + EPS);
        u32x4 vreg[4], ureg[4];
#pragma unroll
        for (int j = 0; j < 4; ++j) { vreg[j] = *(const u32x4*)(vrow + g0 * 128 + sc0 + j * 8); ureg[j] = *(const u32x4*)(urow + g0 * 128 + sc0 + j * 8); }
#pragma unroll 1
        for (int g = g0; g < g1; ++g) {
            LAS unsigned char* buf = vT + (g & 1) * VT_BYTES;
            { const float* gg = lng + g * 128 + sc0; const float* gb = lnb + g * 128 + sc0;
#pragma unroll
              for (int j = 0; j < 4; ++j) { const u32x4 w = vreg[j]; const f32x4 ga = *(const f32x4*)(gg + j * 8), gc = *(const f32x4*)(gg + j * 8 + 4), ba = *(const f32x4*)(gb + j * 8), bc = *(const f32x4*)(gb + j * 8 + 4);
                  const float xv[8] = {bflo(w.x), bfhi(w.x), bflo(w.y), bfhi(w.y), bflo(w.z), bfhi(w.z), bflo(w.w), bfhi(w.w)}; const float gv[8] = {ga.x, ga.y, ga.z, ga.w, gc.x, gc.y, gc.z, gc.w}; const float bv[8] = {ba.x, ba.y, ba.z, ba.w, bc.x, bc.y, bc.z, bc.w};
#pragma unroll
                  for (int e = 0; e < 8; ++e) *(LAS bf16*)(buf + (sc0 + j * 8 + e) * VT_ROW + sq * 2) = (bf16)f2bf((xv[e] - mq) * rq * gv[e] + bv[e]); } }
            const u32x4 u0 = ureg[0], u1 = ureg[1], u2 = ureg[2], u3 = ureg[3];
            if (g + 1 < g1) {
#pragma unroll
                for (int j = 0; j < 4; ++j) { vreg[j] = *(const u32x4*)(vrow + (g + 1) * 128 + sc0 + j * 8); ureg[j] = *(const u32x4*)(urow + (g + 1) * 128 + sc0 + j * 8); } }
            bf16x8 af[8];
            { const bf16* wr = Wsp + ((size_t)g * 128 + pb * 32 + r32) * 128 + hi * 8;
#pragma unroll
              for (int ks = 0; ks < 8; ++ks) af[ks] = *(const bf16x8*)(wr + ks * 16); }
            float bias[16];
#pragma unroll
            for (int r = 0; r < 16; ++r) bias[r] = bsp[g * 128 + pb * 32 + (r & 3) + 8 * (r >> 2) + 4 * hi];
            __syncthreads();
#pragma unroll
            for (int t = 0; t < 2; ++t) { f32x16 acc = f32x16{}; const LAS unsigned char* br = buf + ((cbh * 2 + t) * 32 + r32) * VT_ROW + hi * 16;
#pragma unroll
                for (int ks = 0; ks < 8; ++ks) { const bf16x8 bfr = *(const LAS bf16x8*)(br + ks * 32); acc = __builtin_amdgcn_mfma_f32_32x32x16_bf16(af[ks], bfr, acc, 0, 0, 0); }
#pragma unroll
                for (int r = 0; r < 16; ++r) { const int pr = pb * 32 + (r & 3) + 8 * (r >> 2) + 4 * hi; *(LAS bf16*)(oT + pr * VT_ROW + ((cbh * 2 + t) * 32 + r32) * 2) = (bf16)f2bf(acc[r] + bias[r]); } }
            __syncthreads();
            { const u32x4 uu[4] = {u0, u1, u2, u3};
#pragma unroll
              for (int j = 0; j < 4; ++j) { const u32x4 mx = *(const LAS u32x4*)(oT + sq * VT_ROW + (sc0 + j * 8) * 2); u32x4 o;
                  o.x = pk2(bflo(uu[j].x) * bflo(mx.x), bfhi(uu[j].x) * bfhi(mx.x)); o.y = pk2(bflo(uu[j].y) * bflo(mx.y), bfhi(uu[j].y) * bfhi(mx.y));
                  o.z = pk2(bflo(uu[j].z) * bflo(mx.z), bfhi(uu[j].z) * bfhi(mx.z)); o.w = pk2(bflo(uu[j].w) * bflo(mx.w), bfhi(uu[j].w) * bfhi(mx.w));
                  *(u32x4*)(mrow + g * 128 + sc0 + j * 8) = o; } }
        }
        __syncthreads();
    }
}

namespace pg8 {
constexpr int BM = 256, BK = 64, HALF = 128, HTB = HALF * BK * 2, STAGE_BYTES = 8 * HTB, NXCD = 8, WGM = 4;
__host__ __device__ __forceinline__ int lds_byte(int r, int c) { const int st = (r >> 4) * 2 + (c >> 5), rr = r & 15, cc = c & 31, ob = rr * 64 + cc * 2; return st * 1024 + (ob ^ (((ob >> 9) & 1) << 5)); }
__host__ __device__ __forceinline__ void stage_rc(int b, int& R, int& C) { const int st = b / 1024, sb = b % 1024, swz = sb ^ (((sb >> 9) & 1) << 5); R = (st >> 1) * 16 + swz / 64; C = (st & 1) * 32 + (swz % 64) / 2; }
__host__ __device__ __forceinline__ int perm32(int rho) { const int n = rho >> 4, i = rho & 15; return 8 * (i >> 2) + 4 * n + (i & 3); }
struct Unit { int pm, pn, e, sub; };
struct Sched {
    int nM, nN, nwg, G, c; const LAS int* tl; int grouped, part, skipctx;
    __device__ __forceinline__ void init(int nM_, int nN_, int G_, int c_, const LAS int* tl_, int grouped_, int part_ = 0, int skipctx_ = 0) { nM = nM_; nN = nN_; nwg = nM * nN; G = G_; c = c_; tl = tl_; grouped = grouped_; part = part_; skipctx = skipctx_; }
    __device__ __forceinline__ bool next(int i, Unit& u) const {
        long L = (long)i * G + c; int sub = 0;
        const int full = (nwg / G) * G, R = nwg - full;
        if (part == 1 && L >= full) return false;
        if (part == 2) { if (i > 0 || R == 0) return false;
            if (4 * R <= G) { const int uu = (c >> 5) * 8 + (c & 7); if (uu >= R) return false; L = full + uu; sub = 1 + ((c >> 3) & 3); }
            else { if (c >= R) return false; L = full + c; } }
        if (L >= nwg) return false;
        int wgid = (int)L; { const int q = nwg / NXCD, r = nwg % NXCD, xcd = wgid % NXCD, off = wgid / NXCD; wgid = (xcd < r ? xcd * (q + 1) : r * (q + 1) + (xcd - r) * q) + off; }
        const int nig = WGM * nN, gid = wgid / nig, fm = gid * WGM, gsz = (nM - fm) < WGM ? (nM - fm) : WGM;
        u.pm = fm + ((wgid % nig) % gsz); u.pn = (wgid % nig) / gsz; int e = 0;
        if (grouped) {
#pragma unroll
            for (int x = 1; x < 8; ++x) e += (u.pm >= tl[x]) ? 1 : 0; }
        if (skipctx) u.pm = u.pm + (u.pm >> 5) + 1;
        u.e = e; u.sub = sub; return true;
    }
};
__device__ __forceinline__ unsigned cvt_pk_bf16(float lo, float hi) { unsigned r; asm volatile("v_cvt_pk_bf16_f32 %0, %1, %2" : "=v"(r) : "v"(lo), "v"(hi)); return r; }
__device__ __forceinline__ f32x2 gelu_pk(f32x2 v) {
    const f32x2 av = __builtin_elementwise_abs(v), d = av * 0.2316418882f + 1.0f;
    f32x2 t; t.x = __builtin_amdgcn_rcpf(d.x); t.y = __builtin_amdgcn_rcpf(d.y);
    f32x2 q = t * 0.5307027145f + (-0.7265760135f); q = q * t + 0.7107068705f; q = q * t + (-0.142248368f); q = q * t + 0.127414796f; q = q * t;
    const f32x2 s = (v * v) * (-0.72134752044f);
    f32x2 e; e.x = __builtin_amdgcn_exp2f(s.x); e.y = __builtin_amdgcn_exp2f(s.y);
    const f32x2 m = v * (q * e), r = v - m;
    f32x2 o; o.x = v.x < 0.f ? m.x : r.x; o.y = v.y < 0.f ? m.y : r.y; return o;
}
typedef f32x4 Acc[2][2][4][2];
__device__ __forceinline__ u32x4 pack8(f32x4 v0, f32x4 v1) { u32x4 w; w.x = cvt_pk_bf16(v0[0], v0[1]); w.y = cvt_pk_bf16(v0[2], v0[3]); w.z = cvt_pk_bf16(v1[0], v1[1]); w.w = cvt_pk_bf16(v1[2], v1[3]); return w; }
template <int ROPE>
struct EpiStoreT {
    static constexpr bool PERM = true;
    bf16* O; int ld; const f32x2* cs;
    __device__ __forceinline__ void operator()(const Acc& acc, const Unit& u, int wr, int wc, int fr, int fq) const {
        const int row0 = u.pm * BM + wr * 64 + fr, col0 = u.pn * BM + wc * 32 + 8 * fq;
        const int tb = (u.pm * BM) / RPB, tj = u.pm * BM - tb * RPB; const bool lat = tj >= NCTX;
#pragma unroll
        for (int ai = 0; ai < 2; ++ai)
#pragma unroll
            for (int m = 0; m < 4; ++m) { const int row = row0 + ai * HALF + m * 16; bf16* rowp = O + (size_t)row * ld + col0;
                const int spos = row - tb * RPB - NCTX;
#pragma unroll
                for (int bj = 0; bj < 2; ++bj) { if (SUB_SKIP(u, ai, bj)) continue;
                    f32x4 v0 = acc[ai][bj][m][0], v1 = acc[ai][bj][m][1];
                    if constexpr (ROPE != 0) {
                        const int slab = u.pn * 8 + bj * 4 + wc; bool rot; int axis;
                        if (ROPE == 1) { const int sm = slab % 6; rot = sm >= 4; axis = sm - 4; } else { rot = slab < 36; axis = slab & 1; }
                        if (rot && lat) {
                            const int pos = axis ? (spos & (GRIDW - 1)) : (spos / GRIDW); const f32x2* c = cs + pos * 16 + 8 * (fq & 1);
                            const f32x4 c0 = *(const f32x4*)(c), c1 = *(const f32x4*)(c + 2), c2 = *(const f32x4*)(c + 4), c3 = *(const f32x4*)(c + 6);
                            const float cc[8] = {c0.x, c0.z, c1.x, c1.z, c2.x, c2.z, c3.x, c3.z}, sn[8] = {c0.y, c0.w, c1.y, c1.w, c2.y, c2.w, c3.y, c3.w};
                            const float sg = (fq & 2) ? 1.f : -1.f;
                            float x[8] = {v0[0], v0[1], v0[2], v0[3], v1[0], v1[1], v1[2], v1[3]};
#pragma unroll
                            for (int e = 0; e < 8; ++e) { const auto rr = __builtin_amdgcn_permlane32_swap(__float_as_uint(x[e]), __float_as_uint(x[e]), false, false);
                                const float o = __uint_as_float((fq & 2) ? rr[0] : rr[1]); x[e] = x[e] * cc[e] + sg * o * sn[e]; }
                            v0 = (f32x4){x[0], x[1], x[2], x[3]}; v1 = (f32x4){x[4], x[5], x[6], x[7]};
                        }
                    }
                    *(u32x4*)(rowp + bj * HALF) = pack8(v0, v1); } }
    }
};
typedef EpiStoreT<0> EpiStore;
struct EpiKV {
    static constexpr bool PERM = true;
    bf16* Kb; bf16* Vb;
    __device__ __forceinline__ void operator()(const Acc& acc, const Unit& u, int wr, int wc, int fr, int fq) const {
        const int row0 = u.pm * BM + wr * 64 + fr, c0 = wc * 32 + 8 * fq;
#pragma unroll
        for (int ai = 0; ai < 2; ++ai)
#pragma unroll
            for (int m = 0; m < 4; ++m) { const size_t r = (size_t)(row0 + ai * HALF + m * 16);
                if (!SUB_SKIP(u, ai, 0)) *(u32x4*)(Kb + r * 1536 + u.pn * 192 + c0) = pack8(acc[ai][0][m][0], acc[ai][0][m][1]);
                if (!SUB_SKIP(u, ai, 1)) *(u32x4*)(Vb + r * DM + u.pn * 128 + c0) = pack8(acc[ai][1][m][0], acc[ai][1][m][1]); }
    }
};
struct EpiGelu {
    static constexpr bool PERM = true;
    bf16* U; bf16* V;
    __device__ __forceinline__ void operator()(const Acc& acc, const Unit& u, int wr, int wc, int fr, int fq) const {
        const int row0 = u.pm * BM + wr * 64 + fr; bf16* base = u.pn < 4 ? U : V; const int col0 = (u.pn & 3) * BM + wc * 32 + 8 * fq;
#pragma unroll
        for (int ai = 0; ai < 2; ++ai)
#pragma unroll
            for (int m = 0; m < 4; ++m) { bf16* rowp = base + (size_t)(row0 + ai * HALF + m * 16) * DM + col0;
#pragma unroll
                for (int bj = 0; bj < 2; ++bj) { if (SUB_SKIP(u, ai, bj)) continue; const f32x4 v0 = acc[ai][bj][m][0], v1 = acc[ai][bj][m][1];
                    const f32x2 a = gelu_pk((f32x2){v0[0], v0[1]}), b = gelu_pk((f32x2){v0[2], v0[3]}), c = gelu_pk((f32x2){v1[0], v1[1]}), d = gelu_pk((f32x2){v1[2], v1[3]});
                    *(u32x4*)(rowp + bj * HALF) = pack8((f32x4){a.x, a.y, b.x, b.y}, (f32x4){c.x, c.y, d.x, d.y}); } }
    }
};
struct EpiSwiglu {
    static constexpr bool PERM = true;
    bf16* O; int ld;
    __device__ __forceinline__ void operator()(const Acc& acc, const Unit& u, int wr, int wc, int fr, int fq) const {
        const int rl0 = wr * 64 + fr, nkt = ld >> 6;
        bf16* base = O + ((size_t)u.pm * nkt + (u.pn * 2 + (wc >> 1))) * (BM * BK) + (wc & 1) * 32 + 8 * fq;
#pragma unroll
        for (int ai = 0; ai < 2; ++ai)
#pragma unroll
            for (int m = 0; m < 4; ++m) { f32x4 o[2];
#pragma unroll
                for (int n = 0; n < 2; ++n) { const f32x4 a = acc[ai][0][m][n], b = acc[ai][1][m][n];
#pragma unroll
                    for (int k = 0; k < 4; ++k) o[n][k] = a[k] * __builtin_amdgcn_rcpf(1.f + __builtin_amdgcn_exp2f(-1.4426950408889634f * a[k])) * b[k]; }
                *(u32x4*)(base + (size_t)(rl0 + ai * HALF + m * 16) * BK) = pack8(o[0], o[1]); }
    }
};
struct EpiResid {
    static constexpr bool PERM = true;
    const float* x; const float* ctx; unsigned char* ws; int layer, chunk, from_in;
    __device__ __forceinline__ void operator()(const Acc& acc, const Unit& u, int wr, int wc, int fr, int fq) const {
        P p; p.in[0] = x; p.in[2] = ctx; p.ws = ws;
        const int r0 = u.pm * BM; const float* gate = mod_vec(p, layer, r0, chunk);
        const float* xin0 = in_row(p, r0); bf16* h0 = (bf16*)(ws + WS_H) + (size_t)r0 * DM;
        const int rl0 = wr * 64 + fr, col0 = u.pn * BM + wc * 32 + 8 * fq;
        f32x4 g0v[2], g1v[2];
#pragma unroll
        for (int bj = 0; bj < 2; ++bj) { g0v[bj] = *(const f32x4*)(gate + col0 + bj * HALF); g1v[bj] = *(const f32x4*)(gate + col0 + bj * HALF + 4); }
        u32x4 nx[2] = {(u32x4){0u, 0u, 0u, 0u}, (u32x4){0u, 0u, 0u, 0u}};
        if (!from_in) {
#pragma unroll
            for (int bj = 0; bj < 2; ++bj) { if (SUB_SKIP(u, 0, bj)) continue; nx[bj] = *(const u32x4*)(h0 + (size_t)rl0 * DM + col0 + bj * HALF); } }
#pragma unroll
        for (int it = 0; it < 8; ++it) { const int ai = it >> 2, m = it & 3; const size_t off = (size_t)(rl0 + ai * HALF + m * 16) * DM + col0;
            const u32x4 cu0 = nx[0], cu1 = nx[1];
            if (!from_in && it + 1 < 8) { const int ai2 = (it + 1) >> 2, m2 = (it + 1) & 3; const size_t off2 = (size_t)(rl0 + ai2 * HALF + m2 * 16) * DM + col0;
#pragma unroll
                for (int bj = 0; bj < 2; ++bj) { if (SUB_SKIP(u, ai2, bj)) continue; nx[bj] = *(const u32x4*)(h0 + off2 + bj * HALF); } }
#pragma unroll
            for (int bj = 0; bj < 2; ++bj) { if (SUB_SKIP(u, ai, bj)) continue; const f32x4 g0 = g0v[bj], g1 = g1v[bj]; f32x4 s0, s1;
                if (from_in) { s0 = *(const f32x4*)(xin0 + off + bj * HALF); s1 = *(const f32x4*)(xin0 + off + bj * HALF + 4); }
                else { const u32x4 w = bj ? cu1 : cu0; s0 = (f32x4){bflo(w.x), bfhi(w.x), bflo(w.y), bfhi(w.y)}; s1 = (f32x4){bflo(w.z), bfhi(w.z), bflo(w.w), bfhi(w.w)}; }
                *(u32x4*)(h0 + off + bj * HALF) = pack8(s0 + g0 * acc[ai][bj][m][0], s1 + g1 * acc[ai][bj][m][1]); }
            asm volatile("" ::: "memory"); }
    }
};

template <class Epi, bool GATHER, int K, bool SUB = false, bool ATILE = false, bool BTILE = false>
__device__ __forceinline__ void gemm_phase(int wv, LAS unsigned char* lds, const bf16* A, const bf16* Bt, size_t bstride, const Sched& S, const Epi& E, const LAS unsigned short* gtab) {
    const int tid = otid(wv), wid = __builtin_amdgcn_readfirstlane(tid >> 6), lane = tid & 63, wr = wid >> 2, wc = wid & 3, fr = lane & 15, fq = lane >> 4;
    constexpr int nt = K / BK;
    unsigned voffA[2], voffB[2]; int RA[2], CA[2];
#pragma unroll
    for (int i = 0; i < 2; ++i) { int R, C; stage_rc(tid * 16 + i * 8192, R, C); const int Rb = Epi::PERM ? ((R & ~31) + perm32(R & 31)) : R;
        RA[i] = R; CA[i] = C; voffA[i] = (unsigned)(R * (ATILE ? BK : K) + C) * 2u; voffB[i] = (unsigned)(Rb * (BTILE ? BK : K) + C) * 2u; }
    constexpr size_t kstepA = ATILE ? (size_t)BM * BK * 2 : (size_t)(BK * 2), hstepA = ATILE ? (size_t)HALF * BK * 2 : (size_t)HALF * K * 2, tstepA = (size_t)BM * K * 2;
    constexpr size_t kstepB = BTILE ? (size_t)BM * BK * 2 : (size_t)(BK * 2), hstepB = BTILE ? (size_t)HALF * BK * 2 : (size_t)HALF * K * 2, tstepB = (size_t)BM * K * 2;
    const unsigned ldsw = (unsigned)wid * 1024u;
    const int aoff = lds_byte(wr * 64 + fr, fq * 8), boff = lds_byte(wc * 32 + fr, fq * 8);
    const char* Ab = (const char*)A;
    unsigned cg[2][2], ng[2][2];
#define PG8_SA(b, h) (((b) * 2 + (h)) * HTB)
#define PG8_SB(b, h) ((4 + (b) * 2 + (h)) * HTB)
#define PG8_GLDS(gp, bufoff, i) __builtin_amdgcn_global_load_lds((const unsigned*)(gp), (LAS unsigned*)(lds + (bufoff) + ldsw + (i) * 8192), 16, 0, 0)
#define PG8_STAGE_B(bufoff, gbase) do { _Pragma("unroll") for (int _i = 0; _i < 2; ++_i) PG8_GLDS((const char*)(gbase) + voffB[_i], bufoff, _i); } while (0)
#define PG8_STAGE_A(bufoff, nxtsel, h, kt) do { \
        if constexpr (GATHER) { const char* _b = Ab + (size_t)(kt) * kstepA; _Pragma("unroll") for (int _i = 0; _i < 2; ++_i) { const unsigned _o = (nxtsel) ? ng[h][_i] : cg[h][_i]; PG8_GLDS(_b + _o, bufoff, _i); } } \
        else { const char* _b = ((nxtsel) ? nA : cA) + (size_t)(h) * hstepA + (size_t)(kt) * kstepA; _Pragma("unroll") for (int _i = 0; _i < 2; ++_i) PG8_GLDS(_b + voffA[_i], bufoff, _i); } } while (0)
#define PG8_LDA(dst, b, h) do { _Pragma("unroll") for (int m = 0; m < 4; ++m) _Pragma("unroll") for (int k = 0; k < 2; ++k) dst[m][k] = *(const LAS bf16x8*)(lds + PG8_SA(b, h) + aoff + m * 2048 + k * 1024); } while (0)
#define PG8_LDB(dst, b, h) do { _Pragma("unroll") for (int n = 0; n < 2; ++n) _Pragma("unroll") for (int k = 0; k < 2; ++k) dst[n][k] = *(const LAS bf16x8*)(lds + PG8_SB(b, h) + boff + n * 2048 + k * 1024); } while (0)
#define PG8_MMA(ai, bj, At, Bt_) do { if constexpr (SUB) { if (csub != 0 && csub != 1 + (ai) * 2 + (bj)) break; } __builtin_amdgcn_s_setprio(1); _Pragma("unroll") for (int m = 0; m < 4; ++m) _Pragma("unroll") for (int n = 0; n < 2; ++n) _Pragma("unroll") for (int k = 0; k < 2; ++k) \
        acc[ai][bj][m][n] = __builtin_amdgcn_mfma_f32_16x16x32_bf16(Bt_[n][k], At[m][k], acc[ai][bj][m][n], 0, 0, 0); __builtin_amdgcn_s_setprio(0); } while (0)
#define PG8_WAIT_V(n) asm volatile("s_waitcnt vmcnt(" #n ")" ::: "memory")
#define PG8_WAIT_L(n) asm volatile("s_waitcnt lgkmcnt(" #n ")" ::: "memory")
#define PG8_BAR __builtin_amdgcn_s_barrier()
#define PG8_SCHED __builtin_amdgcn_sched_barrier(0)
#define PG8_GOFF(dst, ui_) do { _Pragma("unroll") for (int _h = 0; _h < 2; ++_h) _Pragma("unroll") for (int _i = 0; _i < 2; ++_i) \
        dst[_h][_i] = ((unsigned)gtab[(ui_) * 256 + _h * HALF + RA[_i]] * (unsigned)K + (unsigned)CA[_i]) * 2u; } while (0)
    Unit cur, nxt; int ui = 0;
    if (!S.next(0, cur)) return;
    f32x4 acc[2][2][4][2];
#pragma unroll
    for (int a = 0; a < 2; ++a)
#pragma unroll
        for (int b = 0; b < 2; ++b)
#pragma unroll
            for (int m = 0; m < 4; ++m)
#pragma unroll
                for (int n = 0; n < 2; ++n) acc[a][b][m][n] = (f32x4){0.f, 0.f, 0.f, 0.f};
    bf16x8 At[4][2], B0[2][2], B1[2][2];
    const char* cA = Ab + (size_t)cur.pm * tstepA; const char* cB = (const char*)(Bt + (size_t)cur.e * bstride) + (size_t)cur.pn * tstepB;
    const char* nA = cA; int csub = cur.sub;
    if constexpr (GATHER) { PG8_GOFF(cg, 0); PG8_GOFF(ng, 0); }
    PG8_STAGE_B(PG8_SB(0, 0), cB); PG8_STAGE_B(PG8_SB(0, 1), cB + hstepB); PG8_STAGE_A(PG8_SA(0, 0), false, 0, 0); PG8_STAGE_A(PG8_SA(0, 1), false, 1, 0);
    if (wr == 1) PG8_BAR;
    PG8_WAIT_V(2); PG8_BAR;
    PG8_STAGE_B(PG8_SB(1, 0), cB + kstepB); PG8_STAGE_A(PG8_SA(1, 0), false, 0, 1); PG8_STAGE_B(PG8_SB(1, 1), cB + hstepB + kstepB);
    PG8_WAIT_V(6); PG8_BAR;
    for (;;) {
        const bool has_next = S.next(ui + 1, nxt);
        nA = has_next ? Ab + (size_t)nxt.pm * tstepA : cA; const char* nB = has_next ? (const char*)(Bt + (size_t)nxt.e * bstride) + (size_t)nxt.pn * tstepB : cB;
        if constexpr (GATHER) { if (has_next) PG8_GOFF(ng, ui + 1); else { _Pragma("unroll") for (int _h = 0; _h < 2; ++_h) _Pragma("unroll") for (int _i = 0; _i < 2; ++_i) ng[_h][_i] = cg[_h][_i]; } }
#pragma nounroll
        for (int t = 0; t < nt; t += 2) {
            const bool last = (t == nt - 2);
            const int t1 = t + 1, t2 = last ? 0 : t + 2, t3 = t2 + 1;
            const char* b2 = (last ? nB : cB) + (size_t)t2 * kstepB; const char* b3 = b2 + kstepB;
            PG8_LDB(B0, 0, 0); PG8_LDB(B1, 0, 1); PG8_SCHED; PG8_LDA(At, 0, 0); PG8_STAGE_A(PG8_SA(1, 1), false, 1, t1);
            PG8_WAIT_V(8); PG8_WAIT_L(0); PG8_BAR; PG8_MMA(0, 0, At, B0); PG8_MMA(0, 1, At, B1); PG8_BAR; PG8_SCHED;
            PG8_LDA(At, 0, 1); PG8_STAGE_B(PG8_SB(0, 0), b2); PG8_STAGE_B(PG8_SB(0, 1), b2 + hstepB); PG8_STAGE_A(PG8_SA(0, 0), last, 0, t2);
            PG8_WAIT_V(8); PG8_WAIT_L(0); PG8_BAR; PG8_MMA(1, 0, At, B0); PG8_MMA(1, 1, At, B1); PG8_BAR; PG8_SCHED;
            PG8_LDB(B0, 1, 0); PG8_LDB(B1, 1, 1); PG8_SCHED; PG8_LDA(At, 1, 0); PG8_STAGE_A(PG8_SA(0, 1), last, 1, t2);
            PG8_WAIT_V(8); PG8_WAIT_L(0); PG8_BAR; PG8_MMA(0, 0, At, B0); PG8_MMA(0, 1, At, B1); PG8_BAR; PG8_SCHED;
            PG8_LDA(At, 1, 1); PG8_STAGE_B(PG8_SB(1, 0), b3); PG8_STAGE_B(PG8_SB(1, 1), b3 + hstepB); PG8_STAGE_A(PG8_SA(1, 0), last, 0, t3);
            PG8_WAIT_V(8); PG8_WAIT_L(0); PG8_BAR; PG8_MMA(1, 0, At, B0); PG8_MMA(1, 1, At, B1); PG8_BAR; PG8_SCHED;
        }
        if (wr == 0) PG8_BAR;
        E(acc, cur, wr, wc, fr, fq);
        if (!has_next) break;
#pragma unroll
        for (int a = 0; a < 2; ++a)
#pragma unroll
            for (int b = 0; b < 2; ++b)
#pragma unroll
                for (int m = 0; m < 4; ++m)
#pragma unroll
                    for (int n = 0; n < 2; ++n) acc[a][b][m][n] = (f32x4){0.f, 0.f, 0.f, 0.f};
        cur = nxt; cA = nA; cB = nB; ++ui; csub = cur.sub;
        if constexpr (GATHER) { _Pragma("unroll") for (int _h = 0; _h < 2; ++_h) _Pragma("unroll") for (int _i = 0; _i < 2; ++_i) cg[_h][_i] = ng[_h][_i]; }
        if (wr == 1) PG8_BAR;
    }
    PG8_WAIT_V(0);
    PG8_BAR;
#undef PG8_SA
#undef PG8_SB
#undef PG8_GLDS
#undef PG8_STAGE_A
#undef PG8_STAGE_B
#undef PG8_LDA
#undef PG8_LDB
#undef PG8_MMA
#undef PG8_WAIT_V
#undef PG8_WAIT_L
#undef PG8_BAR
#undef PG8_SCHED
#undef PG8_GOFF
}

template <class Epi, int K, bool ATILE, bool BTILE>
__device__ __forceinline__ void gemm_sub_unit(int wv, LAS unsigned char* lds, const bf16* A, const bf16* Bt, size_t bstride, const Sched& S, const Epi& E) {
    Unit u; if (!S.next(0, u)) return;
    const int tid = otid(wv), wid = __builtin_amdgcn_readfirstlane(tid >> 6), lane = tid & 63, wr = wid >> 2, wc = wid & 3, fr = lane & 15, fq = lane >> 4;
    constexpr int nt = K / BK;
    unsigned voffA[2], voffB[2];
#pragma unroll
    for (int i = 0; i < 2; ++i) { int R, C; stage_rc(tid * 16 + i * 8192, R, C); const int Rb = Epi::PERM ? ((R & ~31) + perm32(R & 31)) : R;
        voffA[i] = (unsigned)(R * (ATILE ? BK : K) + C) * 2u; voffB[i] = (unsigned)(Rb * (BTILE ? BK : K) + C) * 2u; }
    constexpr size_t kstepA = ATILE ? (size_t)BM * BK * 2 : (size_t)(BK * 2), hstepA = ATILE ? (size_t)HALF * BK * 2 : (size_t)HALF * K * 2, tstepA = (size_t)BM * K * 2;
    constexpr size_t kstepB = BTILE ? (size_t)BM * BK * 2 : (size_t)(BK * 2), hstepB = BTILE ? (size_t)HALF * BK * 2 : (size_t)HALF * K * 2, tstepB = (size_t)BM * K * 2;
    const unsigned ldsw = (unsigned)wid * 1024u;
    const int aoff = lds_byte(wr * 64 + fr, fq * 8), boff = lds_byte(wc * 32 + fr, fq * 8);
#pragma nounroll
    for (int sq = (u.sub ? u.sub - 1 : 0); sq < (u.sub ? u.sub : 4); ++sq) {
    const int ai = sq >> 1, bj = sq & 1; Unit uq = u; uq.sub = sq + 1;
    const char* cA = (const char*)A + (size_t)u.pm * tstepA + (size_t)ai * hstepA;
    const char* cB = (const char*)(Bt + (size_t)u.e * bstride) + (size_t)u.pn * tstepB + (size_t)bj * hstepB;
#define SU_SA(b) ((b) * 2 * HTB)
#define SU_SB(b) ((4 + (b) * 2) * HTB)
#define SU_STAGE(b, kt) do { _Pragma("unroll") for (int _i = 0; _i < 2; ++_i) { \
        __builtin_amdgcn_global_load_lds((const unsigned*)(cA + (size_t)(kt) * kstepA + voffA[_i]), (LAS unsigned*)(lds + SU_SA(b) + ldsw + _i * 8192), 16, 0, 0); \
        __builtin_amdgcn_global_load_lds((const unsigned*)(cB + (size_t)(kt) * kstepB + voffB[_i]), (LAS unsigned*)(lds + SU_SB(b) + ldsw + _i * 8192), 16, 0, 0); } } while (0)
    f32x4 a1[4][2];
#pragma unroll
    for (int m = 0; m < 4; ++m)
#pragma unroll
        for (int n = 0; n < 2; ++n) a1[m][n] = (f32x4){0.f, 0.f, 0.f, 0.f};
#define SU_READ(At, Bf, b) do { _Pragma("unroll") for (int _m = 0; _m < 4; ++_m) { _Pragma("unroll") for (int _k = 0; _k < 2; ++_k) At[_m][_k] = *(const LAS bf16x8*)(lds + SU_SA(b) + aoff + _m * 2048 + _k * 1024); } \
        _Pragma("unroll") for (int _n = 0; _n < 2; ++_n) { _Pragma("unroll") for (int _k = 0; _k < 2; ++_k) Bf[_n][_k] = *(const LAS bf16x8*)(lds + SU_SB(b) + boff + _n * 2048 + _k * 1024); } } while (0)
#define SU_MMA(At, Bf) do { __builtin_amdgcn_s_setprio(1); _Pragma("unroll") for (int _m = 0; _m < 4; ++_m) { _Pragma("unroll") for (int _n = 0; _n < 2; ++_n) { _Pragma("unroll") for (int _k = 0; _k < 2; ++_k) \
        a1[_m][_n] = __builtin_amdgcn_mfma_f32_16x16x32_bf16(Bf[_n][_k], At[_m][_k], a1[_m][_n], 0, 0, 0); } } __builtin_amdgcn_s_setprio(0); } while (0)
#define SU_HALF(Fa, Fb, Ga, Gb, b, t2) do { \
        asm volatile("s_waitcnt lgkmcnt(0)" ::: "memory"); __builtin_amdgcn_s_barrier();        \
        SU_STAGE(b, t2); \
        asm volatile("s_waitcnt vmcnt(4)" ::: "memory"); __builtin_amdgcn_s_barrier();           \
        __builtin_amdgcn_sched_barrier(0); \
        SU_READ(Ga, Gb, (b) ^ 1); \
        __builtin_amdgcn_sched_barrier(0); \
        SU_MMA(Fa, Fb); \
        __builtin_amdgcn_sched_barrier(0); } while (0)
    bf16x8 A0[4][2], B0[2][2], A1[4][2], B1[2][2];
    SU_STAGE(0, 0); SU_STAGE(1, 1);
    asm volatile("s_waitcnt vmcnt(4)" ::: "memory"); __builtin_amdgcn_s_barrier();
    SU_READ(A0, B0, 0);
    static_assert(nt % 2 == 0, "K tiles come in pairs");
#pragma nounroll
    for (int t = 0; t < nt; t += 2) {
        { const int t2 = (t + 2 < nt) ? t + 2 : 0; SU_HALF(A0, B0, A1, B1, 0, t2); }
        { const int t3 = (t + 3 < nt) ? t + 3 : 1; SU_HALF(A1, B1, A0, B0, 1, t3); }
    }
    asm volatile("s_waitcnt vmcnt(0) lgkmcnt(0)" ::: "memory");
    __builtin_amdgcn_s_barrier();
#undef SU_READ
#undef SU_MMA
#undef SU_HALF
    f32x4 acc[2][2][4][2];
#pragma unroll
    for (int a = 0; a < 2; ++a)
#pragma unroll
        for (int bb = 0; bb < 2; ++bb)
#pragma unroll
            for (int m = 0; m < 4; ++m)
#pragma unroll
                for (int n = 0; n < 2; ++n) acc[a][bb][m][n] = a1[m][n];
    E(acc, uq, wr, wc, fr, fq);
    }
#undef SU_SA
#undef SU_SB
#undef SU_STAGE
}
}

namespace att {
using f32x16 = __attribute__((ext_vector_type(16))) float;
using s16x4 = __attribute__((ext_vector_type(4))) short;
constexpr int NW = 8, QBLK = 32, KVBLK = 64;
#define ATT_SBAR() __builtin_amdgcn_sched_barrier(0)
__device__ __forceinline__ int crow(int r, int hi) { return (r & 3) + 8 * (r >> 2) + 4 * hi; }
__device__ __forceinline__ unsigned cvtpk(float lo, float hi) { unsigned r; asm volatile("v_cvt_pk_bf16_f32 %0, %1, %2" : "=v"(r) : "v"(lo), "v"(hi)); return r; }
template <int DQK> struct Cst { static constexpr float scale() { return DQK == 128 ? 0.088388347648318440f : (DQK == 192 ? 0.072168783648703220f : 0.125f); } };
template <int DQK> __device__ __forceinline__ int kswz(int row, int colB) { constexpr int RS = DQK * 2; return row * RS + (colB ^ ((RS == 256 ? (row & 15) : ((row >> 1) & 7)) << 4)); }
template <int DV> __device__ __forceinline__ int v_st(int k, int c) { const int kk = (k & ~0xC) | ((k & 4) << 1) | ((k & 8) >> 1); return ((kk >> 3) * (DV / 32) + (c >> 5)) * 512 + ((kk & 7) * 32 + (c & 31)) * 2; }
__device__ __forceinline__ int v_rd_base(int lane) { return ((lane & 3) << 3) | (((lane >> 2) & 3) << 6) | (((lane >> 4) & 1) << 5) | (((lane >> 5) & 1) << 8); }
typedef short v4i16_t __attribute__((ext_vector_type(4)));
typedef __attribute__((address_space(3))) v4i16_t lds_v4i16_t;
template <int OFF> __device__ __forceinline__ s16x4 tr_read(int vb) { return __builtin_bit_cast(s16x4, __builtin_amdgcn_ds_read_tr16_b64_v4i16((lds_v4i16_t*)(unsigned)(vb + OFF))); }

template <int DQK, int THRI> __device__ __forceinline__ void partialSM(f32x16& p0, f32x16& p1, float& m_reg, float& mn, float& alpha) {
    constexpr float SC = Cst<DQK>::scale(), C = SC * 1.4426950408889634f, THR = (float)THRI;
    float pmax = p0[0];
#pragma unroll
    for (int r = 1; r < 16; ++r) pmax = fmaxf(pmax, p0[r]);
#pragma unroll
    for (int r = 0; r < 16; ++r) pmax = fmaxf(pmax, p1[r]);
    { auto rr = __builtin_amdgcn_permlane32_swap(__float_as_uint(pmax), __float_as_uint(pmax), false, false); pmax = fmaxf(__uint_as_float(rr[0]), __uint_as_float(rr[1])); }
    if (__builtin_expect(__all(pmax - m_reg <= THR / SC), 1)) { mn = m_reg; alpha = 1.f; }
    else { mn = fmaxf(m_reg, pmax); alpha = __builtin_amdgcn_exp2f((m_reg - mn) * C); m_reg = mn; }
    const float mnC = -mn * C;
#pragma unroll
    for (int r = 0; r < 16; ++r) p0[r] = fmaf(p0[r], C, mnC);
#pragma unroll
    for (int r = 0; r < 16; ++r) p1[r] = fmaf(p1[r], C, mnC);
#pragma unroll
    for (int r = 0; r < 16; ++r) p0[r] = __builtin_amdgcn_exp2f(p0[r]);
}
__device__ __forceinline__ void finishSM(f32x16& p0, f32x16& p1, float alpha, float& l_reg, bf16x8& pa0, bf16x8& pa1, bf16x8& pa2, bf16x8& pa3) {
#pragma unroll
    for (int r = 0; r < 16; ++r) p1[r] = __builtin_amdgcn_exp2f(p1[r]);
    float ps = 0;
#pragma unroll
    for (int r = 0; r < 16; ++r) ps += p0[r];
#pragma unroll
    for (int r = 0; r < 16; ++r) ps += p1[r];
    { auto rr = __builtin_amdgcn_permlane32_swap(__float_as_uint(ps), __float_as_uint(ps), false, false); ps = __uint_as_float(rr[0]) + __uint_as_float(rr[1]); }
    l_reg = l_reg * alpha + ps;
#define ATT_PK4(Pv, BASE, OUT) do { unsigned a0 = cvtpk(Pv[BASE + 0], Pv[BASE + 1]), a1 = cvtpk(Pv[BASE + 2], Pv[BASE + 3]); \
    unsigned b0 = cvtpk(Pv[BASE + 4], Pv[BASE + 5]), b1 = cvtpk(Pv[BASE + 6], Pv[BASE + 7]); \
    auto r0 = __builtin_amdgcn_permlane32_swap(a0, b0, false, false); auto r1 = __builtin_amdgcn_permlane32_swap(a1, b1, false, false); \
    u32x4 w = {r0[0], r1[0], r0[1], r1[1]}; OUT = *reinterpret_cast<bf16x8*>(&w); } while (0)
    ATT_PK4(p0, 0, pa0); ATT_PK4(p0, 8, pa1); ATT_PK4(p1, 0, pa2); ATT_PK4(p1, 8, pa3);
#undef ATT_PK4
}
template <int DQK, int QL> __device__ __forceinline__ void qkt(f32x16& p0, f32x16& p1, const char* Ks, const bf16x8* qr, const char* ql, const int* kb, int r32, int hi) {
    p0 = f32x16{}; p1 = f32x16{};
#pragma unroll
    for (int d0 = 0; d0 < DQK / 16; ++d0) {
        bf16x8 b0, b1;
        if constexpr (DQK == 192) { b0 = *reinterpret_cast<const bf16x8*>(Ks + kb[d0 & 3] + 128 * (d0 >> 2)); b1 = *reinterpret_cast<const bf16x8*>(Ks + kb[d0 & 3] + 128 * (d0 >> 2) + 32 * DQK * 2); }
        else { const int cb = (d0 * 16 + hi * 8) * 2; b0 = *reinterpret_cast<const bf16x8*>(Ks + kswz<DQK>(r32, cb)); b1 = *reinterpret_cast<const bf16x8*>(Ks + kswz<DQK>(32 + r32, cb)); }
        bf16x8 q; if constexpr (QL > 0) { if (d0 >= DQK / 16 - QL) q = *reinterpret_cast<const bf16x8*>(ql + (d0 - (DQK / 16 - QL)) * 1024); else q = qr[d0]; } else q = qr[d0];
        p0 = __builtin_amdgcn_mfma_f32_32x32x16_bf16(b0, q, p0, 0, 0, 0);
        p1 = __builtin_amdgcn_mfma_f32_32x32x16_bf16(b1, q, p1, 0, 0, 0); }
}
template <int DV, int D0> __device__ __forceinline__ void pv_one(f32x16& od, int vb, bf16x8 pa0, bf16x8 pa1, bf16x8 pa2, bf16x8 pa3) {
    constexpr int KS = (DV / 32) * 1024, HF = (DV / 32) * 512;
    const s16x4 l0 = tr_read<D0 * 512 + 0 * KS>(vb), h0 = tr_read<D0 * 512 + 0 * KS + HF>(vb), l1 = tr_read<D0 * 512 + 1 * KS>(vb), h1 = tr_read<D0 * 512 + 1 * KS + HF>(vb);
    const s16x4 l2 = tr_read<D0 * 512 + 2 * KS>(vb), h2 = tr_read<D0 * 512 + 2 * KS + HF>(vb), l3 = tr_read<D0 * 512 + 3 * KS>(vb), h3 = tr_read<D0 * 512 + 3 * KS + HF>(vb);
#define ATT_PK(L, H) (bf16x8){L[0], L[1], L[2], L[3], H[0], H[1], H[2], H[3]}
    od = __builtin_amdgcn_mfma_f32_32x32x16_bf16(pa0, ATT_PK(l0, h0), od, 0, 0, 0);
    od = __builtin_amdgcn_mfma_f32_32x32x16_bf16(pa1, ATT_PK(l1, h1), od, 0, 0, 0);
    od = __builtin_amdgcn_mfma_f32_32x32x16_bf16(pa2, ATT_PK(l2, h2), od, 0, 0, 0);
    od = __builtin_amdgcn_mfma_f32_32x32x16_bf16(pa3, ATT_PK(l3, h3), od, 0, 0, 0);
#undef ATT_PK
}
template <int DV> __device__ __forceinline__ void pv_all(f32x16* o, int vb, bf16x8 pa0, bf16x8 pa1, bf16x8 pa2, bf16x8 pa3) {
    pv_one<DV, 0>(o[0], vb, pa0, pa1, pa2, pa3); pv_one<DV, 1>(o[1], vb, pa0, pa1, pa2, pa3);
    if constexpr (DV == 128) { pv_one<DV, 2>(o[2], vb, pa0, pa1, pa2, pa3); pv_one<DV, 3>(o[3], vb, pa0, pa1, pa2, pa3); }
}
template <int DQK, int DV> struct Shm { static constexpr int V = KVBLK * DV * 2, K = KVBLK * DQK * 2, WSO = 2 * V + 2 * K, QLO = WSO + NW * 64 * 4; };

template <int DQK, int DV, int SD, bool WINDOW, int THRI, int QL, bool DMA = false>
__device__ __forceinline__ void attn_unit(const bf16* __restrict__ Qb, int ldq, const bf16* __restrict__ Kh, int ldk, const bf16* __restrict__ Vh, int ldv, bf16* __restrict__ Ob, int ldo,
                                          int NT, int segB, int qlat0, int klat0, float m_init, float l_init, char* lds, int wv) {
    constexpr int SHM_V = Shm<DQK, DV>::V, SHM_K = Shm<DQK, DV>::K, NKP = DQK / 64, NVP = DV / 64, ND0 = DV / 32;
    int tid_ = otid(wv);
    const int tid = tid_, wid = tid >> 6, lane = tid & 63, r32 = lane & 31, hi = lane >> 5;
    char* V_lds = lds; char* K_lds = lds + 2 * SHM_V;
    float* wsf = (float*)(lds + Shm<DQK, DV>::WSO) + wid * 64; float* li_l = wsf; float* al_l = wsf + 32;
    float m_reg = m_init, l_reg = l_init; f32x16 o[ND0]; bf16x8 qr[DQK / 16 - QL > 0 ? DQK / 16 - QL : 1];
    char* ql = lds + Shm<DQK, DV>::QLO + wid * (QL > 0 ? QL : 1) * 1024 + lane * 16;
#pragma unroll
    for (int d = 0; d < ND0; ++d) o[d] = f32x16{};
    const bf16* Qw = Qb + (long)(wid * QBLK + r32) * ldq + hi * 8;
#pragma unroll
    for (int d0 = 0; d0 < DQK / 16; ++d0) { const bf16x8 q = *reinterpret_cast<const bf16x8*>(Qw + d0 * 16); if (d0 < DQK / 16 - QL) qr[d0 < DQK / 16 - QL ? d0 : 0] = q; else *reinterpret_cast<bf16x8*>(ql + (d0 - (DQK / 16 - QL)) * 1024) = q; }
    const int srow = tid >> 3, sch = tid & 7;
    const int kflip = (DQK == 128) ? ((srow >> 3) & 1) * 128 : 0;
    const int kgo = srow * ldk + sch * 8, klo = kswz<DQK>(srow, sch * 16) & ~kflip, vgo = srow * ldv + sch * 8, vlo = v_st<DV>(srow, sch * 8);
    const int vb0 = (int)(uintptr_t)V_lds + v_rd_base(lane);
    int kb[4];
#pragma unroll
    for (int j = 0; j < 4; ++j) kb[j] = kswz<DQK>(r32, 32 * j + 16 * hi);
    bf16x8 ks[SD][NKP], vs[SD][NVP];
#define ATT_BAR() asm volatile("s_waitcnt lgkmcnt(0)\n\ts_barrier" ::: "memory")
#define ATT_KROW(t) ((t) < 4 ? 64 * (t) : segB + 64 * ((t) - 4))
#define ATT_SLOAD(i, t) do { const long _kr = ATT_KROW(t); _Pragma("unroll") for (int _x = 0; _x < NVP; ++_x) vs[i][_x] = *reinterpret_cast<const bf16x8*>(Vh + _kr * ldv + vgo + 64 * _x); \
        _Pragma("unroll") for (int _x = 0; _x < NKP; ++_x) ks[i][_x] = *reinterpret_cast<const bf16x8*>(Kh + _kr * ldk + kgo + 64 * _x); } while (0)
#define ATT_SWRITE(b, i) do { _Pragma("unroll") for (int _x = 0; _x < NVP; ++_x) *(bf16x8*)(V_lds + (b) * SHM_V + vlo + 1024 * _x) = vs[i][_x]; \
        _Pragma("unroll") for (int _x = 0; _x < NKP; ++_x) *(bf16x8*)(K_lds + (b) * SHM_K + klo + ((128 * _x) ^ kflip)) = ks[i][_x]; } while (0)
#define ATT_SWAIT() do { if constexpr (SD == 2) { if constexpr (NKP + NVP == 4) asm volatile("s_waitcnt vmcnt(4)" ::: "memory"); else if constexpr (NKP + NVP == 2) asm volatile("s_waitcnt vmcnt(2)" ::: "memory"); else asm volatile("s_waitcnt vmcnt(5)" ::: "memory"); } \
        else asm volatile("s_waitcnt vmcnt(0)" ::: "memory"); } while (0)
#define ATT_RESC(a) do { if (__any((a) < 1.f)) { if (hi == 0) al_l[r32] = (a); asm volatile("s_waitcnt lgkmcnt(0)" ::: "memory"); \
        _Pragma("unroll") for (int d = 0; d < ND0; ++d) _Pragma("unroll") for (int r = 0; r < 16; ++r) o[d][r] *= al_l[crow(r, hi)]; } } while (0)
#define ATT_MASK(P0, P1, t) do { if constexpr (WINDOW) { if ((t) >= 4) { const int _d0 = klat0 + 64 * ((t) - 4) - (qlat0 + wid * QBLK + r32); \
        _Pragma("unroll") for (int r = 0; r < 16; ++r) { const int _d = _d0 + crow(r, hi); P0[r] = (_d > 128 || _d < -128) ? -1e30f : P0[r]; P1[r] = (_d + 32 > 128 || _d + 32 < -128) ? -1e30f : P1[r]; } } } } while (0)
    f32x16 pA0, pA1, pB0, pB1; float mnA, mnB, alA, alB; bf16x8 pa0, pa1, pa2, pa3;
    constexpr int SE = 0, SO = SD - 1;
    if (wv >= 4) __builtin_amdgcn_s_setprio(1);
    if constexpr (!DMA) {
    ATT_SLOAD(SE, 0); asm volatile("s_waitcnt vmcnt(0)" ::: "memory"); ATT_SWRITE(0, SE); ATT_BAR();
    qkt<DQK, QL>(pA0, pA1, K_lds, qr, ql, kb, r32, hi); partialSM<DQK, THRI>(pA0, pA1, m_reg, mnA, alA);
    ATT_SLOAD(SO, 1); if constexpr (SD == 2) { if (2 < NT) ATT_SLOAD(SE, 2); }
    ATT_SWAIT(); ATT_SWRITE(1, SO); ATT_BAR();
    for (int j = 1; j + 1 < NT; j += 2) {
        ATT_SBAR(); qkt<DQK, QL>(pB0, pB1, K_lds + SHM_K, qr, ql, kb, r32, hi); ATT_MASK(pB0, pB1, j);
        finishSM(pA0, pA1, alA, l_reg, pa0, pa1, pa2, pa3); ATT_SBAR();
        ATT_SLOAD(SO, j + SD); ATT_SBAR();
        pv_all<DV>(o, vb0, pa0, pa1, pa2, pa3); partialSM<DQK, THRI>(pB0, pB1, m_reg, mnB, alB);
        ATT_BAR(); ATT_SWAIT(); ATT_SWRITE(0, SE);
        ATT_RESC(alB); ATT_BAR();
        ATT_SBAR(); qkt<DQK, QL>(pA0, pA1, K_lds, qr, ql, kb, r32, hi); ATT_MASK(pA0, pA1, j + 1);
        finishSM(pB0, pB1, alB, l_reg, pa0, pa1, pa2, pa3); ATT_SBAR();
        if (SD == 1 || j + 3 < NT) ATT_SLOAD(SE, j + 1 + SD); ATT_SBAR();
        pv_all<DV>(o, vb0 + SHM_V, pa0, pa1, pa2, pa3); partialSM<DQK, THRI>(pA0, pA1, m_reg, mnA, alA);
        ATT_BAR(); ATT_SWAIT(); ATT_SWRITE(1, SO);
        ATT_RESC(alA); ATT_BAR();
    }
    ATT_SBAR(); qkt<DQK, QL>(pB0, pB1, K_lds + SHM_K, qr, ql, kb, r32, hi); ATT_MASK(pB0, pB1, NT - 1);
    finishSM(pA0, pA1, alA, l_reg, pa0, pa1, pa2, pa3); ATT_SBAR();
    pv_all<DV>(o, vb0, pa0, pa1, pa2, pa3); partialSM<DQK, THRI>(pB0, pB1, m_reg, mnB, alB);
    ATT_BAR(); ATT_RESC(alB);
    finishSM(pB0, pB1, alB, l_reg, pa0, pa1, pa2, pa3); ATT_SBAR();
    pv_all<DV>(o, vb0 + SHM_V, pa0, pa1, pa2, pa3);
    } else {
        static_assert(!DMA || (DQK == 128 && DV == 128 && !WINDOW), "DMA staging: D = 128 dense only");
        LAS char* ldsL = (LAS char*)lds;
        const int krow = 4 * wid + ((lane >> 4) & 3);
        const int kgo_d = krow * ldk + (((lane & 15) ^ (krow & 15)) << 3);
        const int vsub = 2 * wid + (lane >> 5), w32 = lane & 31, vkk = ((vsub >> 2) << 3) | (w32 >> 2), vk = (vkk & ~0xC) | ((vkk & 4) << 1) | ((vkk & 8) >> 1);
        const int vgo_d = vk * ldv + (vsub & 3) * 32 + (w32 & 3) * 8;
#define ATT_DMA_K(b, t) do { const bf16* _g = Kh + (long)ATT_KROW(t) * ldk + kgo_d; \
        __builtin_amdgcn_global_load_lds((const unsigned*)_g, (LAS unsigned*)(ldsL + 2 * SHM_V + (b) * SHM_K + wv * 1024), 16, 0, 0); \
        __builtin_amdgcn_global_load_lds((const unsigned*)(_g + 32 * ldk), (LAS unsigned*)(ldsL + 2 * SHM_V + (b) * SHM_K + wv * 1024 + 8192), 16, 0, 0); } while (0)
#define ATT_DMA_V(b, t) do { const bf16* _g = Vh + (long)ATT_KROW(t) * ldv + vgo_d; \
        __builtin_amdgcn_global_load_lds((const unsigned*)_g, (LAS unsigned*)(ldsL + (b) * SHM_V + wv * 1024), 16, 0, 0); \
        __builtin_amdgcn_global_load_lds((const unsigned*)(_g + 32 * ldv), (LAS unsigned*)(ldsL + (b) * SHM_V + wv * 1024 + 8192), 16, 0, 0); } while (0)
#define ATT_LAND() asm volatile("s_waitcnt vmcnt(0) lgkmcnt(0)\n\ts_barrier" ::: "memory")
        ATT_DMA_K(0, 0); ATT_DMA_V(0, 0); ATT_DMA_K(1, 1);
        ATT_LAND();
        qkt<DQK, QL>(pA0, pA1, K_lds, qr, ql, kb, r32, hi); partialSM<DQK, THRI>(pA0, pA1, m_reg, mnA, alA);
        ATT_BAR();
        ATT_DMA_K(0, 2); ATT_DMA_V(1, 1);
        for (int j = 1; j + 1 < NT; j += 2) {
            ATT_SBAR(); qkt<DQK, QL>(pB0, pB1, K_lds + SHM_K, qr, ql, kb, r32, hi);
            finishSM(pA0, pA1, alA, l_reg, pa0, pa1, pa2, pa3); ATT_SBAR();
            pv_all<DV>(o, vb0, pa0, pa1, pa2, pa3); partialSM<DQK, THRI>(pB0, pB1, m_reg, mnB, alB);
            ATT_LAND();
            if (j + 2 < NT) ATT_DMA_K(1, j + 2);
            ATT_DMA_V(0, j + 1);
            ATT_RESC(alB);
            ATT_SBAR(); qkt<DQK, QL>(pA0, pA1, K_lds, qr, ql, kb, r32, hi);
            finishSM(pB0, pB1, alB, l_reg, pa0, pa1, pa2, pa3); ATT_SBAR();
            pv_all<DV>(o, vb0 + SHM_V, pa0, pa1, pa2, pa3); partialSM<DQK, THRI>(pA0, pA1, m_reg, mnA, alA);
            ATT_LAND();
            if (j + 3 < NT) ATT_DMA_K(0, j + 3);
            ATT_DMA_V(1, j + 2);
            ATT_RESC(alA);
        }
        ATT_SBAR(); qkt<DQK, QL>(pB0, pB1, K_lds + SHM_K, qr, ql, kb, r32, hi);
        finishSM(pA0, pA1, alA, l_reg, pa0, pa1, pa2, pa3); ATT_SBAR();
        pv_all<DV>(o, vb0, pa0, pa1, pa2, pa3); partialSM<DQK, THRI>(pB0, pB1, m_reg, mnB, alB);
        ATT_LAND(); ATT_RESC(alB);
        finishSM(pB0, pB1, alB, l_reg, pa0, pa1, pa2, pa3); ATT_SBAR();
        pv_all<DV>(o, vb0 + SHM_V, pa0, pa1, pa2, pa3);
#undef ATT_DMA_K
#undef ATT_DMA_V
#undef ATT_LAND
    }
    __builtin_amdgcn_s_setprio(0);
    if (hi == 0) li_l[r32] = l_reg; asm volatile("s_waitcnt lgkmcnt(0)" ::: "memory");
    float rli[16];
#pragma unroll
    for (int r = 0; r < 16; ++r) rli[r] = __builtin_amdgcn_rcpf(li_l[crow(r, hi)]);
    int tid2 = otid(wv);
    bf16* Ow = Ob + (long)((tid2 >> 6) * QBLK) * ldo + (tid2 & 31);
#pragma unroll
    for (int r = 0; r < 16; ++r) { const int orow = crow(r, (tid2 >> 5) & 1);
#pragma unroll
        for (int d0 = 0; d0 < ND0; ++d0) Ow[(long)orow * ldo + d0 * 32] = (bf16)f2bf(o[d0][r] * rli[r]); }
    ATT_BAR();
#undef ATT_BAR
#undef ATT_KROW
#undef ATT_SLOAD
#undef ATT_SWRITE
#undef ATT_SWAIT
#undef ATT_RESC
#undef ATT_MASK
}

template <int DQK, int DV, int SD, bool WINDOW, int QL, bool DMA = false>
__device__ __forceinline__ void attn_phase(const bf16* Q, int ldq, int qhs, const bf16* Kb, int ldk, int khs, const bf16* Vb, int ldv, int vhs, bf16* O, int ldo, int ohs, int H, int G, const float* sinks, char* lds, int wv) {
    const int nlat = NB * H * 32, ntot = WINDOW ? nlat : nlat + NB * H;
    const int c0 = (gridDim.x == 256) ? (((int)blockIdx.x & 7) * 32 + ((int)blockIdx.x >> 3)) : (int)blockIdx.x;
    for (int L = c0; L < ntot; L += gridDim.x) {
        int b, h, q0row, NT, segB = NCTX, qlat0 = 0, klat0 = 0; float m0 = -1e30f, l0 = 0.f;
        if (L < nlat) { const int qb = L & 31; h = (L >> 5) % H; b = (L >> 5) / H; q0row = NCTX + qb * 256; NT = 4 + SEQ / 64;
            if constexpr (WINDOW) { qlat0 = qb * 256; klat0 = max(0, qlat0 - 128); const int hi_ = min(SEQ, qlat0 + 256 + 128); NT = 4 + (hi_ - klat0) / 64; segB = NCTX + klat0; m0 = sinks[h] / Cst<DQK>::scale(); l0 = 1.f; } }
        else { const int L2 = L - nlat; h = L2 % H; b = L2 / H; q0row = 0; NT = 4; }
        const size_t rb = (size_t)b * RPB; const int kvh = h / G;
        attn_unit<DQK, DV, SD, WINDOW, 8, QL, DMA>(Q + (rb + q0row) * ldq + h * qhs, ldq, Kb + rb * ldk + kvh * khs, ldk, Vb + rb * ldv + kvh * vhs, ldv, O + (rb + q0row) * ldo + h * ohs, ldo, NT, segB, qlat0, klat0, m0, l0, lds, wv);
    }
}
}

#define XB_TMO      128
#define XB_XCNT(j)  (256  + 64 * (j))
#define XB_XSUB(j)  (1280 + 64 * (j))
#define XB_XGEN(j)  (2304 + 64 * (j))
#define XB_TOP      3328
#define XB_TOPGEN   3392
#define XCD_BAR_WORDS 3456
#define XB_SPIN_CAP (1u << 18)
__device__ __forceinline__ unsigned xb_ld(unsigned* p)              { return __hip_atomic_load(p, __ATOMIC_RELAXED, __HIP_MEMORY_SCOPE_AGENT); }
__device__ __forceinline__ unsigned xb_add(unsigned* p, unsigned v) { return __hip_atomic_fetch_add(p, v, __ATOMIC_RELAXED, __HIP_MEMORY_SCOPE_AGENT); }
__device__ __forceinline__ unsigned xb_xcc_id() { return (unsigned)__builtin_amdgcn_s_getreg((3 << 11) | 20) & 0xFu; }
#define XB_SPIN(cond, bar) do { unsigned _sp = 0; while (cond) { __builtin_amdgcn_s_sleep(1); \
    if ((++_sp & 255u) == 0u) { if (xb_ld(&(bar)[XB_TMO])) break; if (_sp > XB_SPIN_CAP) { atomicAdd(&(bar)[XB_TMO], 1u); break; } } } } while (0)
struct XcdBarrier { unsigned* bar; unsigned x; volatile LAS unsigned* st; };
__device__ __forceinline__ XcdBarrier xcd_barrier_post(unsigned* bar, volatile LAS unsigned* st) {
    XcdBarrier b; b.bar = bar; b.x = xb_xcc_id(); b.st = st;
    if (threadIdx.x == 0) (void)xb_add(&bar[XB_XCNT(b.x)], 1u);
    return b;
}
__device__ __forceinline__ void xcd_barrier_complete(unsigned* bar, unsigned x, unsigned& nloc, unsigned& nx) {
    const unsigned G = gridDim.x * gridDim.y * gridDim.z;
    unsigned sum, cnt, mine, sp = 0u;
    for (;;) {
        sum = 0u; cnt = 0u; mine = 0u;
#pragma unroll
        for (unsigned j = 0; j < 16; ++j) { const unsigned c = xb_ld(&bar[XB_XCNT(j)]); sum += c; cnt += (c > 0u) ? 1u : 0u; mine = (j == x) ? c : mine; }
        if (sum == G) break;
        __builtin_amdgcn_s_sleep(1);
        if ((++sp & 255u) == 0u) { if (xb_ld(&bar[XB_TMO])) break; if (sp > XB_SPIN_CAP) { atomicAdd(&bar[XB_TMO], 1u); break; } }
    }
    nloc = mine > 0u ? mine : 1u; nx = cnt > 0u ? cnt : 1u;
}
__device__ __forceinline__ void xcd_barrier(const XcdBarrier& b, int wv) {
    asm volatile("s_waitcnt vmcnt(0)" ::: "memory");
    __syncthreads();
    if (otid(wv) == 0) {
        unsigned* bar = b.bar;
        __builtin_amdgcn_s_waitcnt(0);
        unsigned nloc = b.st[0], nx = b.st[1];
        if (nloc == 0u) { xcd_barrier_complete(bar, b.x, nloc, nx); b.st[0] = nloc; b.st[1] = nx; }
        const unsigned old = xb_add(&bar[XB_XSUB(b.x)], 1u);
        const unsigned gen = old / nloc;
        if (old + 1u == (gen + 1u) * nloc) {
            __builtin_amdgcn_fence(__ATOMIC_RELEASE, "agent");
            asm volatile("s_waitcnt vmcnt(0)" ::: "memory");
            const unsigned og = xb_add(&bar[XB_TOP], 1u);
            const unsigned tg = og / nx;
            if (og + 1u == (tg + 1u) * nx) xb_add(&bar[XB_TOPGEN], 1u);
            else XB_SPIN(xb_ld(&bar[XB_TOPGEN]) == tg, bar);
            __builtin_amdgcn_fence(__ATOMIC_ACQUIRE, "agent");
            xb_add(&bar[XB_XGEN(b.x)], 1u);
            asm volatile("s_waitcnt vmcnt(0)" ::: "memory");
        } else {
            XB_SPIN(xb_ld(&bar[XB_XGEN(b.x)]) == gen, bar);
            __builtin_amdgcn_fence(__ATOMIC_ACQUIRE, "agent");
            asm volatile("s_waitcnt vmcnt(0)" ::: "memory");
        }
    }
    __syncthreads();
}

constexpr int RING_OFF = 0, GT_OFF = 131072, MISC_OFF = GT_OFF + 15360, LDS_BYTES = MISC_OFF + 1024;
constexpr int MAX_UNITS_PER_WG = 30;
constexpr int NPH = 35;
__device__ __forceinline__ void grouped_setup(const P& p, int wv, int m, LAS int* tl) {
    __syncthreads();
    if (otid(wv) == 0) { const unsigned* cnt = WSP(const unsigned, WS_CTL) + CW_CNT + 64 * m; int o = 0;
        for (int e = 0; e < NE; ++e) { tl[e] = o; const int c = (int)__hip_atomic_load(cnt + e, __ATOMIC_RELAXED, __HIP_MEMORY_SCOPE_AGENT); tl[16 + e] = c; o += (c + 255) >> 8; }
        tl[8] = o; }
    __syncthreads();
}
template <int K, int N, class Epi, int SPLIT = 1, int SKIPCTX = 0, bool ATILE = false, bool BTILE = false> __device__ __forceinline__ void gemm_plain(const P& p, int wv, unsigned char* lds_, const bf16* A, const bf16* Bt, const Epi& E) {
    LAS unsigned char* lds = (LAS unsigned char*)lds_;
    constexpr int nM = SKIPCTX ? 128 : T / 256, nwg = nM * (N / 256), R = nwg % 256;
    pg8::Sched S; S.init(nM, N / 256, (int)gridDim.x, (int)blockIdx.x, (const LAS int*)(lds + MISC_OFF), 0, (SPLIT && R > 0 && 4 * R <= 256) ? 1 : 0, SKIPCTX);
    pg8::gemm_phase<Epi, false, K, false, ATILE, BTILE>(wv, lds + RING_OFF, A, Bt, 0, S, E, nullptr);
    if constexpr (SPLIT && R > 0 && 4 * R <= 256) {
        pg8::Sched S2; S2.init(nM, N / 256, (int)gridDim.x, (int)blockIdx.x, (const LAS int*)(lds + MISC_OFF), 0, 2, SKIPCTX);
        pg8::gemm_sub_unit<Epi, K, ATILE, BTILE>(wv, lds + RING_OFF, A, Bt, 0, S2, E);
    }
}
__device__ __forceinline__ void moe_w13(const P& p, int wv, unsigned char* lds_, int m) {
    LAS unsigned char* lds = (LAS unsigned char*)lds_; LAS int* tl = (LAS int*)(lds + MISC_OFF); LAS unsigned short* gtab = (LAS unsigned short*)(lds + GT_OFF);
    grouped_setup(p, wv, m, tl);
    pg8::Sched S; S.init(tl[8], 2 * FE / 256, (int)gridDim.x, (int)blockIdx.x, tl, 1);
    const int* idx = WSP(const int, WS_IDX); const int tidg = otid(wv);
    { static_assert(MAX_UNITS_PER_WG % 2 == 0, "two units per step");
      const int half = __builtin_amdgcn_readfirstlane(tidg >> 8), row = tidg & 255; int vals[MAX_UNITS_PER_WG / 2];
#pragma unroll
      for (int k = 0; k < MAX_UNITS_PER_WG / 2; ++k) { pg8::Unit u; int v = 0;
          if (S.next(2 * k + half, u)) { const int pr = (u.pm - tl[u.e]) * 256 + row; const int* ie = idx + (size_t)u.e * T; v = ie[pr < tl[16 + u.e] ? pr : 0]; }
          vals[k] = v; }
#pragma unroll
      for (int k = 0; k < MAX_UNITS_PER_WG / 2; ++k) gtab[(2 * k + half) * 256 + row] = (unsigned short)vals[k]; }
    __syncthreads();
    pg8::EpiSwiglu E{WSP(bf16, WS_ACT), FE};
    pg8::gemm_phase<pg8::EpiSwiglu, true, DM>(wv, lds + RING_OFF, WSP(const bf16, WS_A), WSP(const bf16, W_13M) + (size_t)m * NE * 2 * FE * DM, (size_t)2 * FE * DM, S, E, gtab);
}
__device__ __forceinline__ void moe_w2(const P& p, int wv, unsigned char* lds_, int m) {
    LAS unsigned char* lds = (LAS unsigned char*)lds_; LAS int* tl = (LAS int*)(lds + MISC_OFF);
    grouped_setup(p, wv, m, tl);
    pg8::Sched S; S.init(tl[8], DM / 256, (int)gridDim.x, (int)blockIdx.x, tl, 1, 1, 0);
    pg8::EpiStore E{WSP(bf16, WS_Y), DM, nullptr};
    pg8::gemm_phase<pg8::EpiStore, false, FE, false, true, true>(wv, lds + RING_OFF, WSP(const bf16, WS_ACT), WSP(const bf16, W_2M) + (size_t)m * NE * DM * FE, (size_t)DM * FE, S, E, nullptr);
    pg8::Sched S2; S2.init(tl[8], DM / 256, (int)gridDim.x, (int)blockIdx.x, tl, 1, 2, 0);
    pg8::gemm_sub_unit<pg8::EpiStore, FE, true, true>(wv, lds + RING_OFF, WSP(const bf16, WS_ACT), WSP(const bf16, W_2M) + (size_t)m * NE * DM * FE, (size_t)DM * FE, S2, E);
}
__device__ __forceinline__ void dense_w13(const P& p, int wv, unsigned char* lds, int pi) { pg8::EpiSwiglu E{WSP(bf16, WS_ACT), FF}; gemm_plain<DM, 2 * FF, pg8::EpiSwiglu, 0>(p, wv, lds, WSP(const bf16, WS_A), WSP(const bf16, W_13F) + (size_t)pi * 2 * FF * DM, E); }
__device__ __forceinline__ void dense_w2(const P& p, int wv, unsigned char* lds, int pi, int layer) { pg8::EpiResid E{p.in[0], p.in[2], p.ws, layer, 5, 0}; gemm_plain<FF, DM, pg8::EpiResid, 1, 0, true, true>(p, wv, lds, WSP(const bf16, WS_ACT), WSP(const bf16, W_2F) + (size_t)pi * DM * FF, E); }
template <int SKIPCTX = 0> __device__ __forceinline__ void wo_gemm(const P& p, int wv, unsigned char* lds, const bf16* Ain, size_t woff, int layer, int from_in) { pg8::EpiResid E{p.in[0], p.in[2], p.ws, layer, 2, from_in}; gemm_plain<DM, DM, pg8::EpiResid, 1, SKIPCTX>(p, wv, lds, Ain, WSP(const bf16, woff), E); }

template <int PH> __device__ __forceinline__ void run_phase(const P& p, int wv, unsigned char* lds) {
    const int bid = blockIdx.x, nb = gridDim.x;
    if constexpr (PH == 0) phase_prologue(p, wv, bid, nb, lds);
    if constexpr (PH == 1) phase_norm_plain<true>(p, wv, bid, nb, 0, 0);
    if constexpr (PH == 2) { pg8::EpiStore E{WSP(bf16, WS_QKV), A_NQKV, nullptr}; gemm_plain<DM, A_NQKV>(p, wv, lds, WSP(const bf16, WS_A), WSP(const bf16, W_QKVA), E); }
    if constexpr (PH == 3) phase_post_a(p, wv, bid, nb);
    if constexpr (PH == 4) att::attn_phase<128, 128, 2, false, 0, true>(WSP(const bf16, WS_QKV), A_NQKV, 128, WSP(const bf16, WS_QKV) + 1024, A_NQKV, 128, WSP(const bf16, WS_QKV) + 1280, A_NQKV, 128, WSP(bf16, WS_OB), DM, 128, 8, 4, nullptr, (char*)lds, wv);
    if constexpr (PH == 5) wo_gemm(p, wv, lds, WSP(const bf16, WS_OB), W_OA, 0, 1);
    if constexpr (PH == 6) phase_norm_plain<false>(p, wv, bid, nb, 0, 1);
    if constexpr (PH == 7) dense_w13(p, wv, lds, 0);
    if constexpr (PH == 8) dense_w2(p, wv, lds, 0, 0);
    if constexpr (PH == 9) phase_norm_plain<false>(p, wv, bid, nb, 1, 0);
    if constexpr (PH == 10) { pg8::EpiStore E{WSP(bf16, WS_DOWN), B_NDOWN_P, nullptr}; gemm_plain<DM, B_NDOWN_P>(p, wv, lds, WSP(const bf16, WS_A), WSP(const bf16, W_DOWN), E); }
    if constexpr (PH == 11) phase_post_b1(p, wv, bid, nb);
    if constexpr (PH == 12) { pg8::EpiStoreT<1> E{WSP(bf16, WS_QKV), 1536, WSP(const f32x2, WS_ROPE64)}; gemm_plain<B_QL, B_NUQ>(p, wv, lds, WSP(const bf16, WS_DQN), WSP(const bf16, W_UQ), E); }
    if constexpr (PH == 13) { pg8::EpiKV E{WSP(bf16, WS_KB), WSP(bf16, WS_VB)}; gemm_plain<B_KVL, B_NUKV>(p, wv, lds, WSP(const bf16, WS_DKVN), WSP(const bf16, W_UKV), E); }
    if constexpr (PH == 14) att::attn_phase<192, 128, 1, false, 5>(WSP(const bf16, WS_QKV), 1536, 192, WSP(const bf16, WS_KB), 1536, 192, WSP(const bf16, WS_VB), DM, 128, WSP(bf16, WS_OB), DM, 128, 8, 1, nullptr, (char*)lds, wv);
    if constexpr (PH == 15) wo_gemm(p, wv, lds, WSP(const bf16, WS_OB), W_OB, 1, 0);
    if constexpr (PH == 16) phase_norm<4>(p, wv, bid, nb, lds, 1, 1, 0, 0, 0, true);
    if constexpr (PH == 17) moe_w13(p, wv, lds, 0);
    if constexpr (PH == 18) moe_w2(p, wv, lds, 0);
    if constexpr (PH == 19) phase_combine<false>(p, wv, bid, nb, lds, 2, 0, 0, 1);
    if constexpr (PH == 20) { pg8::EpiGelu E{WSP(bf16, WS_QKV), WSP(bf16, WS_KB)}; gemm_plain<DM, C_NIN>(p, wv, lds, WSP(const bf16, WS_A), WSP(const bf16, W_IN), E); }
    if constexpr (PH == 21) phase_sgu(p, wv, bid, nb, lds);
    if constexpr (PH == 22) wo_gemm(p, wv, lds, WSP(const bf16, WS_VB), W_OUT, 2, 0);
    if constexpr (PH == 23) phase_norm_plain<false>(p, wv, bid, nb, 2, 1);
    if constexpr (PH == 24) dense_w13(p, wv, lds, 1);
    if constexpr (PH == 25) dense_w2(p, wv, lds, 1, 2);
    if constexpr (PH == 26) phase_norm_plain<false>(p, wv, bid, nb, 3, 0);
    if constexpr (PH == 27) { pg8::EpiStoreT<3> E{WSP(bf16, WS_QKV), D_NQKV, WSP(const f32x2, WS_ROPE64)}; gemm_plain<DM, D_NQKV>(p, wv, lds, WSP(const bf16, WS_A), WSP(const bf16, W_QKVD), E); }
    if constexpr (PH == 29) att::attn_phase<64, 64, 2, true, 0>(WSP(const bf16, WS_QKV), D_NQKV, 64, WSP(const bf16, WS_QKV) + 1024, D_NQKV, 64, WSP(const bf16, WS_QKV) + 1152, D_NQKV, 64, WSP(bf16, WS_OB), DM, 64, 16, 8, p.in[26], (char*)lds, wv);
    if constexpr (PH == 30) wo_gemm<1>(p, wv, lds, WSP(const bf16, WS_OB), W_OD, 3, 0);
    if constexpr (PH == 31) phase_norm<4>(p, wv, bid, nb, lds, 3, 1, 0, 0, 1, false);
    if constexpr (PH == 32) moe_w13(p, wv, lds, 1);
    if constexpr (PH == 33) moe_w2(p, wv, lds, 1);
    if constexpr (PH == 34) phase_combine<true>(p, wv, bid, nb, lds, 0, 0, 1, 3);
}
#ifndef MK_PER_PHASE
#define MK_PER_PHASE 0
#endif
template <int PH> __global__ void __launch_bounds__(512, 2) k_phase(P p) {
    extern __shared__ __attribute__((aligned(16))) unsigned char lds[];
    run_phase<PH>(p, __builtin_amdgcn_readfirstlane((int)threadIdx.x >> 6), lds);
}
#define AS4 __attribute__((address_space(4)))
#ifndef PROBE_DUP_MASK
#define PROBE_DUP_MASK 0ull
#endif
template <int PH> __device__ __forceinline__ void phase_fn(const AS4 P* pp, int wv, LAS unsigned char* lds_) {
    const AS4 P* q = pp; asm volatile("" : "+s"(q));
    P p;
#pragma unroll
    for (int i = 0; i < 33; ++i) p.in[i] = q->in[i];
    p.out = q->out; p.ws = q->ws; p.ph_lo = 0; p.ph_hi = 0;
    run_phase<PH>(p, wv, (unsigned char*)lds_);
}
template <int PH> __device__ __forceinline__ void run_all(const AS4 P* pp, int wv, LAS unsigned char* lds, const XcdBarrier& bar) {
    constexpr bool on = (PH != 28);
    if constexpr (on) phase_fn<PH>(pp, wv, lds);
    if constexpr (on && ((PROBE_DUP_MASK >> PH) & 1ull) != 0) { __syncthreads(); phase_fn<PH>(pp, wv, lds); }
    if constexpr (PH + 1 < NPH) { if constexpr (on) xcd_barrier(bar, wv); run_all<PH + 1>(pp, wv, lds, bar); }
}
__global__ void __launch_bounds__(512, 2) k_mega(P p_) {
    extern __shared__ __attribute__((aligned(16))) unsigned char lds[];
    const AS4 P* pp = (const AS4 P*)__builtin_amdgcn_kernarg_segment_ptr();
    const int wv = __builtin_amdgcn_readfirstlane((int)threadIdx.x >> 6);
    LAS unsigned* misc = (LAS unsigned*)((LAS unsigned char*)lds + MISC_OFF);
    if (threadIdx.x < 256) misc[threadIdx.x] = 0u;
    __syncthreads();
    const XcdBarrier bar = xcd_barrier_post((unsigned*)(pp->ws + WS_CTL) + CW_BAR, (volatile LAS unsigned*)(misc + 64));
    run_all<0>(pp, wv, (LAS unsigned char*)lds, bar);
}

template <int PH> static void phase(hipStream_t st, const P& p) {
    static bool attr = false; if (!attr) { (void)hipFuncSetAttribute((const void*)k_phase<PH>, hipFuncAttributeMaxDynamicSharedMemorySize, LDS_BYTES); attr = true; }
    hipLaunchKernelGGL((k_phase<PH>), dim3(256), dim3(512), LDS_BYTES, st, p);
}
template <int LO, int HI> static void phases(hipStream_t st, const P& p) { if constexpr (LO < HI) { phase<LO>(st, p); phases<LO + 1, HI>(st, p); } }

extern "C" void kernel_launch(void* const* d_in, const int* in_sizes, int n_in, void* d_out, int out_size, void* d_ws, size_t ws_size, hipStream_t stream) {
    if (n_in != 33 || ws_size < WS_END || out_size != NB * SEQ * DM) { fprintf(stderr, "kernel_launch: unexpected shapes n_in %d ws %zu (need %zu) out %d\n", n_in, ws_size, (size_t)WS_END, out_size); return; }
    P p{}; for (int i = 0; i < 33; ++i) p.in[i] = (const float*)d_in[i]; p.out = (float*)d_out; p.ws = (unsigned char*)d_ws; p.ph_lo = 0; p.ph_hi = 0;
    unsigned char* ws = (unsigned char*)d_ws;
    (void)hipMemsetAsync(ws + WS_CTL, 0, CTL_BYTES, stream);
#if MK_PER_PHASE
    phases<0, NPH>(stream, p);
#else
    static int grid = 0;
    if (grid == 0) {
        int dev = 0, cus = 0, per_cu = 0;
        (void)hipGetDevice(&dev); (void)hipDeviceGetAttribute(&cus, hipDeviceAttributeMultiprocessorCount, dev);
        if (hipFuncSetAttribute((const void*)k_mega, hipFuncAttributeMaxDynamicSharedMemorySize, LDS_BYTES) != hipSuccess) { fprintf(stderr, "kernel_launch: hipFuncSetAttribute failed\n"); grid = -1; return; }
        if (hipOccupancyMaxActiveBlocksPerMultiprocessor(&per_cu, (const void*)k_mega, 512, LDS_BYTES) != hipSuccess || per_cu < 1) { fprintf(stderr, "kernel_launch: occupancy query says %d blocks per CU\n", per_cu); (void)hipGetLastError(); }
        grid = cus;
        if (grid != 256) fprintf(stderr, "kernel_launch: %d CUs (built for 256)\n", grid);
    }
    if (grid < 0) return;
    hipLaunchKernelGGL(k_mega, dim3(grid), dim3(512), LDS_BYTES, stream, p);
#endif
    const hipError_t le = hipPeekAtLastError();
    if (le != hipSuccess) fprintf(stderr, "kernel_launch: launch failed: %s\n", hipGetErrorName(le));
}
```

```cpp
#include <hip/hip_runtime.h>
#include <cstdio>
#include <cstdint>
#include <cstring>
#include <cmath>

#define GAS __attribute__((address_space(1)))
#define LAS __attribute__((address_space(3)))
typedef unsigned short bf16;
typedef float f32x4 __attribute__((ext_vector_type(4)));
typedef float f32x2 __attribute__((ext_vector_type(2)));
typedef short bf16x8 __attribute__((ext_vector_type(8)));
typedef unsigned u32x4 __attribute__((ext_vector_type(4)));
typedef unsigned u32x2 __attribute__((ext_vector_type(2)));

constexpr int DM = 1024, NB = 4, SEQ = 8192, NCTX = 256, RPB = SEQ + NCTX  , T = NB * RPB  ;
constexpr int GRIDW = 64;
constexpr float EPS = 1e-6f;
constexpr int A_NQKV = 1536, B_NDOWN = 704, B_NDOWN_P = 768, B_QL = 384, B_KVL = 256, B_NUQ = 1536, B_NUKV = 2048, C_NIN = 2048, D_NQKV = 1280;
constexpr int FF = 2816, FE = 3584, NE = 8;
constexpr int MAXSLOT = 69632;

constexpr size_t MiB = 1u << 20;
constexpr size_t al(size_t x) { return (x + 255) & ~(size_t)255; }
constexpr size_t WS_CTL = 0, CTL_BYTES = 1 * MiB;
constexpr size_t WS_MOD = 1 * MiB;
constexpr size_t WS_ROPE128 = 2 * MiB;
constexpr size_t WS_ROPE64 = WS_ROPE128 + 128 * 32 * 8;
constexpr size_t WS_IDX = 3 * MiB;
constexpr size_t WS_GW = WS_IDX + al((size_t)NE * T * 4);
constexpr size_t WS_TOK = WS_GW + al((size_t)NE * T * 4);
constexpr size_t WS_TOKW = WS_TOK + al((size_t)T * 16);
constexpr size_t WS_W0 = 8 * MiB;
static_assert(WS_TOKW + (size_t)T * 8 <= WS_W0, "routing tables fit below the weights");
constexpr size_t W_QKVA = WS_W0;
constexpr size_t W_OA = W_QKVA + (size_t)A_NQKV * DM * 2;
constexpr size_t W_DOWN = W_OA + (size_t)DM * DM * 2;
constexpr size_t W_UQ = W_DOWN + (size_t)B_NDOWN_P * DM * 2;
constexpr size_t W_UKV = W_UQ + (size_t)B_NUQ * B_QL * 2;
constexpr size_t W_OB = W_UKV + (size_t)B_NUKV * B_KVL * 2;
constexpr size_t W_IN = W_OB + (size_t)DM * DM * 2;
constexpr size_t W_OUT = W_IN + (size_t)C_NIN * DM * 2;
constexpr size_t W_SP = W_OUT + (size_t)DM * DM * 2;
constexpr size_t W_QKVD = W_SP + (size_t)8 * 128 * 128 * 2;
constexpr size_t W_OD = W_QKVD + (size_t)D_NQKV * DM * 2;
constexpr size_t W_13F = W_OD + (size_t)DM * DM * 2;
constexpr size_t W_2F = W_13F + (size_t)2 * 2 * FF * DM * 2;
constexpr size_t W_13M = W_2F + (size_t)2 * DM * FF * 2;
constexpr size_t W_2M = W_13M + (size_t)2 * NE * 2 * FE * DM * 2;
constexpr size_t WS_WEND = W_2M + (size_t)2 * NE * DM * FE * 2;
constexpr size_t WS_H = al(WS_WEND);
constexpr size_t WS_A = WS_H + (size_t)T * DM * 2;
constexpr size_t WS_QKV = WS_A + (size_t)T * DM * 2;
constexpr size_t WS_KB = WS_QKV + (size_t)T * 1536 * 2;
constexpr size_t WS_VB = WS_KB + (size_t)T * 1536 * 2;
constexpr size_t WS_OB = WS_VB + (size_t)T * DM * 2;
constexpr size_t WS_DOWN = WS_OB + (size_t)T * DM * 2;
constexpr size_t WS_DQN = WS_DOWN + (size_t)T * B_NDOWN_P * 2;
constexpr size_t WS_DKVN = WS_DQN + (size_t)T * B_QL * 2;
constexpr size_t WS_ACT = WS_DKVN + (size_t)T * B_KVL * 2;
constexpr size_t WS_Y = WS_ACT + (size_t)MAXSLOT * FE * 2;
constexpr size_t WS_END = WS_Y + (size_t)MAXSLOT * DM * 2;
constexpr int CW_CNT = 64;
constexpr int CW_BAR = 4096;

__device__ __forceinline__ unsigned f2bf(float f) { unsigned u = __builtin_bit_cast(unsigned, f); return (u + 0x7fffu + ((u >> 16) & 1u)) >> 16; }
__device__ __forceinline__ unsigned pk2(float lo, float hi) { unsigned r; asm("v_cvt_pk_bf16_f32 %0, %1, %2" : "=v"(r) : "v"(lo), "v"(hi)); return r; }
__device__ __forceinline__ float bf2f(unsigned b) { return __builtin_bit_cast(float, b << 16); }
__device__ __forceinline__ float bflo(unsigned w) { return __builtin_bit_cast(float, w << 16); }
__device__ __forceinline__ float bfhi(unsigned w) { return __builtin_bit_cast(float, w & 0xffff0000u); }
__device__ __forceinline__ float wave_sum(float v) {
#pragma unroll
    for (int o = 1; o < 64; o <<= 1) v += __shfl_xor(v, o);
    return v;
}
__device__ __forceinline__ int otid(int wv) { int l; asm volatile("v_mbcnt_lo_u32_b32 %0, -1, 0\n\tv_mbcnt_hi_u32_b32 %0, -1, %0" : "=v"(l)); return wv * 64 + l; }
__device__ __forceinline__ float silu_f(float x) { return x / (1.f + __expf(-x)); }
__device__ __forceinline__ float gelu_erf(float x) { return 0.5f * x * (1.f + erff(x * 0.70710678118654752f)); }

struct P {
    const float* in[33];
    float* out;
    unsigned char* ws;
    int ph_lo, ph_hi;
};
#define WSP(type, off) ((type*)(p.ws + (off)))
#define SUB_SKIP(u, ai, bj) ((u).sub != 0 && (u).sub != 1 + (ai) * 2 + (bj))

__device__ __forceinline__ void row_info(int r, int& b, int& j) { b = r / RPB; j = r - b * RPB; }
__device__ __forceinline__ const float* in_row(const P& p, int r) {
    int b, j; row_info(r, b, j);
    return j < NCTX ? p.in[2] + ((size_t)b * NCTX + j) * DM : p.in[0] + ((size_t)b * SEQ + (j - NCTX)) * DM;
}
__device__ __forceinline__ const float* mod_vec(const P& p, int layer, int r, int chunk) {
    int b, j; row_info(r, b, j); const int mr = j < NCTX ? 4 : b;
    return WSP(const float, WS_MOD) + ((size_t)(layer * 5 + mr) * 6 + chunk) * DM;
}

__device__ __forceinline__ void transpose_item(const float* W, int K, int N, bf16* WT, int mode, int ffh, LAS float* scr, int item, int lane) {
    const int nblk = N / 64, kb = item / nblk, nb = item % nblk, k0 = 64 * kb, n0 = 64 * nb;
    const int lr = lane >> 4, lc = (lane & 15) * 4;
#pragma unroll 8
    for (int i = 0; i < 16; ++i) { const int kk = 4 * i + lr; const f32x4 v = *(const f32x4*)(W + (size_t)(k0 + kk) * N + n0 + lc); LAS float* d = scr + kk * 65 + lc; d[0] = v.x; d[1] = v.y; d[2] = v.z; d[3] = v.w; }
    asm volatile("s_waitcnt lgkmcnt(0)" ::: "memory");
    int d0 = n0;
    if (mode == 1) { if (n0 < ffh) d0 = (n0 / 128) * 256 + n0 % 128; else { const int j = n0 - ffh; d0 = (j / 128) * 256 + 128 + j % 128; } }
    const int c = lane & 7;
#pragma unroll
    for (int j = 0; j < 8; ++j) { const int n = (lane >> 3) + 8 * j; const LAS float* s = scr + (8 * c) * 65 + n;
        u32x4 o; o.x = pk2(s[0 * 65], s[1 * 65]); o.y = pk2(s[2 * 65], s[3 * 65]); o.z = pk2(s[4 * 65], s[5 * 65]); o.w = pk2(s[6 * 65], s[7 * 65]);
        const int dn = d0 + n;
        if (mode == 2) *(u32x4*)(WT + (((size_t)(dn >> 8) * (K >> 6) + kb) * 256 + (dn & 255)) * 64 + 8 * c) = o;
        else *(u32x4*)(WT + (size_t)dn * K + k0 + 8 * c) = o; }
    asm volatile("s_waitcnt lgkmcnt(0)" ::: "memory");
}
struct TJob { const float* W; bf16* WT; int K, N, mode, ffh, items; };

__device__ __forceinline__ void phase_prologue(const P& p, int wv, int bid, int nb, unsigned char* lds_) {
    LAS unsigned char* lds = (LAS unsigned char*)lds_;
    const int tid = otid(wv), lane = tid & 63, wave = tid >> 6;
    {
        const int g = bid * 512 + tid;
        if (g < 128 * 32) { const int pos = g >> 5, i = g & 31; const float inv = (float)pow(10000.0, -(double)i / 32.0); const float a = (float)pos * inv;
            WSP(f32x2, WS_ROPE128)[g] = (f32x2){cosf(a), sinf(a)}; }
        else if (g < 128 * 32 + 128 * 16) { const int q = g - 128 * 32, pos = q >> 4, i = q & 15; const float inv = (float)pow(10000.0, -(double)i / 16.0); const float a = (float)pos * inv;
            WSP(f32x2, WS_ROPE64)[q] = (f32x2){cosf(a), sinf(a)}; }
    }
    {
        LAS float* sc = (LAS float*)lds;
        LAS float* red = (LAS float*)(lds + 5 * 1024 * 4);
        for (int it = bid; it < 192; it += nb) {
            const int layer = it / 48, cg = it % 48;
            __syncthreads();
            for (int i = tid; i < 5 * 1024; i += 512) { const int r = i >> 10, k = i & 1023; const float v = r < 4 ? p.in[1][r * DM + k] : p.in[3][k]; sc[i] = silu_f(v); }
            __syncthreads();
            const float* W = p.in[4] + (size_t)layer * DM * 6144 + cg * 128 + lane * 2;
            f32x2 acc[5];
#pragma unroll
            for (int r = 0; r < 5; ++r) acc[r] = (f32x2){0.f, 0.f};
            for (int k = wave * 128; k < wave * 128 + 128; ++k) { const f32x2 w = *(const f32x2*)(W + (size_t)k * 6144);
#pragma unroll
                for (int r = 0; r < 5; ++r) acc[r] += w * sc[r * 1024 + k]; }
#pragma unroll
            for (int r = 0; r < 5; ++r) *(LAS f32x2*)(red + (wave * 5 + r) * 128 + lane * 2) = acc[r];
            __syncthreads();
            for (int i = tid; i < 5 * 128; i += 512) { const int r = i >> 7, c = i & 127; float s = 0.f;
#pragma unroll
                for (int w = 0; w < 8; ++w) s += red[(w * 5 + r) * 128 + c];
                const int col = cg * 128 + c;
                WSP(float, WS_MOD)[(size_t)(layer * 5 + r) * 6144 + col] = s + p.in[5][layer * 6144 + col]; }
        }
        __syncthreads();
    }
    {
        LAS float* scr = (LAS float*)(lds + wave * 16640);
        const int gw = bid * 8 + wave, NGW = nb * 8;
        int start = 0;
        auto run = [&](const float* W, bf16* WT, int K, int N, int mode, int ffh) {
            const int items = (K / 64) * (N / 64);
            int first = gw - start; if (first < 0) first += NGW;
            for (int it = first; it < items; it += NGW) transpose_item(W, K, N, WT, mode, ffh, scr, it, lane);
            start = (start + items) % NGW;
        };
        run(p.in[9], WSP(bf16, W_QKVA), DM, A_NQKV, 0, 0);
        run(p.in[12], WSP(bf16, W_OA), DM, DM, 0, 0);
        run(p.in[13], WSP(bf16, W_DOWN), DM, B_NDOWN, 0, 0);
        run(p.in[16], WSP(bf16, W_UQ), B_QL, B_NUQ, 0, 0);
        run(p.in[17], WSP(bf16, W_UKV), B_KVL, B_NUKV, 0, 0);
        run(p.in[18], WSP(bf16, W_OB), DM, DM, 0, 0);
        run(p.in[19], WSP(bf16, W_IN), DM, C_NIN, 0, 0);
        run(p.in[24], WSP(bf16, W_OUT), DM, DM, 0, 0);
        run(p.in[25], WSP(bf16, W_QKVD), DM, D_NQKV, 0, 0);
        run(p.in[27], WSP(bf16, W_OD), DM, DM, 0, 0);
        for (int l = 0; l < 2; ++l) {
            run(p.in[28] + (size_t)l * DM * 2 * FF, WSP(bf16, W_13F) + (size_t)l * 2 * FF * DM, DM, 2 * FF, 1, FF);
            run(p.in[29] + (size_t)l * FF * DM, WSP(bf16, W_2F) + (size_t)l * DM * FF, FF, DM, 2, 0);
        }
        for (int le = 0; le < 2 * NE; ++le) {
            run(p.in[31] + (size_t)le * DM * 2 * FE, WSP(bf16, W_13M) + (size_t)le * 2 * FE * DM, DM, 2 * FE, 1, FE);
            run(p.in[32] + (size_t)le * FE * DM, WSP(bf16, W_2M) + (size_t)le * DM * FE, FE, DM, 2, 0);
        }
        const int g = bid * 512 + tid, ng = nb * 512;
        for (int i = g; i < 64 * DM / 8; i += ng) *(u32x4*)(WSP(bf16, W_DOWN) + (size_t)B_NDOWN * DM + i * 8) = (u32x4){0u, 0u, 0u, 0u};
        for (int i = g; i < 8 * 128 * 128 / 4; i += ng) { const f32x4 v = *(const f32x4*)(p.in[22] + i * 4); *(u32x2*)(WSP(bf16, W_SP) + i * 4) = (u32x2){pk2(v.x, v.y), pk2(v.z, v.w)}; }
    }
}

__device__ __forceinline__ void moe_offsets_lds(const P& p, int m, LAS int* off  ) {
    const unsigned* cnt = WSP(const unsigned, WS_CTL) + CW_CNT + 64 * m; int o = 0;
    for (int e = 0; e < NE; ++e) { off[e] = o; const int c = (int)__hip_atomic_load(cnt + e, __ATOMIC_RELAXED, __HIP_MEMORY_SCOPE_AGENT); o += (c + 255) & ~255; }
    off[NE] = o;
}

template <int MODE>
__device__ __forceinline__ void phase_norm(const P& p, int wv, int bid, int nb, unsigned char* lds_, int layer, int which  , int m_prev, int prev_layer, int m_cur, bool route_ctx) {
    LAS unsigned char* lds = (LAS unsigned char*)lds_;
    const int tid = otid(wv), lane = tid & 63, wave = tid >> 6;
    const int per = (T + nb - 1) / nb, r0 = bid * per, r1 = min(T, r0 + per);
    LAS float* rt = (LAS float*)lds;
    LAS int* re = (LAS int*)(lds + 32768);
    LAS float* rw = (LAS float*)(lds + 32768 + 8192);
    LAS int* soff = (LAS int*)(lds + 32768 + 16384);
    if (MODE & 4) { const float* R = p.in[30] + (size_t)m_cur * DM * NE; for (int i = tid; i < DM * NE; i += 512) rt[i] = R[i]; }
    if (MODE & 2) { if (tid == 0) moe_offsets_lds(p, m_prev, soff); }
    __syncthreads();
    const float* gain = (MODE & 8) ? p.in[8] : (which == 0 ? p.in[6] : p.in[7]) + (size_t)layer * DM;
    int cur_mr = -1; f32x4 gm[4], shv[4], g2v[4];
#pragma unroll
    for (int q = 0; q < 4; ++q) { gm[q] = (f32x4){0.f, 0.f, 0.f, 0.f}; shv[q] = gm[q]; g2v[q] = gm[q]; }
    for (int r = r0 + wave; r < r1; r += 8) {
        int b, j; row_info(r, b, j); const bool isctx = j < NCTX;
        if ((MODE & 8) && isctx) continue;
        { const int mr = isctx ? 4 : b;
          if (mr != cur_mr) { cur_mr = mr;
            if (MODE & 2) { const float* g2 = mod_vec(p, prev_layer, r, 5);
#pragma unroll
                for (int q = 0; q < 4; ++q) g2v[q] = *(const f32x4*)(g2 + q * 256 + lane * 4); }
            if (MODE & 8) {
#pragma unroll
                for (int q = 0; q < 4; ++q) gm[q] = *(const f32x4*)(gain + q * 256 + lane * 4); }
            else { const float* sh_ = mod_vec(p, layer, r, which * 3 + 0); const float* sc_ = mod_vec(p, layer, r, which * 3 + 1);
#pragma unroll
                for (int q = 0; q < 4; ++q) { const f32x4 g = *(const f32x4*)(gain + q * 256 + lane * 4), s1 = *(const f32x4*)(sc_ + q * 256 + lane * 4); gm[q] = g * (s1 + 1.f); shv[q] = *(const f32x4*)(sh_ + q * 256 + lane * 4); } } } }
        f32x4 v[4];
        if (MODE & 1) { const float* src = in_row(p, r);
#pragma unroll
            for (int q = 0; q < 4; ++q) v[q] = *(const f32x4*)(src + q * 256 + lane * 4); }
        else { const bf16* src = WSP(const bf16, WS_H) + (size_t)r * DM;
#pragma unroll
            for (int q = 0; q < 4; ++q) { const u32x2 w = *(const u32x2*)(src + q * 256 + lane * 4); v[q] = (f32x4){bflo(w.x), bfhi(w.x), bflo(w.y), bfhi(w.y)}; } }
        if (MODE & 2) {
            const int4 tk = WSP(const int4, WS_TOK)[r];
            const bool routed = tk.x >= 0;
            if (routed) {
                const int s0 = soff[tk.x] + tk.y, s1 = soff[tk.z] + tk.w;
                const bf16* y0 = WSP(const bf16, WS_Y) + (size_t)s0 * DM; const bf16* y1 = WSP(const bf16, WS_Y) + (size_t)s1 * DM;
                const f32x2 tw = WSP(const f32x2, WS_TOKW)[r];
#pragma unroll
                for (int q = 0; q < 4; ++q) { const u32x2 a = *(const u32x2*)(y0 + q * 256 + lane * 4), c = *(const u32x2*)(y1 + q * 256 + lane * 4); const f32x4 g = g2v[q];
                    v[q].x += g.x * (tw.x * bflo(a.x) + tw.y * bflo(c.x)); v[q].y += g.y * (tw.x * bfhi(a.x) + tw.y * bfhi(c.x)); v[q].z += g.z * (tw.x * bflo(a.y) + tw.y * bflo(c.y)); v[q].w += g.w * (tw.x * bfhi(a.y) + tw.y * bfhi(c.y)); }
                if (!(MODE & 8)) {
#pragma unroll
                    for (int q = 0; q < 4; ++q) *(u32x2*)(WSP(bf16, WS_H) + (size_t)r * DM + q * 256 + lane * 4) = (u32x2){pk2(v[q].x, v[q].y), pk2(v[q].z, v[q].w)};
                }
            }
        }
        float ss = 0.f;
#pragma unroll
        for (int q = 0; q < 4; ++q) ss += (v[q].x * v[q].x + v[q].y * v[q].y) + (v[q].z * v[q].z + v[q].w * v[q].w);
        const float rs = rsqrtf(wave_sum(ss) * (1.f / DM) + EPS);
        if (MODE & 8) {
            float* o = p.out + ((size_t)b * SEQ + (j - NCTX)) * DM;
#pragma unroll
            for (int q = 0; q < 4; ++q) *(f32x4*)(o + q * 256 + lane * 4) = v[q] * rs * gm[q];
            continue;
        }
#pragma unroll
        for (int q = 0; q < 4; ++q) {
            v[q] = (v[q] * rs) * gm[q] + shv[q];
            *(u32x2*)(WSP(bf16, WS_A) + (size_t)r * DM + q * 256 + lane * 4) = (u32x2){pk2(v[q].x, v[q].y), pk2(v[q].z, v[q].w)}; }
        if (MODE & 4) {
            const int li = r - r0;
            if (isctx && !route_ctx) { if (lane == 0) { re[li * 2] = -1; re[li * 2 + 1] = -1; } }
            else {
                float lg[8];
#pragma unroll
                for (int e = 0; e < 8; ++e) lg[e] = 0.f;
#pragma unroll
                for (int q = 0; q < 4; ++q)
#pragma unroll
                    for (int c = 0; c < 4; ++c) { const int col = q * 256 + lane * 4 + c; const f32x4 w0 = *(LAS f32x4*)(rt + col * 8), w1 = *(LAS f32x4*)(rt + col * 8 + 4); const float a = v[q][c];
                        lg[0] += a * w0.x; lg[1] += a * w0.y; lg[2] += a * w0.z; lg[3] += a * w0.w; lg[4] += a * w1.x; lg[5] += a * w1.y; lg[6] += a * w1.z; lg[7] += a * w1.w; }
#pragma unroll
                for (int e = 0; e < 8; ++e) lg[e] = wave_sum(lg[e]);
                int e0 = 0; float v0 = lg[0];
#pragma unroll
                for (int e = 1; e < 8; ++e) if (lg[e] > v0) { v0 = lg[e]; e0 = e; }
                int e1 = -1; float v1 = -3.0e38f;
#pragma unroll
                for (int e = 0; e < 8; ++e) if (e != e0 && lg[e] > v1) { v1 = lg[e]; e1 = e; }
                const float w1 = 1.f / (1.f + __expf(v0 - v1)), w0 = 1.f - w1;
                if (lane == 0) { re[li * 2] = e0; re[li * 2 + 1] = e1; rw[li * 2] = w0; rw[li * 2 + 1] = w1; }
            }
        }
    }
    if (MODE & 4) {
        __syncthreads();
        { LAS int* wcnt = (LAS int*)(lds + 32768 + 16384 + 256); LAS int* woff = wcnt + 64;
          const int n2 = 2 * (r1 - r0);
          int* idxb = WSP(int, WS_IDX); float* gwb = WSP(float, WS_GW); int* tok = WSP(int, WS_TOK);
          for (int ib = 0; ib < n2; ib += 512) {
              const int i = ib + tid; const int ei = (i < n2) ? re[i] : -1; int rank = 0;
#pragma unroll
              for (int e = 0; e < NE; ++e) { const unsigned long long mk = __ballot(ei == e); if (ei == e) rank = __popcll(mk & ((1ull << lane) - 1ull)); if (lane == 0) wcnt[wave * 8 + e] = __popcll(mk); }
              __syncthreads();
              if (tid < NE) { int c = 0;
                  for (int w = 0; w < 8; ++w) c += wcnt[w * 8 + tid];
                  unsigned* cnt = WSP(unsigned, WS_CTL) + CW_CNT + 64 * m_cur + tid;
                  int base = c ? (int)__hip_atomic_fetch_add(cnt, (unsigned)c, __ATOMIC_RELAXED, __HIP_MEMORY_SCOPE_AGENT) : 0;
                  for (int w = 0; w < 8; ++w) { woff[w * 8 + tid] = base; base += wcnt[w * 8 + tid]; } }
              __syncthreads();
              if (ei >= 0) { const int pos = woff[wave * 8 + ei] + rank, r = r0 + (i >> 1); const float wgt = rw[i];
                  idxb[(size_t)ei * T + pos] = r; gwb[(size_t)ei * T + pos] = wgt; tok[r * 4 + (i & 1) * 2] = ei; tok[r * 4 + (i & 1) * 2 + 1] = pos; WSP(float, WS_TOKW)[r * 2 + (i & 1)] = wgt; }
              __syncthreads();
          } }
        for (int i = tid; i < r1 - r0; i += 512) if (re[i * 2] < 0) { int* tok = WSP(int, WS_TOK); const int r = r0 + i; tok[r * 4] = -1; tok[r * 4 + 1] = 0; tok[r * 4 + 2] = -1; tok[r * 4 + 3] = 0; }
    }
}

template <bool FINAL>
__device__ __forceinline__ void phase_combine(const P& p, int wv, int bid, int nb, unsigned char* lds_, int layer, int which, int m_prev, int prev_layer) {
    LAS unsigned char* lds = (LAS unsigned char*)lds_;
    const int tid = otid(wv), lane = tid & 63, wave = tid >> 6;
    const int per = (T + nb - 1) / nb, r0 = bid * per, r1 = min(T, r0 + per);
    LAS int* soff = (LAS int*)(lds + 32768 + 16384);
    if (tid < NE) soff[16 + tid] = (int)__hip_atomic_load(WSP(const unsigned, WS_CTL) + CW_CNT + 64 * m_prev + tid, __ATOMIC_RELAXED, __HIP_MEMORY_SCOPE_AGENT);
    __syncthreads();
    if (tid == 0) { int o = 0; for (int e = 0; e < NE; ++e) { soff[e] = o; o += (soff[16 + e] + 255) & ~255; } soff[NE] = o; }
    __syncthreads();
    const float* gain = FINAL ? p.in[8] : (which == 0 ? p.in[6] : p.in[7]) + (size_t)layer * DM;
    int cur_mr = -1; f32x4 gm[4], shv[4], g2v[4];
#pragma unroll
    for (int q = 0; q < 4; ++q) { gm[q] = (f32x4){0.f, 0.f, 0.f, 0.f}; shv[q] = gm[q]; g2v[q] = gm[q]; }
    const int4* TOK = WSP(const int4, WS_TOK); const f32x2* TOKW = WSP(const f32x2, WS_TOKW);
    const bf16* Yb = WSP(const bf16, WS_Y); bf16* Hb = WSP(bf16, WS_H);
#define CMB_LOAD(hX, aX, cX, rr, tk) do { const bool _ro = (tk).x >= 0; const int _s0 = _ro ? soff[(tk).x] + (tk).y : 0, _s1 = _ro ? soff[(tk).z] + (tk).w : 0; \
        const bf16* _h = Hb + (size_t)(rr) * DM + lane * 4; const bf16* _y0 = Yb + (size_t)_s0 * DM + lane * 4; const bf16* _y1 = Yb + (size_t)_s1 * DM + lane * 4; \
        _Pragma("unroll") for (int q = 0; q < 4; ++q) { hX[q] = *(const u32x2*)(_h + q * 256); aX[q] = *(const u32x2*)(_y0 + q * 256); cX[q] = *(const u32x2*)(_y1 + q * 256); } } while (0)
    int r = r0 + wave;
    if (r < r1) {
        int4 tk_c = TOK[r]; f32x2 tw_c = TOKW[r];
        int4 tk_n = tk_c; f32x2 tw_n = tw_c; if (r + 8 < r1) { tk_n = TOK[r + 8]; tw_n = TOKW[r + 8]; }
        u32x2 hA[4], aA[4], cA[4];
        CMB_LOAD(hA, aA, cA, r, tk_c);
        for (; r < r1; r += 8) {
            u32x2 hB[4], aB[4], cB[4];
#pragma unroll
            for (int q = 0; q < 4; ++q) { hB[q] = hA[q]; aB[q] = aA[q]; cB[q] = cA[q]; }
            if (r + 8 < r1) CMB_LOAD(hB, aB, cB, r + 8, tk_n);
            int4 tk_nn = tk_n; f32x2 tw_nn = tw_n; if (r + 16 < r1) { tk_nn = TOK[r + 16]; tw_nn = TOKW[r + 16]; }
            int b, j; row_info(r, b, j); const bool isctx = j < NCTX;
            if (!(FINAL && isctx)) {
                const int mr = isctx ? 4 : b;
                if (mr != cur_mr) { cur_mr = mr; const float* g2 = mod_vec(p, prev_layer, r, 5);
#pragma unroll
                    for (int q = 0; q < 4; ++q) g2v[q] = *(const f32x4*)(g2 + q * 256 + lane * 4);
                    if (FINAL) {
#pragma unroll
                        for (int q = 0; q < 4; ++q) gm[q] = *(const f32x4*)(gain + q * 256 + lane * 4); }
                    else { const float* sh_ = mod_vec(p, layer, r, which * 3 + 0); const float* sc_ = mod_vec(p, layer, r, which * 3 + 1);
#pragma unroll
                        for (int q = 0; q < 4; ++q) { const f32x4 g = *(const f32x4*)(gain + q * 256 + lane * 4), s1 = *(const f32x4*)(sc_ + q * 256 + lane * 4); gm[q] = g * (s1 + 1.f); shv[q] = *(const f32x4*)(sh_ + q * 256 + lane * 4); } } }
                f32x4 v[4];
#pragma unroll
                for (int q = 0; q < 4; ++q) v[q] = (f32x4){bflo(hA[q].x), bfhi(hA[q].x), bflo(hA[q].y), bfhi(hA[q].y)};
                if (tk_c.x >= 0) {
#pragma unroll
                    for (int q = 0; q < 4; ++q) { const u32x2 a = aA[q], c = cA[q]; const f32x4 g = g2v[q];
                        v[q].x += g.x * (tw_c.x * bflo(a.x) + tw_c.y * bflo(c.x)); v[q].y += g.y * (tw_c.x * bfhi(a.x) + tw_c.y * bfhi(c.x)); v[q].z += g.z * (tw_c.x * bflo(a.y) + tw_c.y * bflo(c.y)); v[q].w += g.w * (tw_c.x * bfhi(a.y) + tw_c.y * bfhi(c.y)); }
                    if (!FINAL) {
#pragma unroll
                        for (int q = 0; q < 4; ++q) *(u32x2*)(Hb + (size_t)r * DM + q * 256 + lane * 4) = (u32x2){pk2(v[q].x, v[q].y), pk2(v[q].z, v[q].w)}; }
                }
                float ss = 0.f;
#pragma unroll
                for (int q = 0; q < 4; ++q) ss += (v[q].x * v[q].x + v[q].y * v[q].y) + (v[q].z * v[q].z + v[q].w * v[q].w);
                const float rs = rsqrtf(wave_sum(ss) * (1.f / DM) + EPS);
                if (FINAL) { float* o = p.out + ((size_t)b * SEQ + (j - NCTX)) * DM;
#pragma unroll
                    for (int q = 0; q < 4; ++q) *(f32x4*)(o + q * 256 + lane * 4) = v[q] * rs * gm[q]; }
                else {
#pragma unroll
                    for (int q = 0; q < 4; ++q) { const f32x4 o = (v[q] * rs) * gm[q] + shv[q]; *(u32x2*)(WSP(bf16, WS_A) + (size_t)r * DM + q * 256 + lane * 4) = (u32x2){pk2(o.x, o.y), pk2(o.z, o.w)}; } }
            }
#pragma unroll
            for (int q = 0; q < 4; ++q) { hA[q] = hB[q]; aA[q] = aB[q]; cA[q] = cB[q]; }
            tk_c = tk_n; tw_c = tw_n; tk_n = tk_nn; tw_n = tw_nn;
        }
    }
#undef CMB_LOAD
}

template <bool FROM_IN>
__device__ __forceinline__ void phase_norm_plain(const P& p, int wv, int bid, int nb, int layer, int which) {
    const int tid = otid(wv), lane = tid & 63, wave = tid >> 6;
    const int per = (T + nb - 1) / nb, r0 = bid * per, r1 = min(T, r0 + per);
    const float* gain = (which == 0 ? p.in[6] : p.in[7]) + (size_t)layer * DM;
    int cur_mr = -1; f32x4 gm[4], shv[4];
#pragma unroll
    for (int q = 0; q < 4; ++q) { gm[q] = (f32x4){0.f, 0.f, 0.f, 0.f}; shv[q] = gm[q]; }
    for (int r = r0 + wave; r < r1; r += 16) {
        const int ra = r, rb = (r + 8 < r1) ? r + 8 : r;
        f32x4 va[4], vb[4];
        if (FROM_IN) { const float* sa = in_row(p, ra); const float* sb = in_row(p, rb);
#pragma unroll
            for (int q = 0; q < 4; ++q) { va[q] = *(const f32x4*)(sa + q * 256 + lane * 4); vb[q] = *(const f32x4*)(sb + q * 256 + lane * 4); } }
        else { const bf16* sa = WSP(const bf16, WS_H) + (size_t)ra * DM; const bf16* sb = WSP(const bf16, WS_H) + (size_t)rb * DM; u32x2 wa[4], wb[4];
#pragma unroll
            for (int q = 0; q < 4; ++q) { wa[q] = *(const u32x2*)(sa + q * 256 + lane * 4); wb[q] = *(const u32x2*)(sb + q * 256 + lane * 4); }
#pragma unroll
            for (int q = 0; q < 4; ++q) { va[q] = (f32x4){bflo(wa[q].x), bfhi(wa[q].x), bflo(wa[q].y), bfhi(wa[q].y)}; vb[q] = (f32x4){bflo(wb[q].x), bfhi(wb[q].x), bflo(wb[q].y), bfhi(wb[q].y)}; } }
        float sa2 = 0.f, sb2 = 0.f;
#pragma unroll
        for (int q = 0; q < 4; ++q) { sa2 += (va[q].x * va[q].x + va[q].y * va[q].y) + (va[q].z * va[q].z + va[q].w * va[q].w); sb2 += (vb[q].x * vb[q].x + vb[q].y * vb[q].y) + (vb[q].z * vb[q].z + vb[q].w * vb[q].w); }
        const float rsa = rsqrtf(wave_sum(sa2) * (1.f / DM) + EPS), rsb = rsqrtf(wave_sum(sb2) * (1.f / DM) + EPS);
#pragma unroll
        for (int half = 0; half < 2; ++half) {
            const int rr = half ? rb : ra; int b, j; row_info(rr, b, j); const int mr = (j < NCTX) ? 4 : b;
            if (mr != cur_mr) { cur_mr = mr; const float* sh_ = mod_vec(p, layer, rr, which * 3 + 0); const float* sc_ = mod_vec(p, layer, rr, which * 3 + 1);
#pragma unroll
                for (int q = 0; q < 4; ++q) { const f32x4 g = *(const f32x4*)(gain + q * 256 + lane * 4), s1 = *(const f32x4*)(sc_ + q * 256 + lane * 4); gm[q] = g * (s1 + 1.f); shv[q] = *(const f32x4*)(sh_ + q * 256 + lane * 4); } }
            const float rs = half ? rsb : rsa;
#pragma unroll
            for (int q = 0; q < 4; ++q) { const f32x4 o = ((half ? vb[q] : va[q]) * rs) * gm[q] + shv[q];
                *(u32x2*)(WSP(bf16, WS_A) + (size_t)rr * DM + q * 256 + lane * 4) = (u32x2){pk2(o.x, o.y), pk2(o.z, o.w)}; }
        }
    }
}

__device__ __forceinline__ void phase_post_a(const P& p, int wv, int bid, int nb) {
    const int tid = otid(wv), hw = (bid * 512 + tid) >> 5, nhw = nb * 16, l = tid & 31;
    const f32x2* cs = WSP(const f32x2, WS_ROPE128);
    for (int it = hw; it < T * 10; it += nhw) {
        const int r = it / 10, h = it - r * 10; int b, j; row_info(r, b, j);
        bf16* ptr = WSP(bf16, WS_QKV) + (size_t)r * A_NQKV + h * 128 + l * 4;
        const u32x2 raw = *(const u32x2*)ptr; float x[4] = {bflo(raw.x), bfhi(raw.x), bflo(raw.y), bfhi(raw.y)};
        float ss = x[0] * x[0] + x[1] * x[1] + x[2] * x[2] + x[3] * x[3];
#pragma unroll
        for (int o = 1; o < 32; o <<= 1) ss += __shfl_xor(ss, o);
        const float rs = rsqrtf(ss * (1.f / 128.f) + EPS);
        const float* w = (h < 8 ? p.in[10] : p.in[11]) + l * 4;
#pragma unroll
        for (int e = 0; e < 4; ++e) x[e] = x[e] * rs * w[e];
        float y[4];
        if (j >= NCTX) {
            const int s = j - NCTX, pos = (l < 16) ? (s / GRIDW) : (s % GRIDW);
            const bool second = (l & 8) != 0;
#pragma unroll
            for (int e = 0; e < 4; ++e) { const float o = __shfl_xor(x[e], 8); const int f = ((l & 7) * 4 + e); const f32x2 c = cs[pos * 32 + f];
                y[e] = second ? (x[e] * c.x + o * c.y) : (x[e] * c.x - o * c.y); }
        } else {
#pragma unroll
            for (int e = 0; e < 4; ++e) y[e] = x[e];
        }
        *(u32x2*)ptr = (u32x2){pk2(y[0], y[1]), pk2(y[2], y[3])};
    }
}
__device__ __forceinline__ void phase_post_b1(const P& p, int wv, int bid, int nb) {
    const int tid = otid(wv), lane = tid & 63, gw = bid * 8 + (tid >> 6), ngw = nb * 8;
    const f32x2* cs = WSP(const f32x2, WS_ROPE64);
    for (int r = gw; r < T; r += ngw) {
        int b, j; row_info(r, b, j);
        const bf16* d = WSP(const bf16, WS_DOWN) + (size_t)r * B_NDOWN_P;
        float q[6], kv[4];
        float s1 = 0.f, s2 = 0.f;
#pragma unroll
        for (int i = 0; i < 6; ++i) { q[i] = bf2f(d[i * 64 + lane]); s1 += q[i] * q[i]; }
#pragma unroll
        for (int i = 0; i < 4; ++i) { kv[i] = bf2f(d[384 + i * 64 + lane]); s2 += kv[i] * kv[i]; }
        float kr = bf2f(d[640 + lane]);
        const float r1 = rsqrtf(wave_sum(s1) * (1.f / 384.f) + EPS), r2 = rsqrtf(wave_sum(s2) * (1.f / 256.f) + EPS);
#pragma unroll
        for (int i = 0; i < 6; ++i) WSP(bf16, WS_DQN)[(size_t)r * B_QL + i * 64 + lane] = (bf16)f2bf(q[i] * r1 * p.in[14][i * 64 + lane]);
#pragma unroll
        for (int i = 0; i < 4; ++i) WSP(bf16, WS_DKVN)[(size_t)r * B_KVL + i * 64 + lane] = (bf16)f2bf(kv[i] * r2 * p.in[15][i * 64 + lane]);
        if (j >= NCTX) {
            const int s = j - NCTX, pos = (lane < 32) ? (s / GRIDW) : (s % GRIDW); const float o = __shfl_xor(kr, 16); const f32x2 c = cs[pos * 16 + (lane & 15)];
            kr = (lane & 16) ? (kr * c.x + o * c.y) : (kr * c.x - o * c.y);
        }
        const bf16 krb = (bf16)f2bf(kr);
#pragma unroll
        for (int h = 0; h < 8; ++h) WSP(bf16, WS_KB)[(size_t)r * 1536 + h * 192 + 128 + lane] = krb;
    }
}
__device__ __forceinline__ void phase_rope64(const P& p, int wv, int bid, int nb, bf16* buf, int ld, int nh, int hs, int off) {
    const int tid = otid(wv), lane = tid & 63, gw = bid * 8 + (tid >> 6), ngw = nb * 8;
    const f32x2* cs = WSP(const f32x2, WS_ROPE64);
    for (int r = gw; r < T; r += ngw) {
        int b, j; row_info(r, b, j); if (j < NCTX) continue;
        const int s = j - NCTX, pos = (lane < 32) ? (s / GRIDW) : (s % GRIDW); const f32x2 c = cs[pos * 16 + (lane & 15)];
        for (int h = 0; h < nh; ++h) { bf16* q = buf + (size_t)r * ld + h * hs + off + lane; const float x = bf2f(*q), o = __shfl_xor(x, 16);
            *q = (bf16)f2bf((lane & 16) ? (x * c.x + o * c.y) : (x * c.x - o * c.y)); }
    }
}

__device__ __forceinline__ void phase_sgu_simple(const P& p, int wv, int bid, int nb, unsigned char* lds_) {
    LAS unsigned char* lds = (LAS unsigned char*)lds_;
    const int tid = otid(wv), lane = tid & 63, wave = tid >> 6;
    LAS float* mean = (LAS float*)lds; LAS float* rstd = mean + 128; LAS float* vl = (LAS float*)(lds + 1024);
    const bf16* U = WSP(const bf16, WS_QKV); const bf16* V = WSP(const bf16, WS_KB); bf16* Mo = WSP(bf16, WS_VB);
    const float* Wsp = p.in[22]; const float* bsp = p.in[23];
    for (int ch = bid; ch < T / 128; ch += nb) {
        const int row0 = ch * 128;
        __syncthreads();
        for (int rr = wave; rr < 128; rr += 8) { const bf16* vr = V + (size_t)(row0 + rr) * DM; float x[16]; float s = 0.f;
#pragma unroll
            for (int i = 0; i < 16; ++i) { x[i] = bf2f(vr[i * 64 + lane]); s += x[i]; }
            const float mu = wave_sum(s) * (1.f / 1024.f); float q = 0.f;
#pragma unroll
            for (int i = 0; i < 16; ++i) { const float d = x[i] - mu; q += d * d; }
            const float var = wave_sum(q) * (1.f / 1024.f);
            if (lane == 0) { mean[rr] = mu; rstd[rr] = rsqrtf(var + EPS); } }
        for (int g = 0; g < 8; ++g) {
            __syncthreads();
            for (int i = tid; i < 128 * 128; i += 512) { const int q = i >> 7, c = i & 127, col = g * 128 + c;
                const float x = bf2f(V[(size_t)(row0 + q) * DM + col]); vl[i] = bf2f(f2bf((x - mean[q]) * rstd[q] * p.in[20][col] + p.in[21][col])); }
            __syncthreads();
            const int pp = tid >> 2, c0 = (tid & 3) * 32;
            float acc[32];
#pragma unroll
            for (int i = 0; i < 32; ++i) acc[i] = 0.f;
            const float* wrow = Wsp + ((size_t)g * 128 + pp) * 128;
            for (int q = 0; q < 128; ++q) { const float w = bf2f(f2bf(wrow[q]));
#pragma unroll
                for (int i = 0; i < 32; ++i) acc[i] += w * vl[q * 128 + c0 + i]; }
            const float bb = bsp[g * 128 + pp];
#pragma unroll
            for (int i = 0; i < 32; ++i) { const size_t o = (size_t)(row0 + pp) * DM + g * 128 + c0 + i; Mo[o] = (bf16)f2bf(bf2f(U[o]) * (acc[i] + bb)); }
        }
    }
}

__device__ __forceinline__ void phase_sgu(const P& p, int wv, int bid, int nb, unsigned char* lds_) {
    using f32x16 = __attribute__((ext_vector_type(16))) float;
    LAS unsigned char* lds = (LAS unsigned char*)lds_;
    const int tid = otid(wv), lane = tid & 63, wave = tid >> 6, r32 = lane & 31, hi = lane >> 5;
    constexpr int VT_ROW = 272, VT_BYTES = 128 * VT_ROW;
    LAS unsigned char* vT = lds; LAS unsigned char* oT = lds + 2 * VT_BYTES;
    const bf16* U = WSP(const bf16, WS_QKV); const bf16* V = WSP(const bf16, WS_KB); bf16* Mo = WSP(bf16, WS_VB);
    const bf16* Wsp = WSP(const bf16, W_SP); const float* bsp = p.in[23]; const float* lng = p.in[20]; const float* lnb = p.in[21];
    const int pb = wave & 3, cbh = wave >> 2;
    const int sq = tid >> 2, sc0 = (tid & 3) * 32;
    const int nch = T / 128, nfull = (nch / nb) * nb, ntail = (nch - nfull) * 8;
    for (int ui = bid; ui < nfull + ntail; ui += nb) {
        int ch, g0, g1; if (ui < nfull) { ch = ui; g0 = 0; g1 = 8; } else { ch = nfull + ((ui - nfull) >> 3); g0 = (ui - nfull) & 7; g1 = g0 + 1; }
        const int row0 = ch * 128;
        const bf16* vrow = V + (size_t)(row0 + sq) * DM; const bf16* urow = U + (size_t)(row0 + sq) * DM; bf16* mrow = Mo + (size_t)(row0 + sq) * DM;
        float s1 = 0.f, s2 = 0.f;
#pragma unroll
        for (int hb = 0; hb < 2; ++hb) { u32x4 w[16];
#pragma unroll
            for (int j = 0; j < 16; ++j) w[j] = *(const u32x4*)(vrow + (tid & 3) * 256 + hb * 128 + j * 8);
#pragma unroll
            for (int j = 0; j < 16; ++j) { const float x0 = bflo(w[j].x), x1 = bfhi(w[j].x), x2 = bflo(w[j].y), x3 = bfhi(w[j].y), x4 = bflo(w[j].z), x5 = bfhi(w[j].z), x6 = bflo(w[j].w), x7 = bfhi(w[j].w);
                s1 += ((x0 + x1) + (x2 + x3)) + ((x4 + x5) + (x6 + x7)); s2 += ((x0 * x0 + x1 * x1) + (x2 * x2 + x3 * x3)) + ((x4 * x4 + x5 * x5) + (x6 * x6 + x7 * x7)); } }
        s1 += __shfl_xor(s1, 1); s2 += __shfl_xor(s2, 1); s1 += __shfl_xor(s1, 2); s2 += __shfl_xor(s2, 2);
        const float mq = s1 * (1.f / 1024.f), rq = rsqrtf(fmaxf(s2 * (1.f / 1024.f) - mq * mq, 0.f) + EPS);
        u32x4 vreg[4], ureg[4];
#pragma unroll
        for (int j = 0; j < 4; ++j) { vreg[j] = *(const u32x4*)(vrow + g0 * 128 + sc0 + j * 8); ureg[j] = *(const u32x4*)(urow + g0 * 128 + sc0 + j * 8); }
#pragma unroll 1
        for (int g = g0; g < g1; ++g) {
            LAS unsigned char* buf = vT + (g & 1) * VT_BYTES;
            { const float* gg = lng + g * 128 + sc0; const float* gb = lnb + g * 128 + sc0;
#pragma unroll
              for (int j = 0; j < 4; ++j) { const u32x4 w = vreg[j]; const f32x4 ga = *(const f32x4*)(gg + j * 8), gc = *(const f32x4*)(gg + j * 8 + 4), ba = *(const f32x4*)(gb + j * 8), bc = *(const f32x4*)(gb + j * 8 + 4);
                  const float xv[8] = {bflo(w.x), bfhi(w.x), bflo(w.y), bfhi(w.y), bflo(w.z), bfhi(w.z), bflo(w.w), bfhi(w.w)}; const float gv[8] = {ga.x, ga.y, ga.z, ga.w, gc.x, gc.y, gc.z, gc.w}; const float bv[8] = {ba.x, ba.y, ba.z, ba.w, bc.x, bc.y, bc.z, bc.w};
#pragma unroll
                  for (int e = 0; e < 8; ++e) *(LAS bf16*)(buf + (sc0 + j * 8 + e) * VT_ROW + sq * 2) = (bf16)f2bf((xv[e] - mq) * rq * gv[e] + bv[e]); } }
            const u32x4 u0 = ureg[0], u1 = ureg[1], u2 = ureg[2], u3 = ureg[3];
            if (g + 1 < g1) {
#pragma unroll
                for (int j = 0; j < 4; ++j) { vreg[j] = *(const u32x4*)(vrow + (g + 1) * 128 + sc0 + j * 8); ureg[j] = *(const u32x4*)(urow + (g + 1) * 128 + sc0 + j * 8); } }
            bf16x8 af[8];
            { const bf16* wr = Wsp + ((size_t)g * 128 + pb * 32 + r32) * 128 + hi * 8;
#pragma unroll
              for (int ks = 0; ks < 8; ++ks) af[ks] = *(const bf16x8*)(wr + ks * 16); }
            float bias[16];
#pragma unroll
            for (int r = 0; r < 16; ++r) bias[r] = bsp[g * 128 + pb * 32 + (r & 3) + 8 * (r >> 2) + 4 * hi];
            __syncthreads();
#pragma unroll
            for (int t = 0; t < 2; ++t) { f32x16 acc = f32x16{}; const LAS unsigned char* br = buf + ((cbh * 2 + t) * 32 + r32) * VT_ROW + hi * 16;
#pragma unroll
                for (int ks = 0; ks < 8; ++ks) { const bf16x8 bfr = *(const LAS bf16x8*)(br + ks * 32); acc = __builtin_amdgcn_mfma_f32_32x32x16_bf16(af[ks], bfr, acc, 0, 0, 0); }
#pragma unroll
                for (int r = 0; r < 16; ++r) { const int pr = pb * 32 + (r & 3) + 8 * (r >> 2) + 4 * hi; *(LAS bf16*)(oT + pr * VT_ROW + ((cbh * 2 + t) * 32 + r32) * 2) = (bf16)f2bf(acc[r] + bias[r]); } }
            __syncthreads();
            { const u32x4 uu[4] = {u0, u1, u2, u3};
#pragma unroll
              for (int j = 0; j < 4; ++j) { const u32x4 mx = *(const LAS u32x4*)(oT + sq * VT_ROW + (sc0 + j * 8) * 2); u32x4 o;
                  o.x = pk2(bflo(uu[j].x) * bflo(mx.x), bfhi(uu[j].x) * bfhi(mx.x)); o.y = pk2(bflo(uu[j].y) * bflo(mx.y), bfhi(uu[j].y) * bfhi(mx.y));
                  o.z = pk2(bflo(uu[j].z) * bflo(mx.z), bfhi(uu[j].z) * bfhi(mx.z)); o.w = pk2(bflo(uu[j].w) * bflo(mx.w), bfhi(uu[j].w) * bfhi(mx.w));
                  *(u32x4*)(mrow + g * 128 + sc0 + j * 8) = o; } }
        }
        __syncthreads();
    }
}

namespace pg8 {
constexpr int BM = 256, BK = 64, HALF = 128, HTB = HALF * BK * 2, STAGE_BYTES = 8 * HTB, NXCD = 8, WGM = 4;
__host__ __device__ __forceinline__ int lds_byte(int r, int c) { const int st = (r >> 4) * 2 + (c >> 5), rr = r & 15, cc = c & 31, ob = rr * 64 + cc * 2; return st * 1024 + (ob ^ (((ob >> 9) & 1) << 5)); }
__host__ __device__ __forceinline__ void stage_rc(int b, int& R, int& C) { const int st = b / 1024, sb = b % 1024, swz = sb ^ (((sb >> 9) & 1) << 5); R = (st >> 1) * 16 + swz / 64; C = (st & 1) * 32 + (swz % 64) / 2; }
__host__ __device__ __forceinline__ int perm32(int rho) { const int n = rho >> 4, i = rho & 15; return 8 * (i >> 2) + 4 * n + (i & 3); }
struct Unit { int pm, pn, e, sub; };
struct Sched {
    int nM, nN, nwg, G, c; const LAS int* tl; int grouped, part, skipctx;
    __device__ __forceinline__ void init(int nM_, int nN_, int G_, int c_, const LAS int* tl_, int grouped_, int part_ = 0, int skipctx_ = 0) { nM = nM_; nN = nN_; nwg = nM * nN; G = G_; c = c_; tl = tl_; grouped = grouped_; part = part_; skipctx = skipctx_; }
    __device__ __forceinline__ bool next(int i, Unit& u) const {
        long L = (long)i * G + c; int sub = 0;
        const int full = (nwg / G) * G, R = nwg - full;
        if (part == 1 && L >= full) return false;
        if (part == 2) { if (i > 0 || R == 0) return false;
            if (4 * R <= G) { const int uu = (c >> 5) * 8 + (c & 7); if (uu >= R) return false; L = full + uu; sub = 1 + ((c >> 3) & 3); }
            else { if (c >= R) return false; L = full + c; } }
        if (L >= nwg) return false;
        int wgid = (int)L; { const int q = nwg / NXCD, r = nwg % NXCD, xcd = wgid % NXCD, off = wgid / NXCD; wgid = (xcd < r ? xcd * (q + 1) : r * (q + 1) + (xcd - r) * q) + off; }
        const int nig = WGM * nN, gid = wgid / nig, fm = gid * WGM, gsz = (nM - fm) < WGM ? (nM - fm) : WGM;
        u.pm = fm + ((wgid % nig) % gsz); u.pn = (wgid % nig) / gsz; int e = 0;
        if (grouped) {
#pragma unroll
            for (int x = 1; x < 8; ++x) e += (u.pm >= tl[x]) ? 1 : 0; }
        if (skipctx) u.pm = u.pm + (u.pm >> 5) + 1;
        u.e = e; u.sub = sub; return true;
    }
};
__device__ __forceinline__ unsigned cvt_pk_bf16(float lo, float hi) { unsigned r; asm volatile("v_cvt_pk_bf16_f32 %0, %1, %2" : "=v"(r) : "v"(lo), "v"(hi)); return r; }
__device__ __forceinline__ f32x2 gelu_pk(f32x2 v) {
    const f32x2 av = __builtin_elementwise_abs(v), d = av * 0.2316418882f + 1.0f;
    f32x2 t; t.x = __builtin_amdgcn_rcpf(d.x); t.y = __builtin_amdgcn_rcpf(d.y);
    f32x2 q = t * 0.5307027145f + (-0.7265760135f); q = q * t + 0.7107068705f; q = q * t + (-0.142248368f); q = q * t + 0.127414796f; q = q * t;
    const f32x2 s = (v * v) * (-0.72134752044f);
    f32x2 e; e.x = __builtin_amdgcn_exp2f(s.x); e.y = __builtin_amdgcn_exp2f(s.y);
    const f32x2 m = v * (q * e), r = v - m;
    f32x2 o; o.x = v.x < 0.f ? m.x : r.x; o.y = v.y < 0.f ? m.y : r.y; return o;
}
typedef f32x4 Acc[2][2][4][2];
__device__ __forceinline__ u32x4 pack8(f32x4 v0, f32x4 v1) { u32x4 w; w.x = cvt_pk_bf16(v0[0], v0[1]); w.y = cvt_pk_bf16(v0[2], v0[3]); w.z = cvt_pk_bf16(v1[0], v1[1]); w.w = cvt_pk_bf16(v1[2], v1[3]); return w; }
template <int ROPE>
struct EpiStoreT {
    static constexpr bool PERM = true;
    bf16* O; int ld; const f32x2* cs;
    __device__ __forceinline__ void operator()(const Acc& acc, const Unit& u, int wr, int wc, int fr, int fq) const {
        const int row0 = u.pm * BM + wr * 64 + fr, col0 = u.pn * BM + wc * 32 + 8 * fq;
        const int tb = (u.pm * BM) / RPB, tj = u.pm * BM - tb * RPB; const bool lat = tj >= NCTX;
#pragma unroll
        for (int ai = 0; ai < 2; ++ai)
#pragma unroll
            for (int m = 0; m < 4; ++m) { const int row = row0 + ai * HALF + m * 16; bf16* rowp = O + (size_t)row * ld + col0;
                const int spos = row - tb * RPB - NCTX;
#pragma unroll
                for (int bj = 0; bj < 2; ++bj) { if (SUB_SKIP(u, ai, bj)) continue;
                    f32x4 v0 = acc[ai][bj][m][0], v1 = acc[ai][bj][m][1];
                    if constexpr (ROPE != 0) {
                        const int slab = u.pn * 8 + bj * 4 + wc; bool rot; int axis;
                        if (ROPE == 1) { const int sm = slab % 6; rot = sm >= 4; axis = sm - 4; } else { rot = slab < 36; axis = slab & 1; }
                        if (rot && lat) {
                            const int pos = axis ? (spos & (GRIDW - 1)) : (spos / GRIDW); const f32x2* c = cs + pos * 16 + 8 * (fq & 1);
                            const f32x4 c0 = *(const f32x4*)(c), c1 = *(const f32x4*)(c + 2), c2 = *(const f32x4*)(c + 4), c3 = *(const f32x4*)(c + 6);
                            const float cc[8] = {c0.x, c0.z, c1.x, c1.z, c2.x, c2.z, c3.x, c3.z}, sn[8] = {c0.y, c0.w, c1.y, c1.w, c2.y, c2.w, c3.y, c3.w};
                            const float sg = (fq & 2) ? 1.f : -1.f;
                            float x[8] = {v0[0], v0[1], v0[2], v0[3], v1[0], v1[1], v1[2], v1[3]};
#pragma unroll
                            for (int e = 0; e < 8; ++e) { const auto rr = __builtin_amdgcn_permlane32_swap(__float_as_uint(x[e]), __float_as_uint(x[e]), false, false);
                                const float o = __uint_as_float((fq & 2) ? rr[0] : rr[1]); x[e] = x[e] * cc[e] + sg * o * sn[e]; }
                            v0 = (f32x4){x[0], x[1], x[2], x[3]}; v1 = (f32x4){x[4], x[5], x[6], x[7]};
                        }
                    }
                    *(u32x4*)(rowp + bj * HALF) = pack8(v0, v1); } }
    }
};
typedef EpiStoreT<0> EpiStore;
struct EpiKV {
    static constexpr bool PERM = true;
    bf16* Kb; bf16* Vb;
    __device__ __forceinline__ void operator()(const Acc& acc, const Unit& u, int wr, int wc, int fr, int fq) const {
        const int row0 = u.pm * BM + wr * 64 + fr, c0 = wc * 32 + 8 * fq;
#pragma unroll
        for (int ai = 0; ai < 2; ++ai)
#pragma unroll
            for (int m = 0; m < 4; ++m) { const size_t r = (size_t)(row0 + ai * HALF + m * 16);
                if (!SUB_SKIP(u, ai, 0)) *(u32x4*)(Kb + r * 1536 + u.pn * 192 + c0) = pack8(acc[ai][0][m][0], acc[ai][0][m][1]);
                if (!SUB_SKIP(u, ai, 1)) *(u32x4*)(Vb + r * DM + u.pn * 128 + c0) = pack8(acc[ai][1][m][0], acc[ai][1][m][1]); }
    }
};
struct EpiGelu {
    static constexpr bool PERM = true;
    bf16* U; bf16* V;
    __device__ __forceinline__ void operator()(const Acc& acc, const Unit& u, int wr, int wc, int fr, int fq) const {
        const int row0 = u.pm * BM + wr * 64 + fr; bf16* base = u.pn < 4 ? U : V; const int col0 = (u.pn & 3) * BM + wc * 32 + 8 * fq;
#pragma unroll
        for (int ai = 0; ai < 2; ++ai)
#pragma unroll
            for (int m = 0; m < 4; ++m) { bf16* rowp = base + (size_t)(row0 + ai * HALF + m * 16) * DM + col0;
#pragma unroll
                for (int bj = 0; bj < 2; ++bj) { if (SUB_SKIP(u, ai, bj)) continue; const f32x4 v0 = acc[ai][bj][m][0], v1 = acc[ai][bj][m][1];
                    const f32x2 a = gelu_pk((f32x2){v0[0], v0[1]}), b = gelu_pk((f32x2){v0[2], v0[3]}), c = gelu_pk((f32x2){v1[0], v1[1]}), d = gelu_pk((f32x2){v1[2], v1[3]});
                    *(u32x4*)(rowp + bj * HALF) = pack8((f32x4){a.x, a.y, b.x, b.y}, (f32x4){c.x, c.y, d.x, d.y}); } }
    }
};
struct EpiSwiglu {
    static constexpr bool PERM = true;
    bf16* O; int ld;
    __device__ __forceinline__ void operator()(const Acc& acc, const Unit& u, int wr, int wc, int fr, int fq) const {
        const int rl0 = wr * 64 + fr, nkt = ld >> 6;
        bf16* base = O + ((size_t)u.pm * nkt + (u.pn * 2 + (wc >> 1))) * (BM * BK) + (wc & 1) * 32 + 8 * fq;
#pragma unroll
        for (int ai = 0; ai < 2; ++ai)
#pragma unroll
            for (int m = 0; m < 4; ++m) { f32x4 o[2];
#pragma unroll
                for (int n = 0; n < 2; ++n) { const f32x4 a = acc[ai][0][m][n], b = acc[ai][1][m][n];
#pragma unroll
                    for (int k = 0; k < 4; ++k) o[n][k] = a[k] * __builtin_amdgcn_rcpf(1.f + __builtin_amdgcn_exp2f(-1.4426950408889634f * a[k])) * b[k]; }
                *(u32x4*)(base + (size_t)(rl0 + ai * HALF + m * 16) * BK) = pack8(o[0], o[1]); }
    }
};
struct EpiResid {
    static constexpr bool PERM = true;
    const float* x; const float* ctx; unsigned char* ws; int layer, chunk, from_in;
    __device__ __forceinline__ void operator()(const Acc& acc, const Unit& u, int wr, int wc, int fr, int fq) const {
        P p; p.in[0] = x; p.in[2] = ctx; p.ws = ws;
        const int r0 = u.pm * BM; const float* gate = mod_vec(p, layer, r0, chunk);
        const float* xin0 = in_row(p, r0); bf16* h0 = (bf16*)(ws + WS_H) + (size_t)r0 * DM;
        const int rl0 = wr * 64 + fr, col0 = u.pn * BM + wc * 32 + 8 * fq;
        f32x4 g0v[2], g1v[2];
#pragma unroll
        for (int bj = 0; bj < 2; ++bj) { g0v[bj] = *(const f32x4*)(gate + col0 + bj * HALF); g1v[bj] = *(const f32x4*)(gate + col0 + bj * HALF + 4); }
        u32x4 nx[2] = {(u32x4){0u, 0u, 0u, 0u}, (u32x4){0u, 0u, 0u, 0u}};
        if (!from_in) {
#pragma unroll
            for (int bj = 0; bj < 2; ++bj) { if (SUB_SKIP(u, 0, bj)) continue; nx[bj] = *(const u32x4*)(h0 + (size_t)rl0 * DM + col0 + bj * HALF); } }
#pragma unroll
        for (int it = 0; it < 8; ++it) { const int ai = it >> 2, m = it & 3; const size_t off = (size_t)(rl0 + ai * HALF + m * 16) * DM + col0;
            const u32x4 cu0 = nx[0], cu1 = nx[1];
            if (!from_in && it + 1 < 8) { const int ai2 = (it + 1) >> 2, m2 = (it + 1) & 3; const size_t off2 = (size_t)(rl0 + ai2 * HALF + m2 * 16) * DM + col0;
#pragma unroll
                for (int bj = 0; bj < 2; ++bj) { if (SUB_SKIP(u, ai2, bj)) continue; nx[bj] = *(const u32x4*)(h0 + off2 + bj * HALF); } }
#pragma unroll
            for (int bj = 0; bj < 2; ++bj) { if (SUB_SKIP(u, ai, bj)) continue; const f32x4 g0 = g0v[bj], g1 = g1v[bj]; f32x4 s0, s1;
                if (from_in) { s0 = *(const f32x4*)(xin0 + off + bj * HALF); s1 = *(const f32x4*)(xin0 + off + bj * HALF + 4); }
                else { const u32x4 w = bj ? cu1 : cu0; s0 = (f32x4){bflo(w.x), bfhi(w.x), bflo(w.y), bfhi(w.y)}; s1 = (f32x4){bflo(w.z), bfhi(w.z), bflo(w.w), bfhi(w.w)}; }
                *(u32x4*)(h0 + off + bj * HALF) = pack8(s0 + g0 * acc[ai][bj][m][0], s1 + g1 * acc[ai][bj][m][1]); }
            asm volatile("" ::: "memory"); }
    }
};

template <class Epi, bool GATHER, int K, bool SUB = false, bool ATILE = false, bool BTILE = false>
__device__ __forceinline__ void gemm_phase(int wv, LAS unsigned char* lds, const bf16* A, const bf16* Bt, size_t bstride, const Sched& S, const Epi& E, const LAS unsigned short* gtab) {
    const int tid = otid(wv), wid = __builtin_amdgcn_readfirstlane(tid >> 6), lane = tid & 63, wr = wid >> 2, wc = wid & 3, fr = lane & 15, fq = lane >> 4;
    constexpr int nt = K / BK;
    unsigned voffA[2], voffB[2]; int RA[2], CA[2];
#pragma unroll
    for (int i = 0; i < 2; ++i) { int R, C; stage_rc(tid * 16 + i * 8192, R, C); const int Rb = Epi::PERM ? ((R & ~31) + perm32(R & 31)) : R;
        RA[i] = R; CA[i] = C; voffA[i] = (unsigned)(R * (ATILE ? BK : K) + C) * 2u; voffB[i] = (unsigned)(Rb * (BTILE ? BK : K) + C) * 2u; }
    constexpr size_t kstepA = ATILE ? (size_t)BM * BK * 2 : (size_t)(BK * 2), hstepA = ATILE ? (size_t)HALF * BK * 2 : (size_t)HALF * K * 2, tstepA = (size_t)BM * K * 2;
    constexpr size_t kstepB = BTILE ? (size_t)BM * BK * 2 : (size_t)(BK * 2), hstepB = BTILE ? (size_t)HALF * BK * 2 : (size_t)HALF * K * 2, tstepB = (size_t)BM * K * 2;
    const unsigned ldsw = (unsigned)wid * 1024u;
    const int aoff = lds_byte(wr * 64 + fr, fq * 8), boff = lds_byte(wc * 32 + fr, fq * 8);
    const char* Ab = (const char*)A;
    unsigned cg[2][2], ng[2][2];
#define PG8_SA(b, h) (((b) * 2 + (h)) * HTB)
#define PG8_SB(b, h) ((4 + (b) * 2 + (h)) * HTB)
#define PG8_GLDS(gp, bufoff, i) __builtin_amdgcn_global_load_lds((const unsigned*)(gp), (LAS unsigned*)(lds + (bufoff) + ldsw + (i) * 8192), 16, 0, 0)
#define PG8_STAGE_B(bufoff, gbase) do { _Pragma("unroll") for (int _i = 0; _i < 2; ++_i) PG8_GLDS((const char*)(gbase) + voffB[_i], bufoff, _i); } while (0)
#define PG8_STAGE_A(bufoff, nxtsel, h, kt) do { \
        if constexpr (GATHER) { const char* _b = Ab + (size_t)(kt) * kstepA; _Pragma("unroll") for (int _i = 0; _i < 2; ++_i) { const unsigned _o = (nxtsel) ? ng[h][_i] : cg[h][_i]; PG8_GLDS(_b + _o, bufoff, _i); } } \
        else { const char* _b = ((nxtsel) ? nA : cA) + (size_t)(h) * hstepA + (size_t)(kt) * kstepA; _Pragma("unroll") for (int _i = 0; _i < 2; ++_i) PG8_GLDS(_b + voffA[_i], bufoff, _i); } } while (0)
#define PG8_LDA(dst, b, h) do { _Pragma("unroll") for (int m = 0; m < 4; ++m) _Pragma("unroll") for (int k = 0; k < 2; ++k) dst[m][k] = *(const LAS bf16x8*)(lds + PG8_SA(b, h) + aoff + m * 2048 + k * 1024); } while (0)
#define PG8_LDB(dst, b, h) do { _Pragma("unroll") for (int n = 0; n < 2; ++n) _Pragma("unroll") for (int k = 0; k < 2; ++k) dst[n][k] = *(const LAS bf16x8*)(lds + PG8_SB(b, h) + boff + n * 2048 + k * 1024); } while (0)
#define PG8_MMA(ai, bj, At, Bt_) do { if constexpr (SUB) { if (csub != 0 && csub != 1 + (ai) * 2 + (bj)) break; } __builtin_amdgcn_s_setprio(1); _Pragma("unroll") for (int m = 0; m < 4; ++m) _Pragma("unroll") for (int n = 0; n < 2; ++n) _Pragma("unroll") for (int k = 0; k < 2; ++k) \
        acc[ai][bj][m][n] = __builtin_amdgcn_mfma_f32_16x16x32_bf16(Bt_[n][k], At[m][k], acc[ai][bj][m][n], 0, 0, 0); __builtin_amdgcn_s_setprio(0); } while (0)
#define PG8_WAIT_V(n) asm volatile("s_waitcnt vmcnt(" #n ")" ::: "memory")
#define PG8_WAIT_L(n) asm volatile("s_waitcnt lgkmcnt(" #n ")" ::: "memory")
#define PG8_BAR __builtin_amdgcn_s_barrier()
#define PG8_SCHED __builtin_amdgcn_sched_barrier(0)
#define PG8_GOFF(dst, ui_) do { _Pragma("unroll") for (int _h = 0; _h < 2; ++_h) _Pragma("unroll") for (int _i = 0; _i < 2; ++_i) \
        dst[_h][_i] = ((unsigned)gtab[(ui_) * 256 + _h * HALF + RA[_i]] * (unsigned)K + (unsigned)CA[_i]) * 2u; } while (0)
    Unit cur, nxt; int ui = 0;
    if (!S.next(0, cur)) return;
    f32x4 acc[2][2][4][2];
#pragma unroll
    for (int a = 0; a < 2; ++a)
#pragma unroll
        for (int b = 0; b < 2; ++b)
#pragma unroll
            for (int m = 0; m < 4; ++m)
#pragma unroll
                for (int n = 0; n < 2; ++n) acc[a][b][m][n] = (f32x4){0.f, 0.f, 0.f, 0.f};
    bf16x8 At[4][2], B0[2][2], B1[2][2];
    const char* cA = Ab + (size_t)cur.pm * tstepA; const char* cB = (const char*)(Bt + (size_t)cur.e * bstride) + (size_t)cur.pn * tstepB;
    const char* nA = cA; int csub = cur.sub;
    if constexpr (GATHER) { PG8_GOFF(cg, 0); PG8_GOFF(ng, 0); }
    PG8_STAGE_B(PG8_SB(0, 0), cB); PG8_STAGE_B(PG8_SB(0, 1), cB + hstepB); PG8_STAGE_A(PG8_SA(0, 0), false, 0, 0); PG8_STAGE_A(PG8_SA(0, 1), false, 1, 0);
    if (wr == 1) PG8_BAR;
    PG8_WAIT_V(2); PG8_BAR;
    PG8_STAGE_B(PG8_SB(1, 0), cB + kstepB); PG8_STAGE_A(PG8_SA(1, 0), false, 0, 1); PG8_STAGE_B(PG8_SB(1, 1), cB + hstepB + kstepB);
    PG8_WAIT_V(6); PG8_BAR;
    for (;;) {
        const bool has_next = S.next(ui + 1, nxt);
        nA = has_next ? Ab + (size_t)nxt.pm * tstepA : cA; const char* nB = has_next ? (const char*)(Bt + (size_t)nxt.e * bstride) + (size_t)nxt.pn * tstepB : cB;
        if constexpr (GATHER) { if (has_next) PG8_GOFF(ng, ui + 1); else { _Pragma("unroll") for (int _h = 0; _h < 2; ++_h) _Pragma("unroll") for (int _i = 0; _i < 2; ++_i) ng[_h][_i] = cg[_h][_i]; } }
#pragma nounroll
        for (int t = 0; t < nt; t += 2) {
            const bool last = (t == nt - 2);
            const int t1 = t + 1, t2 = last ? 0 : t + 2, t3 = t2 + 1;
            const char* b2 = (last ? nB : cB) + (size_t)t2 * kstepB; const char* b3 = b2 + kstepB;
            PG8_LDB(B0, 0, 0); PG8_LDB(B1, 0, 1); PG8_SCHED; PG8_LDA(At, 0, 0); PG8_STAGE_A(PG8_SA(1, 1), false, 1, t1);
            PG8_WAIT_V(8); PG8_WAIT_L(0); PG8_BAR; PG8_MMA(0, 0, At, B0); PG8_MMA(0, 1, At, B1); PG8_BAR; PG8_SCHED;
            PG8_LDA(At, 0, 1); PG8_STAGE_B(PG8_SB(0, 0), b2); PG8_STAGE_B(PG8_SB(0, 1), b2 + hstepB); PG8_STAGE_A(PG8_SA(0, 0), last, 0, t2);
            PG8_WAIT_V(8); PG8_WAIT_L(0); PG8_BAR; PG8_MMA(1, 0, At, B0); PG8_MMA(1, 1, At, B1); PG8_BAR; PG8_SCHED;
            PG8_LDB(B0, 1, 0); PG8_LDB(B1, 1, 1); PG8_SCHED; PG8_LDA(At, 1, 0); PG8_STAGE_A(PG8_SA(0, 1), last, 1, t2);
            PG8_WAIT_V(8); PG8_WAIT_L(0); PG8_BAR; PG8_MMA(0, 0, At, B0); PG8_MMA(0, 1, At, B1); PG8_BAR; PG8_SCHED;
            PG8_LDA(At, 1, 1); PG8_STAGE_B(PG8_SB(1, 0), b3); PG8_STAGE_B(PG8_SB(1, 1), b3 + hstepB); PG8_STAGE_A(PG8_SA(1, 0), last, 0, t3);
            PG8_WAIT_V(8); PG8_WAIT_L(0); PG8_BAR; PG8_MMA(1, 0, At, B0); PG8_MMA(1, 1, At, B1); PG8_BAR; PG8_SCHED;
        }
        if (wr == 0) PG8_BAR;
        E(acc, cur, wr, wc, fr, fq);
        if (!has_next) break;
#pragma unroll
        for (int a = 0; a < 2; ++a)
#pragma unroll
            for (int b = 0; b < 2; ++b)
#pragma unroll
                for (int m = 0; m < 4; ++m)
#pragma unroll
                    for (int n = 0; n < 2; ++n) acc[a][b][m][n] = (f32x4){0.f, 0.f, 0.f, 0.f};
        cur = nxt; cA = nA; cB = nB; ++ui; csub = cur.sub;
        if constexpr (GATHER) { _Pragma("unroll") for (int _h = 0; _h < 2; ++_h) _Pragma("unroll") for (int _i = 0; _i < 2; ++_i) cg[_h][_i] = ng[_h][_i]; }
        if (wr == 1) PG8_BAR;
    }
    PG8_WAIT_V(0);
    PG8_BAR;
#undef PG8_SA
#undef PG8_SB
#undef PG8_GLDS
#undef PG8_STAGE_A
#undef PG8_STAGE_B
#undef PG8_LDA
#undef PG8_LDB
#undef PG8_MMA
#undef PG8_WAIT_V
#undef PG8_WAIT_L
#undef PG8_BAR
#undef PG8_SCHED
#undef PG8_GOFF
}

template <class Epi, int K, bool ATILE, bool BTILE>
__device__ __forceinline__ void gemm_sub_unit(int wv, LAS unsigned char* lds, const bf16* A, const bf16* Bt, size_t bstride, const Sched& S, const Epi& E) {
    Unit u; if (!S.next(0, u)) return;
    const int tid = otid(wv), wid = __builtin_amdgcn_readfirstlane(tid >> 6), lane = tid & 63, wr = wid >> 2, wc = wid & 3, fr = lane & 15, fq = lane >> 4;
    constexpr int nt = K / BK;
    unsigned voffA[2], voffB[2];
#pragma unroll
    for (int i = 0; i < 2; ++i) { int R, C; stage_rc(tid * 16 + i * 8192, R, C); const int Rb = Epi::PERM ? ((R & ~31) + perm32(R & 31)) : R;
        voffA[i] = (unsigned)(R * (ATILE ? BK : K) + C) * 2u; voffB[i] = (unsigned)(Rb * (BTILE ? BK : K) + C) * 2u; }
    constexpr size_t kstepA = ATILE ? (size_t)BM * BK * 2 : (size_t)(BK * 2), hstepA = ATILE ? (size_t)HALF * BK * 2 : (size_t)HALF * K * 2, tstepA = (size_t)BM * K * 2;
    constexpr size_t kstepB = BTILE ? (size_t)BM * BK * 2 : (size_t)(BK * 2), hstepB = BTILE ? (size_t)HALF * BK * 2 : (size_t)HALF * K * 2, tstepB = (size_t)BM * K * 2;
    const unsigned ldsw = (unsigned)wid * 1024u;
    const int aoff = lds_byte(wr * 64 + fr, fq * 8), boff = lds_byte(wc * 32 + fr, fq * 8);
#pragma nounroll
    for (int sq = (u.sub ? u.sub - 1 : 0); sq < (u.sub ? u.sub : 4); ++sq) {
    const int ai = sq >> 1, bj = sq & 1; Unit uq = u; uq.sub = sq + 1;
    const char* cA = (const char*)A + (size_t)u.pm * tstepA + (size_t)ai * hstepA;
    const char* cB = (const char*)(Bt + (size_t)u.e * bstride) + (size_t)u.pn * tstepB + (size_t)bj * hstepB;
#define SU_SA(b) ((b) * 2 * HTB)
#define SU_SB(b) ((4 + (b) * 2) * HTB)
#define SU_STAGE(b, kt) do { _Pragma("unroll") for (int _i = 0; _i < 2; ++_i) { \
        __builtin_amdgcn_global_load_lds((const unsigned*)(cA + (size_t)(kt) * kstepA + voffA[_i]), (LAS unsigned*)(lds + SU_SA(b) + ldsw + _i * 8192), 16, 0, 0); \
        __builtin_amdgcn_global_load_lds((const unsigned*)(cB + (size_t)(kt) * kstepB + voffB[_i]), (LAS unsigned*)(lds + SU_SB(b) + ldsw + _i * 8192), 16, 0, 0); } } while (0)
    f32x4 a1[4][2];
#pragma unroll
    for (int m = 0; m < 4; ++m)
#pragma unroll
        for (int n = 0; n < 2; ++n) a1[m][n] = (f32x4){0.f, 0.f, 0.f, 0.f};
#define SU_READ(At, Bf, b) do { _Pragma("unroll") for (int _m = 0; _m < 4; ++_m) { _Pragma("unroll") for (int _k = 0; _k < 2; ++_k) At[_m][_k] = *(const LAS bf16x8*)(lds + SU_SA(b) + aoff + _m * 2048 + _k * 1024); } \
        _Pragma("unroll") for (int _n = 0; _n < 2; ++_n) { _Pragma("unroll") for (int _k = 0; _k < 2; ++_k) Bf[_n][_k] = *(const LAS bf16x8*)(lds + SU_SB(b) + boff + _n * 2048 + _k * 1024); } } while (0)
#define SU_MMA(At, Bf) do { __builtin_amdgcn_s_setprio(1); _Pragma("unroll") for (int _m = 0; _m < 4; ++_m) { _Pragma("unroll") for (int _n = 0; _n < 2; ++_n) { _Pragma("unroll") for (int _k = 0; _k < 2; ++_k) \
        a1[_m][_n] = __builtin_amdgcn_mfma_f32_16x16x32_bf16(Bf[_n][_k], At[_m][_k], a1[_m][_n], 0, 0, 0); } } __builtin_amdgcn_s_setprio(0); } while (0)
#define SU_HALF(Fa, Fb, Ga, Gb, b, t2) do { \
        asm volatile("s_waitcnt lgkmcnt(0)" ::: "memory"); __builtin_amdgcn_s_barrier();        \
        SU_STAGE(b, t2); \
        asm volatile("s_waitcnt vmcnt(4)" ::: "memory"); __builtin_amdgcn_s_barrier();           \
        __builtin_amdgcn_sched_barrier(0); \
        SU_READ(Ga, Gb, (b) ^ 1); \
        __builtin_amdgcn_sched_barrier(0); \
        SU_MMA(Fa, Fb); \
        __builtin_amdgcn_sched_barrier(0); } while (0)
    bf16x8 A0[4][2], B0[2][2], A1[4][2], B1[2][2];
    SU_STAGE(0, 0); SU_STAGE(1, 1);
    asm volatile("s_waitcnt vmcnt(4)" ::: "memory"); __builtin_amdgcn_s_barrier();
    SU_READ(A0, B0, 0);
    static_assert(nt % 2 == 0, "K tiles come in pairs");
#pragma nounroll
    for (int t = 0; t < nt; t += 2) {
        { const int t2 = (t + 2 < nt) ? t + 2 : 0; SU_HALF(A0, B0, A1, B1, 0, t2); }
        { const int t3 = (t + 3 < nt) ? t + 3 : 1; SU_HALF(A1, B1, A0, B0, 1, t3); }
    }
    asm volatile("s_waitcnt vmcnt(0) lgkmcnt(0)" ::: "memory");
    __builtin_amdgcn_s_barrier();
#undef SU_READ
#undef SU_MMA
#undef SU_HALF
    f32x4 acc[2][2][4][2];
#pragma unroll
    for (int a = 0; a < 2; ++a)
#pragma unroll
        for (int bb = 0; bb < 2; ++bb)
#pragma unroll
            for (int m = 0; m < 4; ++m)
#pragma unroll
                for (int n = 0; n < 2; ++n) acc[a][bb][m][n] = a1[m][n];
    E(acc, uq, wr, wc, fr, fq);
    }
#undef SU_SA
#undef SU_SB
#undef SU_STAGE
}
}

namespace att {
using f32x16 = __attribute__((ext_vector_type(16))) float;
using s16x4 = __attribute__((ext_vector_type(4))) short;
constexpr int NW = 8, QBLK = 32, KVBLK = 64;
#define ATT_SBAR() __builtin_amdgcn_sched_barrier(0)
__device__ __forceinline__ int crow(int r, int hi) { return (r & 3) + 8 * (r >> 2) + 4 * hi; }
__device__ __forceinline__ unsigned cvtpk(float lo, float hi) { unsigned r; asm volatile("v_cvt_pk_bf16_f32 %0, %1, %2" : "=v"(r) : "v"(lo), "v"(hi)); return r; }
template <int DQK> struct Cst { static constexpr float scale() { return DQK == 128 ? 0.088388347648318440f : (DQK == 192 ? 0.072168783648703220f : 0.125f); } };
template <int DQK> __device__ __forceinline__ int kswz(int row, int colB) { constexpr int RS = DQK * 2; return row * RS + (colB ^ ((RS == 256 ? (row & 15) : ((row >> 1) & 7)) << 4)); }
template <int DV> __device__ __forceinline__ int v_st(int k, int c) { const int kk = (k & ~0xC) | ((k & 4) << 1) | ((k & 8) >> 1); return ((kk >> 3) * (DV / 32) + (c >> 5)) * 512 + ((kk & 7) * 32 + (c & 31)) * 2; }
__device__ __forceinline__ int v_rd_base(int lane) { return ((lane & 3) << 3) | (((lane >> 2) & 3) << 6) | (((lane >> 4) & 1) << 5) | (((lane >> 5) & 1) << 8); }
typedef short v4i16_t __attribute__((ext_vector_type(4)));
typedef __attribute__((address_space(3))) v4i16_t lds_v4i16_t;
template <int OFF> __device__ __forceinline__ s16x4 tr_read(int vb) { return __builtin_bit_cast(s16x4, __builtin_amdgcn_ds_read_tr16_b64_v4i16((lds_v4i16_t*)(unsigned)(vb + OFF))); }

template <int DQK, int THRI> __device__ __forceinline__ void partialSM(f32x16& p0, f32x16& p1, float& m_reg, float& mn, float& alpha) {
    constexpr float SC = Cst<DQK>::scale(), C = SC * 1.4426950408889634f, THR = (float)THRI;
    float pmax = p0[0];
#pragma unroll
    for (int r = 1; r < 16; ++r) pmax = fmaxf(pmax, p0[r]);
#pragma unroll
    for (int r = 0; r < 16; ++r) pmax = fmaxf(pmax, p1[r]);
    { auto rr = __builtin_amdgcn_permlane32_swap(__float_as_uint(pmax), __float_as_uint(pmax), false, false); pmax = fmaxf(__uint_as_float(rr[0]), __uint_as_float(rr[1])); }
    if (__builtin_expect(__all(pmax - m_reg <= THR / SC), 1)) { mn = m_reg; alpha = 1.f; }
    else { mn = fmaxf(m_reg, pmax); alpha = __builtin_amdgcn_exp2f((m_reg - mn) * C); m_reg = mn; }
    const float mnC = -mn * C;
#pragma unroll
    for (int r = 0; r < 16; ++r) p0[r] = fmaf(p0[r], C, mnC);
#pragma unroll
    for (int r = 0; r < 16; ++r) p1[r] = fmaf(p1[r], C, mnC);
#pragma unroll
    for (int r = 0; r < 16; ++r) p0[r] = __builtin_amdgcn_exp2f(p0[r]);
}
__device__ __forceinline__ void finishSM(f32x16& p0, f32x16& p1, float alpha, float& l_reg, bf16x8& pa0, bf16x8& pa1, bf16x8& pa2, bf16x8& pa3) {
#pragma unroll
    for (int r = 0; r < 16; ++r) p1[r] = __builtin_amdgcn_exp2f(p1[r]);
    float ps = 0;
#pragma unroll
    for (int r = 0; r < 16; ++r) ps += p0[r];
#pragma unroll
    for (int r = 0; r < 16; ++r) ps += p1[r];
    { auto rr = __builtin_amdgcn_permlane32_swap(__float_as_uint(ps), __float_as_uint(ps), false, false); ps = __uint_as_float(rr[0]) + __uint_as_float(rr[1]); }
    l_reg = l_reg * alpha + ps;
#define ATT_PK4(Pv, BASE, OUT) do { unsigned a0 = cvtpk(Pv[BASE + 0], Pv[BASE + 1]), a1 = cvtpk(Pv[BASE + 2], Pv[BASE + 3]); \
    unsigned b0 = cvtpk(Pv[BASE + 4], Pv[BASE + 5]), b1 = cvtpk(Pv[BASE + 6], Pv[BASE + 7]); \
    auto r0 = __builtin_amdgcn_permlane32_swap(a0, b0, false, false); auto r1 = __builtin_amdgcn_permlane32_swap(a1, b1, false, false); \
    u32x4 w = {r0[0], r1[0], r0[1], r1[1]}; OUT = *reinterpret_cast<bf16x8*>(&w); } while (0)
    ATT_PK4(p0, 0, pa0); ATT_PK4(p0, 8, pa1); ATT_PK4(p1, 0, pa2); ATT_PK4(p1, 8, pa3);
#undef ATT_PK4
}
template <int DQK, int QL> __device__ __forceinline__ void qkt(f32x16& p0, f32x16& p1, const char* Ks, const bf16x8* qr, const char* ql, const int* kb, int r32, int hi) {
    p0 = f32x16{}; p1 = f32x16{};
#pragma unroll
    for (int d0 = 0; d0 < DQK / 16; ++d0) {
        bf16x8 b0, b1;
        if constexpr (DQK == 192) { b0 = *reinterpret_cast<const bf16x8*>(Ks + kb[d0 & 3] + 128 * (d0 >> 2)); b1 = *reinterpret_cast<const bf16x8*>(Ks + kb[d0 & 3] + 128 * (d0 >> 2) + 32 * DQK * 2); }
        else { const int cb = (d0 * 16 + hi * 8) * 2; b0 = *reinterpret_cast<const bf16x8*>(Ks + kswz<DQK>(r32, cb)); b1 = *reinterpret_cast<const bf16x8*>(Ks + kswz<DQK>(32 + r32, cb)); }
        bf16x8 q; if constexpr (QL > 0) { if (d0 >= DQK / 16 - QL) q = *reinterpret_cast<const bf16x8*>(ql + (d0 - (DQK / 16 - QL)) * 1024); else q = qr[d0]; } else q = qr[d0];
        p0 = __builtin_amdgcn_mfma_f32_32x32x16_bf16(b0, q, p0, 0, 0, 0);
        p1 = __builtin_amdgcn_mfma_f32_32x32x16_bf16(b1, q, p1, 0, 0, 0); }
}
template <int DV, int D0> __device__ __forceinline__ void pv_one(f32x16& od, int vb, bf16x8 pa0, bf16x8 pa1, bf16x8 pa2, bf16x8 pa3) {
    constexpr int KS = (DV / 32) * 1024, HF = (DV / 32) * 512;
    const s16x4 l0 = tr_read<D0 * 512 + 0 * KS>(vb), h0 = tr_read<D0 * 512 + 0 * KS + HF>(vb), l1 = tr_read<D0 * 512 + 1 * KS>(vb), h1 = tr_read<D0 * 512 + 1 * KS + HF>(vb);
    const s16x4 l2 = tr_read<D0 * 512 + 2 * KS>(vb), h2 = tr_read<D0 * 512 + 2 * KS + HF>(vb), l3 = tr_read<D0 * 512 + 3 * KS>(vb), h3 = tr_read<D0 * 512 + 3 * KS + HF>(vb);
#define ATT_PK(L, H) (bf16x8){L[0], L[1], L[2], L[3], H[0], H[1], H[2], H[3]}
    od = __builtin_amdgcn_mfma_f32_32x32x16_bf16(pa0, ATT_PK(l0, h0), od, 0, 0, 0);
    od = __builtin_amdgcn_mfma_f32_32x32x16_bf16(pa1, ATT_PK(l1, h1), od, 0, 0, 0);
    od = __builtin_amdgcn_mfma_f32_32x32x16_bf16(pa2, ATT_PK(l2, h2), od, 0, 0, 0);
    od = __builtin_amdgcn_mfma_f32_32x32x16_bf16(pa3, ATT_PK(l3, h3), od, 0, 0, 0);
#undef ATT_PK
}
template <int DV> __device__ __forceinline__ void pv_all(f32x16* o, int vb, bf16x8 pa0, bf16x8 pa1, bf16x8 pa2, bf16x8 pa3) {
    pv_one<DV, 0>(o[0], vb, pa0, pa1, pa2, pa3); pv_one<DV, 1>(o[1], vb, pa0, pa1, pa2, pa3);
    if constexpr (DV == 128) { pv_one<DV, 2>(o[2], vb, pa0, pa1, pa2, pa3); pv_one<DV, 3>(o[3], vb, pa0, pa1, pa2, pa3); }
}
template <int DQK, int DV> struct Shm { static constexpr int V = KVBLK * DV * 2, K = KVBLK * DQK * 2, WSO = 2 * V + 2 * K, QLO = WSO + NW * 64 * 4; };

template <int DQK, int DV, int SD, bool WINDOW, int THRI, int QL, bool DMA = false>
__device__ __forceinline__ void attn_unit(const bf16* __restrict__ Qb, int ldq, const bf16* __restrict__ Kh, int ldk, const bf16* __restrict__ Vh, int ldv, bf16* __restrict__ Ob, int ldo,
                                          int NT, int segB, int qlat0, int klat0, float m_init, float l_init, char* lds, int wv) {
    constexpr int SHM_V = Shm<DQK, DV>::V, SHM_K = Shm<DQK, DV>::K, NKP = DQK / 64, NVP = DV / 64, ND0 = DV / 32;
    int tid_ = otid(wv);
    const int tid = tid_, wid = tid >> 6, lane = tid & 63, r32 = lane & 31, hi = lane >> 5;
    char* V_lds = lds; char* K_lds = lds + 2 * SHM_V;
    float* wsf = (float*)(lds + Shm<DQK, DV>::WSO) + wid * 64; float* li_l = wsf; float* al_l = wsf + 32;
    float m_reg = m_init, l_reg = l_init; f32x16 o[ND0]; bf16x8 qr[DQK / 16 - QL > 0 ? DQK / 16 - QL : 1];
    char* ql = lds + Shm<DQK, DV>::QLO + wid * (QL > 0 ? QL : 1) * 1024 + lane * 16;
#pragma unroll
    for (int d = 0; d < ND0; ++d) o[d] = f32x16{};
    const bf16* Qw = Qb + (long)(wid * QBLK + r32) * ldq + hi * 8;
#pragma unroll
    for (int d0 = 0; d0 < DQK / 16; ++d0) { const bf16x8 q = *reinterpret_cast<const bf16x8*>(Qw + d0 * 16); if (d0 < DQK / 16 - QL) qr[d0 < DQK / 16 - QL ? d0 : 0] = q; else *reinterpret_cast<bf16x8*>(ql + (d0 - (DQK / 16 - QL)) * 1024) = q; }
    const int srow = tid >> 3, sch = tid & 7;
    const int kflip = (DQK == 128) ? ((srow >> 3) & 1) * 128 : 0;
    const int kgo = srow * ldk + sch * 8, klo = kswz<DQK>(srow, sch * 16) & ~kflip, vgo = srow * ldv + sch * 8, vlo = v_st<DV>(srow, sch * 8);
    const int vb0 = (int)(uintptr_t)V_lds + v_rd_base(lane);
    int kb[4];
#pragma unroll
    for (int j = 0; j < 4; ++j) kb[j] = kswz<DQK>(r32, 32 * j + 16 * hi);
    bf16x8 ks[SD][NKP], vs[SD][NVP];
#define ATT_BAR() asm volatile("s_waitcnt lgkmcnt(0)\n\ts_barrier" ::: "memory")
#define ATT_KROW(t) ((t) < 4 ? 64 * (t) : segB + 64 * ((t) - 4))
#define ATT_SLOAD(i, t) do { const long _kr = ATT_KROW(t); _Pragma("unroll") for (int _x = 0; _x < NVP; ++_x) vs[i][_x] = *reinterpret_cast<const bf16x8*>(Vh + _kr * ldv + vgo + 64 * _x); \
        _Pragma("unroll") for (int _x = 0; _x < NKP; ++_x) ks[i][_x] = *reinterpret_cast<const bf16x8*>(Kh + _kr * ldk + kgo + 64 * _x); } while (0)
#define ATT_SWRITE(b, i) do { _Pragma("unroll") for (int _x = 0; _x < NVP; ++_x) *(bf16x8*)(V_lds + (b) * SHM_V + vlo + 1024 * _x) = vs[i][_x]; \
        _Pragma("unroll") for (int _x = 0; _x < NKP; ++_x) *(bf16x8*)(K_lds + (b) * SHM_K + klo + ((128 * _x) ^ kflip)) = ks[i][_x]; } while (0)
#define ATT_SWAIT() do { if constexpr (SD == 2) { if constexpr (NKP + NVP == 4) asm volatile("s_waitcnt vmcnt(4)" ::: "memory"); else if constexpr (NKP + NVP == 2) asm volatile("s_waitcnt vmcnt(2)" ::: "memory"); else asm volatile("s_waitcnt vmcnt(5)" ::: "memory"); } \
        else asm volatile("s_waitcnt vmcnt(0)" ::: "memory"); } while (0)
#define ATT_RESC(a) do { if (__any((a) < 1.f)) { if (hi == 0) al_l[r32] = (a); asm volatile("s_waitcnt lgkmcnt(0)" ::: "memory"); \
        _Pragma("unroll") for (int d = 0; d < ND0; ++d) _Pragma("unroll") for (int r = 0; r < 16; ++r) o[d][r] *= al_l[crow(r, hi)]; } } while (0)
#define ATT_MASK(P0, P1, t) do { if constexpr (WINDOW) { if ((t) >= 4) { const int _d0 = klat0 + 64 * ((t) - 4) - (qlat0 + wid * QBLK + r32); \
        _Pragma("unroll") for (int r = 0; r < 16; ++r) { const int _d = _d0 + crow(r, hi); P0[r] = (_d > 128 || _d < -128) ? -1e30f : P0[r]; P1[r] = (_d + 32 > 128 || _d + 32 < -128) ? -1e30f : P1[r]; } } } } while (0)
    f32x16 pA0, pA1, pB0, pB1; float mnA, mnB, alA, alB; bf16x8 pa0, pa1, pa2, pa3;
    constexpr int SE = 0, SO = SD - 1;
    if (wv >= 4) __builtin_amdgcn_s_setprio(1);
    if constexpr (!DMA) {
    ATT_SLOAD(SE, 0); asm volatile("s_waitcnt vmcnt(0)" ::: "memory"); ATT_SWRITE(0, SE); ATT_BAR();
    qkt<DQK, QL>(pA0, pA1, K_lds, qr, ql, kb, r32, hi); partialSM<DQK, THRI>(pA0, pA1, m_reg, mnA, alA);
    ATT_SLOAD(SO, 1); if constexpr (SD == 2) { if (2 < NT) ATT_SLOAD(SE, 2); }
    ATT_SWAIT(); ATT_SWRITE(1, SO); ATT_BAR();
    for (int j = 1; j + 1 < NT; j += 2) {
        ATT_SBAR(); qkt<DQK, QL>(pB0, pB1, K_lds + SHM_K, qr, ql, kb, r32, hi); ATT_MASK(pB0, pB1, j);
        finishSM(pA0, pA1, alA, l_reg, pa0, pa1, pa2, pa3); ATT_SBAR();
        ATT_SLOAD(SO, j + SD); ATT_SBAR();
        pv_all<DV>(o, vb0, pa0, pa1, pa2, pa3); partialSM<DQK, THRI>(pB0, pB1, m_reg, mnB, alB);
        ATT_BAR(); ATT_SWAIT(); ATT_SWRITE(0, SE);
        ATT_RESC(alB); ATT_BAR();
        ATT_SBAR(); qkt<DQK, QL>(pA0, pA1, K_lds, qr, ql, kb, r32, hi); ATT_MASK(pA0, pA1, j + 1);
        finishSM(pB0, pB1, alB, l_reg, pa0, pa1, pa2, pa3); ATT_SBAR();
        if (SD == 1 || j + 3 < NT) ATT_SLOAD(SE, j + 1 + SD); ATT_SBAR();
        pv_all<DV>(o, vb0 + SHM_V, pa0, pa1, pa2, pa3); partialSM<DQK, THRI>(pA0, pA1, m_reg, mnA, alA);
        ATT_BAR(); ATT_SWAIT(); ATT_SWRITE(1, SO);
        ATT_RESC(alA); ATT_BAR();
    }
    ATT_SBAR(); qkt<DQK, QL>(pB0, pB1, K_lds + SHM_K, qr, ql, kb, r32, hi); ATT_MASK(pB0, pB1, NT - 1);
    finishSM(pA0, pA1, alA, l_reg, pa0, pa1, pa2, pa3); ATT_SBAR();
    pv_all<DV>(o, vb0, pa0, pa1, pa2, pa3); partialSM<DQK, THRI>(pB0, pB1, m_reg, mnB, alB);
    ATT_BAR(); ATT_RESC(alB);
    finishSM(pB0, pB1, alB, l_reg, pa0, pa1, pa2, pa3); ATT_SBAR();
    pv_all<DV>(o, vb0 + SHM_V, pa0, pa1, pa2, pa3);
    } else {
        static_assert(!DMA || (DQK == 128 && DV == 128 && !WINDOW), "DMA staging: D = 128 dense only");
        LAS char* ldsL = (LAS char*)lds;
        const int krow = 4 * wid + ((lane >> 4) & 3);
        const int kgo_d = krow * ldk + (((lane & 15) ^ (krow & 15)) << 3);
        const int vsub = 2 * wid + (lane >> 5), w32 = lane & 31, vkk = ((vsub >> 2) << 3) | (w32 >> 2), vk = (vkk & ~0xC) | ((vkk & 4) << 1) | ((vkk & 8) >> 1);
        const int vgo_d = vk * ldv + (vsub & 3) * 32 + (w32 & 3) * 8;
#define ATT_DMA_K(b, t) do { const bf16* _g = Kh + (long)ATT_KROW(t) * ldk + kgo_d; \
        __builtin_amdgcn_global_load_lds((const unsigned*)_g, (LAS unsigned*)(ldsL + 2 * SHM_V + (b) * SHM_K + wv * 1024), 16, 0, 0); \
        __builtin_amdgcn_global_load_lds((const unsigned*)(_g + 32 * ldk), (LAS unsigned*)(ldsL + 2 * SHM_V + (b) * SHM_K + wv * 1024 + 8192), 16, 0, 0); } while (0)
#define ATT_DMA_V(b, t) do { const bf16* _g = Vh + (long)ATT_KROW(t) * ldv + vgo_d; \
        __builtin_amdgcn_global_load_lds((const unsigned*)_g, (LAS unsigned*)(ldsL + (b) * SHM_V + wv * 1024), 16, 0, 0); \
        __builtin_amdgcn_global_load_lds((const unsigned*)(_g + 32 * ldv), (LAS unsigned*)(ldsL + (b) * SHM_V + wv * 1024 + 8192), 16, 0, 0); } while (0)
#define ATT_LAND() asm volatile("s_waitcnt vmcnt(0) lgkmcnt(0)\n\ts_barrier" ::: "memory")
        ATT_DMA_K(0, 0); ATT_DMA_V(0, 0); ATT_DMA_K(1, 1);
        ATT_LAND();
        qkt<DQK, QL>(pA0, pA1, K_lds, qr, ql, kb, r32, hi); partialSM<DQK, THRI>(pA0, pA1, m_reg, mnA, alA);
        ATT_BAR();
        ATT_DMA_K(0, 2); ATT_DMA_V(1, 1);
        for (int j = 1; j + 1 < NT; j += 2) {
            ATT_SBAR(); qkt<DQK, QL>(pB0, pB1, K_lds + SHM_K, qr, ql, kb, r32, hi);
            finishSM(pA0, pA1, alA, l_reg, pa0, pa1, pa2, pa3); ATT_SBAR();
            pv_all<DV>(o, vb0, pa0, pa1, pa2, pa3); partialSM<DQK, THRI>(pB0, pB1, m_reg, mnB, alB);
            ATT_LAND();
            if (j + 2 < NT) ATT_DMA_K(1, j + 2);
            ATT_DMA_V(0, j + 1);
            ATT_RESC(alB);
            ATT_SBAR(); qkt<DQK, QL>(pA0, pA1, K_lds, qr, ql, kb, r32, hi);
            finishSM(pB0, pB1, alB, l_reg, pa0, pa1, pa2, pa3); ATT_SBAR();
            pv_all<DV>(o, vb0 + SHM_V, pa0, pa1, pa2, pa3); partialSM<DQK, THRI>(pA0, pA1, m_reg, mnA, alA);
            ATT_LAND();
            if (j + 3 < NT) ATT_DMA_K(0, j + 3);
            ATT_DMA_V(1, j + 2);
            ATT_RESC(alA);
        }
        ATT_SBAR(); qkt<DQK, QL>(pB0, pB1, K_lds + SHM_K, qr, ql, kb, r32, hi);
        finishSM(pA0, pA1, alA, l_reg, pa0, pa1, pa2, pa3); ATT_SBAR();
        pv_all<DV>(o, vb0, pa0, pa1, pa2, pa3); partialSM<DQK, THRI>(pB0, pB1, m_reg, mnB, alB);
        ATT_LAND(); ATT_RESC(alB);
        finishSM(pB0, pB1, alB, l_reg, pa0, pa1, pa2, pa3); ATT_SBAR();
        pv_all<DV>(o, vb0 + SHM_V, pa0, pa1, pa2, pa3);
#undef ATT_DMA_K
#undef ATT_DMA_V
#undef ATT_LAND
    }
    __builtin_amdgcn_s_setprio(0);
    if (hi == 0) li_l[r32] = l_reg; asm volatile("s_waitcnt lgkmcnt(0)" ::: "memory");
    float rli[16];
#pragma unroll
    for (int r = 0; r < 16; ++r) rli[r] = __builtin_amdgcn_rcpf(li_l[crow(r, hi)]);
    int tid2 = otid(wv);
    bf16* Ow = Ob + (long)((tid2 >> 6) * QBLK) * ldo + (tid2 & 31);
#pragma unroll
    for (int r = 0; r < 16; ++r) { const int orow = crow(r, (tid2 >> 5) & 1);
#pragma unroll
        for (int d0 = 0; d0 < ND0; ++d0) Ow[(long)orow * ldo + d0 * 32] = (bf16)f2bf(o[d0][r] * rli[r]); }
    ATT_BAR();
#undef ATT_BAR
#undef ATT_KROW
#undef ATT_SLOAD
#undef ATT_SWRITE
#undef ATT_SWAIT
#undef ATT_RESC
#undef ATT_MASK
}

template <int DQK, int DV, int SD, bool WINDOW, int QL, bool DMA = false>
__device__ __forceinline__ void attn_phase(const bf16* Q, int ldq, int qhs, const bf16* Kb, int ldk, int khs, const bf16* Vb, int ldv, int vhs, bf16* O, int ldo, int ohs, int H, int G, const float* sinks, char* lds, int wv) {
    const int nlat = NB * H * 32, ntot = WINDOW ? nlat : nlat + NB * H;
    const int c0 = (gridDim.x == 256) ? (((int)blockIdx.x & 7) * 32 + ((int)blockIdx.x >> 3)) : (int)blockIdx.x;
    for (int L = c0; L < ntot; L += gridDim.x) {
        int b, h, q0row, NT, segB = NCTX, qlat0 = 0, klat0 = 0; float m0 = -1e30f, l0 = 0.f;
        if (L < nlat) { const int qb = L & 31; h = (L >> 5) % H; b = (L >> 5) / H; q0row = NCTX + qb * 256; NT = 4 + SEQ / 64;
            if constexpr (WINDOW) { qlat0 = qb * 256; klat0 = max(0, qlat0 - 128); const int hi_ = min(SEQ, qlat0 + 256 + 128); NT = 4 + (hi_ - klat0) / 64; segB = NCTX + klat0; m0 = sinks[h] / Cst<DQK>::scale(); l0 = 1.f; } }
        else { const int L2 = L - nlat; h = L2 % H; b = L2 / H; q0row = 0; NT = 4; }
        const size_t rb = (size_t)b * RPB; const int kvh = h / G;
        attn_unit<DQK, DV, SD, WINDOW, 8, QL, DMA>(Q + (rb + q0row) * ldq + h * qhs, ldq, Kb + rb * ldk + kvh * khs, ldk, Vb + rb * ldv + kvh * vhs, ldv, O + (rb + q0row) * ldo + h * ohs, ldo, NT, segB, qlat0, klat0, m0, l0, lds, wv);
    }
}
}

#define XB_TMO      128
#define XB_XCNT(j)  (256  + 64 * (j))
#define XB_XSUB(j)  (1280 + 64 * (j))
#define XB_XGEN(j)  (2304 + 64 * (j))
#define XB_TOP      3328
#define XB_TOPGEN   3392
#define XCD_BAR_WORDS 3456
#define XB_SPIN_CAP (1u << 18)
__device__ __forceinline__ unsigned xb_ld(unsigned* p)              { return __hip_atomic_load(p, __ATOMIC_RELAXED, __HIP_MEMORY_SCOPE_AGENT); }
__device__ __forceinline__ unsigned xb_add(unsigned* p, unsigned v) { return __hip_atomic_fetch_add(p, v, __ATOMIC_RELAXED, __HIP_MEMORY_SCOPE_AGENT); }
__device__ __forceinline__ unsigned xb_xcc_id() { return (unsigned)__builtin_amdgcn_s_getreg((3 << 11) | 20) & 0xFu; }
#define XB_SPIN(cond, bar) do { unsigned _sp = 0; while (cond) { __builtin_amdgcn_s_sleep(1); \
    if ((++_sp & 255u) == 0u) { if (xb_ld(&(bar)[XB_TMO])) break; if (_sp > XB_SPIN_CAP) { atomicAdd(&(bar)[XB_TMO], 1u); break; } } } } while (0)
struct XcdBarrier { unsigned* bar; unsigned x; volatile LAS unsigned* st; };
__device__ __forceinline__ XcdBarrier xcd_barrier_post(unsigned* bar, volatile LAS unsigned* st) {
    XcdBarrier b; b.bar = bar; b.x = xb_xcc_id(); b.st = st;
    if (threadIdx.x == 0) (void)xb_add(&bar[XB_XCNT(b.x)], 1u);
    return b;
}
__device__ __forceinline__ void xcd_barrier_complete(unsigned* bar, unsigned x, unsigned& nloc, unsigned& nx) {
    const unsigned G = gridDim.x * gridDim.y * gridDim.z;
    unsigned sum, cnt, mine, sp = 0u;
    for (;;) {
        sum = 0u; cnt = 0u; mine = 0u;
#pragma unroll
        for (unsigned j = 0; j < 16; ++j) { const unsigned c = xb_ld(&bar[XB_XCNT(j)]); sum += c; cnt += (c > 0u) ? 1u : 0u; mine = (j == x) ? c : mine; }
        if (sum == G) break;
        __builtin_amdgcn_s_sleep(1);
        if ((++sp & 255u) == 0u) { if (xb_ld(&bar[XB_TMO])) break; if (sp > XB_SPIN_CAP) { atomicAdd(&bar[XB_TMO], 1u); break; } }
    }
    nloc = mine > 0u ? mine : 1u; nx = cnt > 0u ? cnt : 1u;
}
__device__ __forceinline__ void xcd_barrier(const XcdBarrier& b, int wv) {
    asm volatile("s_waitcnt vmcnt(0)" ::: "memory");
    __syncthreads();
    if (otid(wv) == 0) {
        unsigned* bar = b.bar;
        __builtin_amdgcn_s_waitcnt(0);
        unsigned nloc = b.st[0], nx = b.st[1];
        if (nloc == 0u) { xcd_barrier_complete(bar, b.x, nloc, nx); b.st[0] = nloc; b.st[1] = nx; }
        const unsigned old = xb_add(&bar[XB_XSUB(b.x)], 1u);
        const unsigned gen = old / nloc;
        if (old + 1u == (gen + 1u) * nloc) {
            __builtin_amdgcn_fence(__ATOMIC_RELEASE, "agent");
            asm volatile("s_waitcnt vmcnt(0)" ::: "memory");
            const unsigned og = xb_add(&bar[XB_TOP], 1u);
            const unsigned tg = og / nx;
            if (og + 1u == (tg + 1u) * nx) xb_add(&bar[XB_TOPGEN], 1u);
            else XB_SPIN(xb_ld(&bar[XB_TOPGEN]) == tg, bar);
            __builtin_amdgcn_fence(__ATOMIC_ACQUIRE, "agent");
            xb_add(&bar[XB_XGEN(b.x)], 1u);
            asm volatile("s_waitcnt vmcnt(0)" ::: "memory");
        } else {
            XB_SPIN(xb_ld(&bar[XB_XGEN(b.x)]) == gen, bar);
            __builtin_amdgcn_fence(__ATOMIC_ACQUIRE, "agent");
            asm volatile("s_waitcnt vmcnt(0)" ::: "memory");
        }
    }
    __syncthreads();
}

constexpr int RING_OFF = 0, GT_OFF = 131072, MISC_OFF = GT_OFF + 15360, LDS_BYTES = MISC_OFF + 1024;
constexpr int MAX_UNITS_PER_WG = 30;
constexpr int NPH = 35;
__device__ __forceinline__ void grouped_setup(const P& p, int wv, int m, LAS int* tl) {
    __syncthreads();
    const int t_ = otid(wv);
    if (t_ < NE) { const unsigned* cnt = WSP(const unsigned, WS_CTL) + CW_CNT + 64 * m; tl[16 + t_] = (int)__hip_atomic_load(cnt + t_, __ATOMIC_RELAXED, __HIP_MEMORY_SCOPE_AGENT); }
    __syncthreads();
    if (t_ == 0) { int o = 0;
        for (int e = 0; e < NE; ++e) { tl[e] = o; o += (tl[16 + e] + 255) >> 8; }
        tl[8] = o; }
    __syncthreads();
}
template <int K, int N, class Epi, int SPLIT = 1, int SKIPCTX = 0, bool ATILE = false, bool BTILE = false> __device__ __forceinline__ void gemm_plain(const P& p, int wv, unsigned char* lds_, const bf16* A, const bf16* Bt, const Epi& E) {
    LAS unsigned char* lds = (LAS unsigned char*)lds_;
    constexpr int nM = SKIPCTX ? 128 : T / 256, nwg = nM * (N / 256), R = nwg % 256;
    pg8::Sched S; S.init(nM, N / 256, (int)gridDim.x, (int)blockIdx.x, (const LAS int*)(lds + MISC_OFF), 0, (SPLIT && R > 0 && 4 * R <= 256) ? 1 : 0, SKIPCTX);
    pg8::gemm_phase<Epi, false, K, false, ATILE, BTILE>(wv, lds + RING_OFF, A, Bt, 0, S, E, nullptr);
    if constexpr (SPLIT && R > 0 && 4 * R <= 256) {
        pg8::Sched S2; S2.init(nM, N / 256, (int)gridDim.x, (int)blockIdx.x, (const LAS int*)(lds + MISC_OFF), 0, 2, SKIPCTX);
        pg8::gemm_sub_unit<Epi, K, ATILE, BTILE>(wv, lds + RING_OFF, A, Bt, 0, S2, E);
    }
}
__device__ __forceinline__ void moe_w13(const P& p, int wv, unsigned char* lds_, int m) {
    LAS unsigned char* lds = (LAS unsigned char*)lds_; LAS int* tl = (LAS int*)(lds + MISC_OFF); LAS unsigned short* gtab = (LAS unsigned short*)(lds + GT_OFF);
    grouped_setup(p, wv, m, tl);
    pg8::Sched S; S.init(tl[8], 2 * FE / 256, (int)gridDim.x, (int)blockIdx.x, tl, 1);
    const int* idx = WSP(const int, WS_IDX); const int tidg = otid(wv);
    { static_assert(MAX_UNITS_PER_WG % 2 == 0, "two units per step");
      const int half = __builtin_amdgcn_readfirstlane(tidg >> 8), row = tidg & 255; int vals[MAX_UNITS_PER_WG / 2];
#pragma unroll
      for (int k = 0; k < MAX_UNITS_PER_WG / 2; ++k) { pg8::Unit u; int v = 0;
          if (S.next(2 * k + half, u)) { const int pr = (u.pm - tl[u.e]) * 256 + row; const int* ie = idx + (size_t)u.e * T; v = ie[pr < tl[16 + u.e] ? pr : 0]; }
          vals[k] = v; }
#pragma unroll
      for (int k = 0; k < MAX_UNITS_PER_WG / 2; ++k) gtab[(2 * k + half) * 256 + row] = (unsigned short)vals[k]; }
    __syncthreads();
    pg8::EpiSwiglu E{WSP(bf16, WS_ACT), FE};
    pg8::gemm_phase<pg8::EpiSwiglu, true, DM>(wv, lds + RING_OFF, WSP(const bf16, WS_A), WSP(const bf16, W_13M) + (size_t)m * NE * 2 * FE * DM, (size_t)2 * FE * DM, S, E, gtab);
}
__device__ __forceinline__ void moe_w2(const P& p, int wv, unsigned char* lds_, int m) {
    LAS unsigned char* lds = (LAS unsigned char*)lds_; LAS int* tl = (LAS int*)(lds + MISC_OFF);
    grouped_setup(p, wv, m, tl);
    pg8::Sched S; S.init(tl[8], DM / 256, (int)gridDim.x, (int)blockIdx.x, tl, 1, 1, 0);
    pg8::EpiStore E{WSP(bf16, WS_Y), DM, nullptr};
    pg8::gemm_phase<pg8::EpiStore, false, FE, false, true, true>(wv, lds + RING_OFF, WSP(const bf16, WS_ACT), WSP(const bf16, W_2M) + (size_t)m * NE * DM * FE, (size_t)DM * FE, S, E, nullptr);
    pg8::Sched S2; S2.init(tl[8], DM / 256, (int)gridDim.x, (int)blockIdx.x, tl, 1, 2, 0);
    pg8::gemm_sub_unit<pg8::EpiStore, FE, true, true>(wv, lds + RING_OFF, WSP(const bf16, WS_ACT), WSP(const bf16, W_2M) + (size_t)m * NE * DM * FE, (size_t)DM * FE, S2, E);
}
__device__ __forceinline__ void dense_w13(const P& p, int wv, unsigned char* lds, int pi) { pg8::EpiSwiglu E{WSP(bf16, WS_ACT), FF}; gemm_plain<DM, 2 * FF, pg8::EpiSwiglu, 0>(p, wv, lds, WSP(const bf16, WS_A), WSP(const bf16, W_13F) + (size_t)pi * 2 * FF * DM, E); }
__device__ __forceinline__ void dense_w2(const P& p, int wv, unsigned char* lds, int pi, int layer) { pg8::EpiResid E{p.in[0], p.in[2], p.ws, layer, 5, 0}; gemm_plain<FF, DM, pg8::EpiResid, 1, 0, true, true>(p, wv, lds, WSP(const bf16, WS_ACT), WSP(const bf16, W_2F) + (size_t)pi * DM * FF, E); }
template <int SKIPCTX = 0> __device__ __forceinline__ void wo_gemm(const P& p, int wv, unsigned char* lds, const bf16* Ain, size_t woff, int layer, int from_in) { pg8::EpiResid E{p.in[0], p.in[2], p.ws, layer, 2, from_in}; gemm_plain<DM, DM, pg8::EpiResid, 1, SKIPCTX>(p, wv, lds, Ain, WSP(const bf16, woff), E); }

template <int PH> __device__ __forceinline__ void run_phase(const P& p, int wv, unsigned char* lds) {
    const int bid = blockIdx.x, nb = gridDim.x;
    if constexpr (PH == 0) phase_prologue(p, wv, bid, nb, lds);
    if constexpr (PH == 1) phase_norm_plain<true>(p, wv, bid, nb, 0, 0);
    if constexpr (PH == 2) { pg8::EpiStore E{WSP(bf16, WS_QKV), A_NQKV, nullptr}; gemm_plain<DM, A_NQKV>(p, wv, lds, WSP(const bf16, WS_A), WSP(const bf16, W_QKVA), E); }
    if constexpr (PH == 3) phase_post_a(p, wv, bid, nb);
    if constexpr (PH == 4) att::attn_phase<128, 128, 2, false, 0, true>(WSP(const bf16, WS_QKV), A_NQKV, 128, WSP(const bf16, WS_QKV) + 1024, A_NQKV, 128, WSP(const bf16, WS_QKV) + 1280, A_NQKV, 128, WSP(bf16, WS_OB), DM, 128, 8, 4, nullptr, (char*)lds, wv);
    if constexpr (PH == 5) wo_gemm(p, wv, lds, WSP(const bf16, WS_OB), W_OA, 0, 1);
    if constexpr (PH == 6) phase_norm_plain<false>(p, wv, bid, nb, 0, 1);
    if constexpr (PH == 7) dense_w13(p, wv, lds, 0);
    if constexpr (PH == 8) dense_w2(p, wv, lds, 0, 0);
    if constexpr (PH == 9) phase_norm_plain<false>(p, wv, bid, nb, 1, 0);
    if constexpr (PH == 10) { pg8::EpiStore E{WSP(bf16, WS_DOWN), B_NDOWN_P, nullptr}; gemm_plain<DM, B_NDOWN_P>(p, wv, lds, WSP(const bf16, WS_A), WSP(const bf16, W_DOWN), E); }
    if constexpr (PH == 11) phase_post_b1(p, wv, bid, nb);
    if constexpr (PH == 12) { pg8::EpiStoreT<1> E{WSP(bf16, WS_QKV), 1536, WSP(const f32x2, WS_ROPE64)}; gemm_plain<B_QL, B_NUQ>(p, wv, lds, WSP(const bf16, WS_DQN), WSP(const bf16, W_UQ), E); }
    if constexpr (PH == 13) { pg8::EpiKV E{WSP(bf16, WS_KB), WSP(bf16, WS_VB)}; gemm_plain<B_KVL, B_NUKV>(p, wv, lds, WSP(const bf16, WS_DKVN), WSP(const bf16, W_UKV), E); }
    if constexpr (PH == 14) att::attn_phase<192, 128, 1, false, 5>(WSP(const bf16, WS_QKV), 1536, 192, WSP(const bf16, WS_KB), 1536, 192, WSP(const bf16, WS_VB), DM, 128, WSP(bf16, WS_OB), DM, 128, 8, 1, nullptr, (char*)lds, wv);
    if constexpr (PH == 15) wo_gemm(p, wv, lds, WSP(const bf16, WS_OB), W_OB, 1, 0);
    if constexpr (PH == 16) phase_norm<4>(p, wv, bid, nb, lds, 1, 1, 0, 0, 0, true);
    if constexpr (PH == 17) moe_w13(p, wv, lds, 0);
    if constexpr (PH == 18) moe_w2(p, wv, lds, 0);
    if constexpr (PH == 19) phase_combine<false>(p, wv, bid, nb, lds, 2, 0, 0, 1);
    if constexpr (PH == 20) { pg8::EpiGelu E{WSP(bf16, WS_QKV), WSP(bf16, WS_KB)}; gemm_plain<DM, C_NIN>(p, wv, lds, WSP(const bf16, WS_A), WSP(const bf16, W_IN), E); }
    if constexpr (PH == 21) phase_sgu(p, wv, bid, nb, lds);
    if constexpr (PH == 22) wo_gemm(p, wv, lds, WSP(const bf16, WS_VB), W_OUT, 2, 0);
    if constexpr (PH == 23) phase_norm_plain<false>(p, wv, bid, nb, 2, 1);
    if constexpr (PH == 24) dense_w13(p, wv, lds, 1);
    if constexpr (PH == 25) dense_w2(p, wv, lds, 1, 2);
    if constexpr (PH == 26) phase_norm_plain<false>(p, wv, bid, nb, 3, 0);
    if constexpr (PH == 27) { pg8::EpiStoreT<3> E{WSP(bf16, WS_QKV), D_NQKV, WSP(const f32x2, WS_ROPE64)}; gemm_plain<DM, D_NQKV>(p, wv, lds, WSP(const bf16, WS_A), WSP(const bf16, W_QKVD), E); }
    if constexpr (PH == 29) att::attn_phase<64, 64, 2, true, 0>(WSP(const bf16, WS_QKV), D_NQKV, 64, WSP(const bf16, WS_QKV) + 1024, D_NQKV, 64, WSP(const bf16, WS_QKV) + 1152, D_NQKV, 64, WSP(bf16, WS_OB), DM, 64, 16, 8, p.in[26], (char*)lds, wv);
    if constexpr (PH == 30) wo_gemm<1>(p, wv, lds, WSP(const bf16, WS_OB), W_OD, 3, 0);
    if constexpr (PH == 31) phase_norm<4>(p, wv, bid, nb, lds, 3, 1, 0, 0, 1, false);
    if constexpr (PH == 32) moe_w13(p, wv, lds, 1);
    if constexpr (PH == 33) moe_w2(p, wv, lds, 1);
    if constexpr (PH == 34) phase_combine<true>(p, wv, bid, nb, lds, 0, 0, 1, 3);
}
#ifndef MK_PER_PHASE
#define MK_PER_PHASE 0
#endif
template <int PH> __global__ void __launch_bounds__(512, 2) k_phase(P p) {
    extern __shared__ __attribute__((aligned(16))) unsigned char lds[];
    run_phase<PH>(p, __builtin_amdgcn_readfirstlane((int)threadIdx.x >> 6), lds);
}
#define AS4 __attribute__((address_space(4)))
#ifndef PROBE_DUP_MASK
#define PROBE_DUP_MASK 0ull
#endif
template <int PH> __device__ __forceinline__ void phase_fn(const AS4 P* pp, int wv, LAS unsigned char* lds_) {
    const AS4 P* q = pp; asm volatile("" : "+s"(q));
    P p;
#pragma unroll
    for (int i = 0; i < 33; ++i) p.in[i] = q->in[i];
    p.out = q->out; p.ws = q->ws; p.ph_lo = 0; p.ph_hi = 0;
    run_phase<PH>(p, wv, (unsigned char*)lds_);
}
template <int PH> __device__ __forceinline__ void run_all(const AS4 P* pp, int wv, LAS unsigned char* lds, const XcdBarrier& bar) {
    constexpr bool on = (PH != 28);
    if constexpr (on) phase_fn<PH>(pp, wv, lds);
    if constexpr (on && ((PROBE_DUP_MASK >> PH) & 1ull) != 0) { __syncthreads(); phase_fn<PH>(pp, wv, lds); }
    if constexpr (PH + 1 < NPH) { if constexpr (on) xcd_barrier(bar, wv); run_all<PH + 1>(pp, wv, lds, bar); }
}
__global__ void __launch_bounds__(512, 2) k_mega(P p_) {
    extern __shared__ __attribute__((aligned(16))) unsigned char lds[];
    const AS4 P* pp = (const AS4 P*)__builtin_amdgcn_kernarg_segment_ptr();
    const int wv = __builtin_amdgcn_readfirstlane((int)threadIdx.x >> 6);
    LAS unsigned* misc = (LAS unsigned*)((LAS unsigned char*)lds + MISC_OFF);
    if (threadIdx.x < 256) misc[threadIdx.x] = 0u;
    __syncthreads();
    const XcdBarrier bar = xcd_barrier_post((unsigned*)(pp->ws + WS_CTL) + CW_BAR, (volatile LAS unsigned*)(misc + 64));
    run_all<0>(pp, wv, (LAS unsigned char*)lds, bar);
}

template <int PH> static void phase(hipStream_t st, const P& p) {
    static bool attr = false; if (!attr) { (void)hipFuncSetAttribute((const void*)k_phase<PH>, hipFuncAttributeMaxDynamicSharedMemorySize, LDS_BYTES); attr = true; }
    hipLaunchKernelGGL((k_phase<PH>), dim3(256), dim3(512), LDS_BYTES, st, p);
}
template <int LO, int HI> static void phases(hipStream_t st, const P& p) { if constexpr (LO < HI) { phase<LO>(st, p); phases<LO + 1, HI>(st, p); } }

extern "C" void kernel_launch(void* const* d_in, const int* in_sizes, int n_in, void* d_out, int out_size, void* d_ws, size_t ws_size, hipStream_t stream) {
    if (n_in != 33 || ws_size < WS_END || out_size != NB * SEQ * DM) { fprintf(stderr, "kernel_launch: unexpected shapes n_in %d ws %zu (need %zu) out %d\n", n_in, ws_size, (size_t)WS_END, out_size); return; }
    P p{}; for (int i = 0; i < 33; ++i) p.in[i] = (const float*)d_in[i]; p.out = (float*)d_out; p.ws = (unsigned char*)d_ws; p.ph_lo = 0; p.ph_hi = 0;
    unsigned char* ws = (unsigned char*)d_ws;
    (void)hipMemsetAsync(ws + WS_CTL, 0, CTL_BYTES, stream);
#if MK_PER_PHASE
    phases<0, NPH>(stream, p);
#else
    static int grid = 0;
    if (grid == 0) {
        int dev = 0, cus = 0, per_cu = 0;
        (void)hipGetDevice(&dev); (void)hipDeviceGetAttribute(&cus, hipDeviceAttributeMultiprocessorCount, dev);
        if (hipFuncSetAttribute((const void*)k_mega, hipFuncAttributeMaxDynamicSharedMemorySize, LDS_BYTES) != hipSuccess) { fprintf(stderr, "kernel_launch: hipFuncSetAttribute failed\n"); grid = -1; return; }
        if (hipOccupancyMaxActiveBlocksPerMultiprocessor(&per_cu, (const void*)k_mega, 512, LDS_BYTES) != hipSuccess || per_cu < 1) { fprintf(stderr, "kernel_launch: occupancy query says %d blocks per CU\n", per_cu); (void)hipGetLastError(); }
        grid = cus;
        if (grid != 256) fprintf(stderr, "kernel_launch: %d CUs (built for 256)\n", grid);
    }
    if (grid < 0) return;
    hipLaunchKernelGGL(k_mega, dim3(grid), dim3(512), LDS_BYTES, stream, p);
#endif
    const hipError_t le = hipPeekAtLastError();
    if (le != hipSuccess) fprintf(stderr, "kernel_launch: launch failed: %s\n", hipGetErrorName(le));
}
```

```cpp
#include <hip/hip_runtime.h>
#include <cstdio>
#include <cstdint>
#include <cstring>
#include <cmath>

#define GAS __attribute__((address_space(1)))
#define LAS __attribute__((address_space(3)))
typedef unsigned short bf16;
typedef float f32x4 __attribute__((ext_vector_type(4)));
typedef float f32x2 __attribute__((ext_vector_type(2)));
typedef short bf16x8 __attribute__((ext_vector_type(8)));
typedef unsigned u32x4 __attribute__((ext_vector_type(4)));
typedef unsigned u32x2 __attribute__((ext_vector_type(2)));

constexpr int DM = 1024, NB = 4, SEQ = 8192, NCTX = 256, RPB = SEQ + NCTX  , T = NB * RPB  ;
constexpr int GRIDW = 64;
constexpr float EPS = 1e-6f;
constexpr int A_NQKV = 1536, B_NDOWN = 704, B_NDOWN_P = 768, B_QL = 384, B_KVL = 256, B_NUQ = 1536, B_NUKV = 2048, C_NIN = 2048, D_NQKV = 1280;
constexpr int FF = 2816, FE = 3584, NE = 8;
constexpr int MAXSLOT = 69632;

constexpr size_t MiB = 1u << 20;
constexpr size_t al(size_t x) { return (x + 255) & ~(size_t)255; }
constexpr size_t WS_CTL = 0, CTL_BYTES = 1 * MiB;
constexpr size_t WS_MOD = 1 * MiB;
constexpr size_t WS_ROPE128 = 2 * MiB;
constexpr size_t WS_ROPE64 = WS_ROPE128 + 128 * 32 * 8;
constexpr size_t WS_IDX = 3 * MiB;
constexpr size_t WS_GW = WS_IDX + al((size_t)NE * T * 4);
constexpr size_t WS_TOK = WS_GW + al((size_t)NE * T * 4);
constexpr size_t WS_TOKW = WS_TOK + al((size_t)T * 16);
constexpr size_t WS_W0 = 8 * MiB;
static_assert(WS_TOKW + (size_t)T * 8 <= WS_W0, "routing tables fit below the weights");
constexpr size_t W_QKVA = WS_W0;
constexpr size_t W_OA = W_QKVA + (size_t)A_NQKV * DM * 2;
constexpr size_t W_DOWN = W_OA + (size_t)DM * DM * 2;
constexpr size_t W_UQ = W_DOWN + (size_t)B_NDOWN_P * DM * 2;
constexpr size_t W_UKV = W_UQ + (size_t)B_NUQ * B_QL * 2;
constexpr size_t W_OB = W_UKV + (size_t)B_NUKV * B_KVL * 2;
constexpr size_t W_IN = W_OB + (size_t)DM * DM * 2;
constexpr size_t W_OUT = W_IN + (size_t)C_NIN * DM * 2;
constexpr size_t W_SP = W_OUT + (size_t)DM * DM * 2;
constexpr size_t W_QKVD = W_SP + (size_t)8 * 128 * 128 * 2;
constexpr size_t W_OD = W_QKVD + (size_t)D_NQKV * DM * 2;
constexpr size_t W_13F = W_OD + (size_t)DM * DM * 2;
constexpr size_t W_2F = W_13F + (size_t)2 * 2 * FF * DM * 2;
constexpr size_t W_13M = W_2F + (size_t)2 * DM * FF * 2;
constexpr size_t W_2M = W_13M + (size_t)2 * NE * 2 * FE * DM * 2;
constexpr size_t WS_WEND = W_2M + (size_t)2 * NE * DM * FE * 2;
constexpr size_t WS_H = al(WS_WEND);
constexpr size_t WS_A = WS_H + (size_t)T * DM * 2;
constexpr size_t WS_QKV = WS_A + (size_t)T * DM * 2;
constexpr size_t WS_KB = WS_QKV + (size_t)T * 1536 * 2;
constexpr size_t WS_VB = WS_KB + (size_t)T * 1536 * 2;
constexpr size_t WS_OB = WS_VB + (size_t)T * DM * 2;
constexpr size_t WS_DOWN = WS_OB + (size_t)T * DM * 2;
constexpr size_t WS_DQN = WS_DOWN + (size_t)T * B_NDOWN_P * 2;
constexpr size_t WS_DKVN = WS_DQN + (size_t)T * B_QL * 2;
constexpr size_t WS_ACT = WS_DKVN + (size_t)T * B_KVL * 2;
constexpr size_t WS_Y = WS_ACT + (size_t)MAXSLOT * FE * 2;
constexpr size_t WS_END = WS_Y + (size_t)MAXSLOT * DM * 2;
constexpr int CW_CNT = 64;
constexpr int CW_BAR = 4096;

__device__ __forceinline__ unsigned f2bf(float f) { unsigned u = __builtin_bit_cast(unsigned, f); return (u + 0x7fffu + ((u >> 16) & 1u)) >> 16; }
__device__ __forceinline__ unsigned pk2(float lo, float hi) { unsigned r; asm("v_cvt_pk_bf16_f32 %0, %1, %2" : "=v"(r) : "v"(lo), "v"(hi)); return r; }
__device__ __forceinline__ float bf2f(unsigned b) { return __builtin_bit_cast(float, b << 16); }
__device__ __forceinline__ float bflo(unsigned w) { return __builtin_bit_cast(float, w << 16); }
__device__ __forceinline__ float bfhi(unsigned w) { return __builtin_bit_cast(float, w & 0xffff0000u); }
__device__ __forceinline__ float wave_sum(float v) {
#pragma unroll
    for (int o = 1; o < 64; o <<= 1) v += __shfl_xor(v, o);
    return v;
}
__device__ __forceinline__ int otid(int wv) { int l; asm volatile("v_mbcnt_lo_u32_b32 %0, -1, 0\n\tv_mbcnt_hi_u32_b32 %0, -1, %0" : "=v"(l)); return wv * 64 + l; }
__device__ __forceinline__ float silu_f(float x) { return x / (1.f + __expf(-x)); }
__device__ __forceinline__ float gelu_erf(float x) { return 0.5f * x * (1.f + erff(x * 0.70710678118654752f)); }

struct P {
    const float* in[33];
    float* out;
    unsigned char* ws;
    int ph_lo, ph_hi;
};
#define WSP(type, off) ((type*)(p.ws + (off)))
#define SUB_SKIP(u, ai, bj) ((u).sub != 0 && (u).sub != 1 + (ai) * 2 + (bj))

__device__ __forceinline__ void row_info(int r, int& b, int& j) { b = r / RPB; j = r - b * RPB; }
__device__ __forceinline__ const float* in_row(const P& p, int r) {
    int b, j; row_info(r, b, j);
    return j < NCTX ? p.in[2] + ((size_t)b * NCTX + j) * DM : p.in[0] + ((size_t)b * SEQ + (j - NCTX)) * DM;
}
__device__ __forceinline__ const float* mod_vec(const P& p, int layer, int r, int chunk) {
    int b, j; row_info(r, b, j); const int mr = j < NCTX ? 4 : b;
    return WSP(const float, WS_MOD) + ((size_t)(layer * 5 + mr) * 6 + chunk) * DM;
}

__device__ __forceinline__ void transpose_item(const float* W, int K, int N, bf16* WT, int mode, int ffh, LAS float* scr, int item, int lane) {
    const int nblk = N / 64, kb = item / nblk, nb = item % nblk, k0 = 64 * kb, n0 = 64 * nb;
    const int lr = lane >> 4, lc = (lane & 15) * 4;
#pragma unroll 8
    for (int i = 0; i < 16; ++i) { const int kk = 4 * i + lr; const f32x4 v = *(const f32x4*)(W + (size_t)(k0 + kk) * N + n0 + lc); LAS float* d = scr + kk * 65 + lc; d[0] = v.x; d[1] = v.y; d[2] = v.z; d[3] = v.w; }
    asm volatile("s_waitcnt lgkmcnt(0)" ::: "memory");
    int d0 = n0;
    if (mode == 1) { if (n0 < ffh) d0 = (n0 / 128) * 256 + n0 % 128; else { const int j = n0 - ffh; d0 = (j / 128) * 256 + 128 + j % 128; } }
    const int c = lane & 7;
#pragma unroll
    for (int j = 0; j < 8; ++j) { const int n = (lane >> 3) + 8 * j; const LAS float* s = scr + (8 * c) * 65 + n;
        u32x4 o; o.x = pk2(s[0 * 65], s[1 * 65]); o.y = pk2(s[2 * 65], s[3 * 65]); o.z = pk2(s[4 * 65], s[5 * 65]); o.w = pk2(s[6 * 65], s[7 * 65]);
        const int dn = d0 + n;
        if (mode == 2) *(u32x4*)(WT + (((size_t)(dn >> 8) * (K >> 6) + kb) * 256 + (dn & 255)) * 64 + 8 * c) = o;
        else *(u32x4*)(WT + (size_t)dn * K + k0 + 8 * c) = o; }
    asm volatile("s_waitcnt lgkmcnt(0)" ::: "memory");
}
struct TJob { const float* W; bf16* WT; int K, N, mode, ffh, items; };

__device__ __forceinline__ void phase_prologue(const P& p, int wv, int bid, int nb, unsigned char* lds_) {
    LAS unsigned char* lds = (LAS unsigned char*)lds_;
    const int tid = otid(wv), lane = tid & 63, wave = tid >> 6;
    {
        const int g = bid * 512 + tid;
        if (g < 128 * 32) { const int pos = g >> 5, i = g & 31; const float inv = (float)pow(10000.0, -(double)i / 32.0); const float a = (float)pos * inv;
            WSP(f32x2, WS_ROPE128)[g] = (f32x2){cosf(a), sinf(a)}; }
        else if (g < 128 * 32 + 128 * 16) { const int q = g - 128 * 32, pos = q >> 4, i = q & 15; const float inv = (float)pow(10000.0, -(double)i / 16.0); const float a = (float)pos * inv;
            WSP(f32x2, WS_ROPE64)[q] = (f32x2){cosf(a), sinf(a)}; }
    }
    {
        LAS float* sc = (LAS float*)lds;
        LAS float* red = (LAS float*)(lds + 5 * 1024 * 4);
        for (int it = bid; it < 192; it += nb) {
            const int layer = it / 48, cg = it % 48;
            __syncthreads();
            for (int i = tid; i < 5 * 1024; i += 512) { const int r = i >> 10, k = i & 1023; const float v = r < 4 ? p.in[1][r * DM + k] : p.in[3][k]; sc[i] = silu_f(v); }
            __syncthreads();
            const float* W = p.in[4] + (size_t)layer * DM * 6144 + cg * 128 + lane * 2;
            f32x2 acc[5];
#pragma unroll
            for (int r = 0; r < 5; ++r) acc[r] = (f32x2){0.f, 0.f};
            for (int k = wave * 128; k < wave * 128 + 128; ++k) { const f32x2 w = *(const f32x2*)(W + (size_t)k * 6144);
#pragma unroll
                for (int r = 0; r < 5; ++r) acc[r] += w * sc[r * 1024 + k]; }
#pragma unroll
            for (int r = 0; r < 5; ++r) *(LAS f32x2*)(red + (wave * 5 + r) * 128 + lane * 2) = acc[r];
            __syncthreads();
            for (int i = tid; i < 5 * 128; i += 512) { const int r = i >> 7, c = i & 127; float s = 0.f;
#pragma unroll
                for (int w = 0; w < 8; ++w) s += red[(w * 5 + r) * 128 + c];
                const int col = cg * 128 + c;
                WSP(float, WS_MOD)[(size_t)(layer * 5 + r) * 6144 + col] = s + p.in[5][layer * 6144 + col]; }
        }
        __syncthreads();
    }
    {
        LAS float* scr = (LAS float*)(lds + wave * 16640);
        const int gw = bid * 8 + wave, NGW = nb * 8;
        int start = 0;
        auto run = [&](const float* W, bf16* WT, int K, int N, int mode, int ffh) {
            const int items = (K / 64) * (N / 64);
            int first = gw - start; if (first < 0) first += NGW;
            for (int it = first; it < items; it += NGW) transpose_item(W, K, N, WT, mode, ffh, scr, it, lane);
            start = (start + items) % NGW;
        };
        run(p.in[9], WSP(bf16, W_QKVA), DM, A_NQKV, 0, 0);
        run(p.in[12], WSP(bf16, W_OA), DM, DM, 0, 0);
        run(p.in[13], WSP(bf16, W_DOWN), DM, B_NDOWN, 0, 0);
        run(p.in[16], WSP(bf16, W_UQ), B_QL, B_NUQ, 0, 0);
        run(p.in[17], WSP(bf16, W_UKV), B_KVL, B_NUKV, 0, 0);
        run(p.in[18], WSP(bf16, W_OB), DM, DM, 0, 0);
        run(p.in[19], WSP(bf16, W_IN), DM, C_NIN, 0, 0);
        run(p.in[24], WSP(bf16, W_OUT), DM, DM, 0, 0);
        run(p.in[25], WSP(bf16, W_QKVD), DM, D_NQKV, 0, 0);
        run(p.in[27], WSP(bf16, W_OD), DM, DM, 0, 0);
        for (int l = 0; l < 2; ++l) {
            run(p.in[28] + (size_t)l * DM * 2 * FF, WSP(bf16, W_13F) + (size_t)l * 2 * FF * DM, DM, 2 * FF, 1, FF);
            run(p.in[29] + (size_t)l * FF * DM, WSP(bf16, W_2F) + (size_t)l * DM * FF, FF, DM, 2, 0);
        }
        for (int le = 0; le < 2 * NE; ++le) {
            run(p.in[31] + (size_t)le * DM * 2 * FE, WSP(bf16, W_13M) + (size_t)le * 2 * FE * DM, DM, 2 * FE, 1, FE);
            run(p.in[32] + (size_t)le * FE * DM, WSP(bf16, W_2M) + (size_t)le * DM * FE, FE, DM, 2, 0);
        }
        const int g = bid * 512 + tid, ng = nb * 512;
        for (int i = g; i < 64 * DM / 8; i += ng) *(u32x4*)(WSP(bf16, W_DOWN) + (size_t)B_NDOWN * DM + i * 8) = (u32x4){0u, 0u, 0u, 0u};
        for (int i = g; i < 8 * 128 * 128 / 4; i += ng) { const f32x4 v = *(const f32x4*)(p.in[22] + i * 4); *(u32x2*)(WSP(bf16, W_SP) + i * 4) = (u32x2){pk2(v.x, v.y), pk2(v.z, v.w)}; }
    }
}

__device__ __forceinline__ void moe_offsets_lds(const P& p, int m, LAS int* off  ) {
    const unsigned* cnt = WSP(const unsigned, WS_CTL) + CW_CNT + 64 * m; int o = 0;
    for (int e = 0; e < NE; ++e) { off[e] = o; const int c = (int)__hip_atomic_load(cnt + e, __ATOMIC_RELAXED, __HIP_MEMORY_SCOPE_AGENT); o += (c + 255) & ~255; }
    off[NE] = o;
}

template <int MODE>
__device__ __forceinline__ void phase_norm(const P& p, int wv, int bid, int nb, unsigned char* lds_, int layer, int which  , int m_prev, int prev_layer, int m_cur, bool route_ctx) {
    LAS unsigned char* lds = (LAS unsigned char*)lds_;
    const int tid = otid(wv), lane = tid & 63, wave = tid >> 6;
    const int per = (T + nb - 1) / nb, r0 = bid * per, r1 = min(T, r0 + per);
    LAS float* rt = (LAS float*)lds;
    LAS int* re = (LAS int*)(lds + 32768);
    LAS float* rw = (LAS float*)(lds + 32768 + 8192);
    LAS int* soff = (LAS int*)(lds + 32768 + 16384);
    if (MODE & 4) { const float* R = p.in[30] + (size_t)m_cur * DM * NE; for (int i = tid; i < DM * NE; i += 512) rt[i] = R[i]; }
    if (MODE & 2) { if (tid == 0) moe_offsets_lds(p, m_prev, soff); }
    __syncthreads();
    const float* gain = (MODE & 8) ? p.in[8] : (which == 0 ? p.in[6] : p.in[7]) + (size_t)layer * DM;
    int cur_mr = -1; f32x4 gm[4], shv[4], g2v[4];
#pragma unroll
    for (int q = 0; q < 4; ++q) { gm[q] = (f32x4){0.f, 0.f, 0.f, 0.f}; shv[q] = gm[q]; g2v[q] = gm[q]; }
    for (int r = r0 + wave; r < r1; r += 8) {
        int b, j; row_info(r, b, j); const bool isctx = j < NCTX;
        if ((MODE & 8) && isctx) continue;
        { const int mr = isctx ? 4 : b;
          if (mr != cur_mr) { cur_mr = mr;
            if (MODE & 2) { const float* g2 = mod_vec(p, prev_layer, r, 5);
#pragma unroll
                for (int q = 0; q < 4; ++q) g2v[q] = *(const f32x4*)(g2 + q * 256 + lane * 4); }
            if (MODE & 8) {
#pragma unroll
                for (int q = 0; q < 4; ++q) gm[q] = *(const f32x4*)(gain + q * 256 + lane * 4); }
            else { const float* sh_ = mod_vec(p, layer, r, which * 3 + 0); const float* sc_ = mod_vec(p, layer, r, which * 3 + 1);
#pragma unroll
                for (int q = 0; q < 4; ++q) { const f32x4 g = *(const f32x4*)(gain + q * 256 + lane * 4), s1 = *(const f32x4*)(sc_ + q * 256 + lane * 4); gm[q] = g * (s1 + 1.f); shv[q] = *(const f32x4*)(sh_ + q * 256 + lane * 4); } } } }
        f32x4 v[4];
        if (MODE & 1) { const float* src = in_row(p, r);
#pragma unroll
            for (int q = 0; q < 4; ++q) v[q] = *(const f32x4*)(src + q * 256 + lane * 4); }
        else { const bf16* src = WSP(const bf16, WS_H) + (size_t)r * DM;
#pragma unroll
            for (int q = 0; q < 4; ++q) { const u32x2 w = *(const u32x2*)(src + q * 256 + lane * 4); v[q] = (f32x4){bflo(w.x), bfhi(w.x), bflo(w.y), bfhi(w.y)}; } }
        if (MODE & 2) {
            const int4 tk = WSP(const int4, WS_TOK)[r];
            const bool routed = tk.x >= 0;
            if (routed) {
                const int s0 = soff[tk.x] + tk.y, s1 = soff[tk.z] + tk.w;
                const bf16* y0 = WSP(const bf16, WS_Y) + (size_t)s0 * DM; const bf16* y1 = WSP(const bf16, WS_Y) + (size_t)s1 * DM;
                const f32x2 tw = WSP(const f32x2, WS_TOKW)[r];
#pragma unroll
                for (int q = 0; q < 4; ++q) { const u32x2 a = *(const u32x2*)(y0 + q * 256 + lane * 4), c = *(const u32x2*)(y1 + q * 256 + lane * 4); const f32x4 g = g2v[q];
                    v[q].x += g.x * (tw.x * bflo(a.x) + tw.y * bflo(c.x)); v[q].y += g.y * (tw.x * bfhi(a.x) + tw.y * bfhi(c.x)); v[q].z += g.z * (tw.x * bflo(a.y) + tw.y * bflo(c.y)); v[q].w += g.w * (tw.x * bfhi(a.y) + tw.y * bfhi(c.y)); }
                if (!(MODE & 8)) {
#pragma unroll
                    for (int q = 0; q < 4; ++q) *(u32x2*)(WSP(bf16, WS_H) + (size_t)r * DM + q * 256 + lane * 4) = (u32x2){pk2(v[q].x, v[q].y), pk2(v[q].z, v[q].w)};
                }
            }
        }
        float ss = 0.f;
#pragma unroll
        for (int q = 0; q < 4; ++q) ss += (v[q].x * v[q].x + v[q].y * v[q].y) + (v[q].z * v[q].z + v[q].w * v[q].w);
        const float rs = rsqrtf(wave_sum(ss) * (1.f / DM) + EPS);
        if (MODE & 8) {
            float* o = p.out + ((size_t)b * SEQ + (j - NCTX)) * DM;
#pragma unroll
            for (int q = 0; q < 4; ++q) *(f32x4*)(o + q * 256 + lane * 4) = v[q] * rs * gm[q];
            continue;
        }
#pragma unroll
        for (int q = 0; q < 4; ++q) {
            v[q] = (v[q] * rs) * gm[q] + shv[q];
            *(u32x2*)(WSP(bf16, WS_A) + (size_t)r * DM + q * 256 + lane * 4) = (u32x2){pk2(v[q].x, v[q].y), pk2(v[q].z, v[q].w)}; }
        if (MODE & 4) {
            const int li = r - r0;
            if (isctx && !route_ctx) { if (lane == 0) { re[li * 2] = -1; re[li * 2 + 1] = -1; } }
            else {
                float lg[8];
#pragma unroll
                for (int e = 0; e < 8; ++e) lg[e] = 0.f;
#pragma unroll
                for (int q = 0; q < 4; ++q)
#pragma unroll
                    for (int c = 0; c < 4; ++c) { const int col = q * 256 + lane * 4 + c; const f32x4 w0 = *(LAS f32x4*)(rt + col * 8), w1 = *(LAS f32x4*)(rt + col * 8 + 4); const float a = v[q][c];
                        lg[0] += a * w0.x; lg[1] += a * w0.y; lg[2] += a * w0.z; lg[3] += a * w0.w; lg[4] += a * w1.x; lg[5] += a * w1.y; lg[6] += a * w1.z; lg[7] += a * w1.w; }
#pragma unroll
                for (int e = 0; e < 8; ++e) lg[e] = wave_sum(lg[e]);
                int e0 = 0; float v0 = lg[0];
#pragma unroll
                for (int e = 1; e < 8; ++e) if (lg[e] > v0) { v0 = lg[e]; e0 = e; }
                int e1 = -1; float v1 = -3.0e38f;
#pragma unroll
                for (int e = 0; e < 8; ++e) if (e != e0 && lg[e] > v1) { v1 = lg[e]; e1 = e; }
                const float w1 = 1.f / (1.f + __expf(v0 - v1)), w0 = 1.f - w1;
                if (lane == 0) { re[li * 2] = e0; re[li * 2 + 1] = e1; rw[li * 2] = w0; rw[li * 2 + 1] = w1; }
            }
        }
    }
    if (MODE & 4) {
        __syncthreads();
        { LAS int* wcnt = (LAS int*)(lds + 32768 + 16384 + 256); LAS int* woff = wcnt + 64;
          const int n2 = 2 * (r1 - r0);
          int* idxb = WSP(int, WS_IDX); float* gwb = WSP(float, WS_GW); int* tok = WSP(int, WS_TOK);
          for (int ib = 0; ib < n2; ib += 512) {
              const int i = ib + tid; const int ei = (i < n2) ? re[i] : -1; int rank = 0;
#pragma unroll
              for (int e = 0; e < NE; ++e) { const unsigned long long mk = __ballot(ei == e); if (ei == e) rank = __popcll(mk & ((1ull << lane) - 1ull)); if (lane == 0) wcnt[wave * 8 + e] = __popcll(mk); }
              __syncthreads();
              if (tid < NE) { int c = 0;
                  for (int w = 0; w < 8; ++w) c += wcnt[w * 8 + tid];
                  unsigned* cnt = WSP(unsigned, WS_CTL) + CW_CNT + 64 * m_cur + tid;
                  int base = c ? (int)__hip_atomic_fetch_add(cnt, (unsigned)c, __ATOMIC_RELAXED, __HIP_MEMORY_SCOPE_AGENT) : 0;
                  for (int w = 0; w < 8; ++w) { woff[w * 8 + tid] = base; base += wcnt[w * 8 + tid]; } }
              __syncthreads();
              if (ei >= 0) { const int pos = woff[wave * 8 + ei] + rank, r = r0 + (i >> 1); const float wgt = rw[i];
                  idxb[(size_t)ei * T + pos] = r; gwb[(size_t)ei * T + pos] = wgt; tok[r * 4 + (i & 1) * 2] = ei; tok[r * 4 + (i & 1) * 2 + 1] = pos; WSP(float, WS_TOKW)[r * 2 + (i & 1)] = wgt; }
              __syncthreads();
          } }
        for (int i = tid; i < r1 - r0; i += 512) if (re[i * 2] < 0) { int* tok = WSP(int, WS_TOK); const int r = r0 + i; tok[r * 4] = -1; tok[r * 4 + 1] = 0; tok[r * 4 + 2] = -1; tok[r * 4 + 3] = 0; }
    }
}

template <bool FINAL>
__device__ __forceinline__ void phase_combine(const P& p, int wv, int bid, int nb, unsigned char* lds_, int layer, int which, int m_prev, int prev_layer) {
    LAS unsigned char* lds = (LAS unsigned char*)lds_;
    const int tid = otid(wv), lane = tid & 63, wave = tid >> 6;
    const int per = (T + nb - 1) / nb, r0 = bid * per, r1 = min(T, r0 + per);
    LAS int* soff = (LAS int*)(lds + 32768 + 16384);
    if (tid < NE) soff[16 + tid] = (int)__hip_atomic_load(WSP(const unsigned, WS_CTL) + CW_CNT + 64 * m_prev + tid, __ATOMIC_RELAXED, __HIP_MEMORY_SCOPE_AGENT);
    __syncthreads();
    if (tid == 0) { int o = 0; for (int e = 0; e < NE; ++e) { soff[e] = o; o += (soff[16 + e] + 255) & ~255; } soff[NE] = o; }
    __syncthreads();
    const float* gain = FINAL ? p.in[8] : (which == 0 ? p.in[6] : p.in[7]) + (size_t)layer * DM;
    int cur_mr = -1; f32x4 gm[4], shv[4], g2v[4];
#pragma unroll
    for (int q = 0; q < 4; ++q) { gm[q] = (f32x4){0.f, 0.f, 0.f, 0.f}; shv[q] = gm[q]; g2v[q] = gm[q]; }
    const int4* TOK = WSP(const int4, WS_TOK); const f32x2* TOKW = WSP(const f32x2, WS_TOKW);
    const bf16* Yb = WSP(const bf16, WS_Y); bf16* Hb = WSP(bf16, WS_H);
#define CMB_LOAD(hX, aX, cX, rr, tk) do { const bool _ro = (tk).x >= 0; const int _s0 = _ro ? soff[(tk).x] + (tk).y : 0, _s1 = _ro ? soff[(tk).z] + (tk).w : 0; \
        const bf16* _h = Hb + (size_t)(rr) * DM + lane * 4; const bf16* _y0 = Yb + (size_t)_s0 * DM + lane * 4; const bf16* _y1 = Yb + (size_t)_s1 * DM + lane * 4; \
        _Pragma("unroll") for (int q = 0; q < 4; ++q) { hX[q] = *(const u32x2*)(_h + q * 256); aX[q] = *(const u32x2*)(_y0 + q * 256); cX[q] = *(const u32x2*)(_y1 + q * 256); } } while (0)
    int r = r0 + wave;
    if (r < r1) {
        int4 tk_c = TOK[r]; f32x2 tw_c = TOKW[r];
        int4 tk_n = tk_c; f32x2 tw_n = tw_c; if (r + 8 < r1) { tk_n = TOK[r + 8]; tw_n = TOKW[r + 8]; }
        u32x2 hA[4], aA[4], cA[4];
        CMB_LOAD(hA, aA, cA, r, tk_c);
        for (; r < r1; r += 8) {
            u32x2 hB[4], aB[4], cB[4];
#pragma unroll
            for (int q = 0; q < 4; ++q) { hB[q] = hA[q]; aB[q] = aA[q]; cB[q] = cA[q]; }
            if (r + 8 < r1) CMB_LOAD(hB, aB, cB, r + 8, tk_n);
            int4 tk_nn = tk_n; f32x2 tw_nn = tw_n; if (r + 16 < r1) { tk_nn = TOK[r + 16]; tw_nn = TOKW[r + 16]; }
            int b, j; row_info(r, b, j); const bool isctx = j < NCTX;
            if (!(FINAL && isctx)) {
                const int mr = isctx ? 4 : b;
                if (mr != cur_mr) { cur_mr = mr; const float* g2 = mod_vec(p, prev_layer, r, 5);
#pragma unroll
                    for (int q = 0; q < 4; ++q) g2v[q] = *(const f32x4*)(g2 + q * 256 + lane * 4);
                    if (FINAL) {
#pragma unroll
                        for (int q = 0; q < 4; ++q) gm[q] = *(const f32x4*)(gain + q * 256 + lane * 4); }
                    else { const float* sh_ = mod_vec(p, layer, r, which * 3 + 0); const float* sc_ = mod_vec(p, layer, r, which * 3 + 1);
#pragma unroll
                        for (int q = 0; q < 4; ++q) { const f32x4 g = *(const f32x4*)(gain + q * 256 + lane * 4), s1 = *(const f32x4*)(sc_ + q * 256 + lane * 4); gm[q] = g * (s1 + 1.f); shv[q] = *(const f32x4*)(sh_ + q * 256 + lane * 4); } } }
                f32x4 v[4];
#pragma unroll
                for (int q = 0; q < 4; ++q) v[q] = (f32x4){bflo(hA[q].x), bfhi(hA[q].x), bflo(hA[q].y), bfhi(hA[q].y)};
                if (tk_c.x >= 0) {
#pragma unroll
                    for (int q = 0; q < 4; ++q) { const u32x2 a = aA[q], c = cA[q]; const f32x4 g = g2v[q];
                        v[q].x += g.x * (tw_c.x * bflo(a.x) + tw_c.y * bflo(c.x)); v[q].y += g.y * (tw_c.x * bfhi(a.x) + tw_c.y * bfhi(c.x)); v[q].z += g.z * (tw_c.x * bflo(a.y) + tw_c.y * bflo(c.y)); v[q].w += g.w * (tw_c.x * bfhi(a.y) + tw_c.y * bfhi(c.y)); }
                    if (!FINAL) {
#pragma unroll
                        for (int q = 0; q < 4; ++q) *(u32x2*)(Hb + (size_t)r * DM + q * 256 + lane * 4) = (u32x2){pk2(v[q].x, v[q].y), pk2(v[q].z, v[q].w)}; }
                }
                float ss = 0.f;
#pragma unroll
                for (int q = 0; q < 4; ++q) ss += (v[q].x * v[q].x + v[q].y * v[q].y) + (v[q].z * v[q].z + v[q].w * v[q].w);
                const float rs = rsqrtf(wave_sum(ss) * (1.f / DM) + EPS);
                if (FINAL) { float* o = p.out + ((size_t)b * SEQ + (j - NCTX)) * DM;
#pragma unroll
                    for (int q = 0; q < 4; ++q) *(f32x4*)(o + q * 256 + lane * 4) = v[q] * rs * gm[q]; }
                else {
#pragma unroll
                    for (int q = 0; q < 4; ++q) { const f32x4 o = (v[q] * rs) * gm[q] + shv[q]; *(u32x2*)(WSP(bf16, WS_A) + (size_t)r * DM + q * 256 + lane * 4) = (u32x2){pk2(o.x, o.y), pk2(o.z, o.w)}; } }
            }
#pragma unroll
            for (int q = 0; q < 4; ++q) { hA[q] = hB[q]; aA[q] = aB[q]; cA[q] = cB[q]; }
            tk_c = tk_n; tw_c = tw_n; tk_n = tk_nn; tw_n = tw_nn;
        }
    }
#undef CMB_LOAD
}

template <bool FROM_IN>
__device__ __forceinline__ void phase_norm_plain(const P& p, int wv, int bid, int nb, int layer, int which) {
    const int tid = otid(wv), lane = tid & 63, wave = tid >> 6;
    const int per = (T + nb - 1) / nb, r0 = bid * per, r1 = min(T, r0 + per);
    const float* gain = (which == 0 ? p.in[6] : p.in[7]) + (size_t)layer * DM;
    int cur_mr = -1; f32x4 gm[4], shv[4];
#pragma unroll
    for (int q = 0; q < 4; ++q) { gm[q] = (f32x4){0.f, 0.f, 0.f, 0.f}; shv[q] = gm[q]; }
    for (int r = r0 + wave; r < r1; r += 16) {
        const int ra = r, rb = (r + 8 < r1) ? r + 8 : r;
        f32x4 va[4], vb[4];
        if (FROM_IN) { const float* sa = in_row(p, ra); const float* sb = in_row(p, rb);
#pragma unroll
            for (int q = 0; q < 4; ++q) { va[q] = *(const f32x4*)(sa + q * 256 + lane * 4); vb[q] = *(const f32x4*)(sb + q * 256 + lane * 4); } }
        else { const bf16* sa = WSP(const bf16, WS_H) + (size_t)ra * DM; const bf16* sb = WSP(const bf16, WS_H) + (size_t)rb * DM; u32x2 wa[4], wb[4];
#pragma unroll
            for (int q = 0; q < 4; ++q) { wa[q] = *(const u32x2*)(sa + q * 256 + lane * 4); wb[q] = *(const u32x2*)(sb + q * 256 + lane * 4); }
#pragma unroll
            for (int q = 0; q < 4; ++q) { va[q] = (f32x4){bflo(wa[q].x), bfhi(wa[q].x), bflo(wa[q].y), bfhi(wa[q].y)}; vb[q] = (f32x4){bflo(wb[q].x), bfhi(wb[q].x), bflo(wb[q].y), bfhi(wb[q].y)}; } }
        float sa2 = 0.f, sb2 = 0.f;
#pragma unroll
        for (int q = 0; q < 4; ++q) { sa2 += (va[q].x * va[q].x + va[q].y * va[q].y) + (va[q].z * va[q].z + va[q].w * va[q].w); sb2 += (vb[q].x * vb[q].x + vb[q].y * vb[q].y) + (vb[q].z * vb[q].z + vb[q].w * vb[q].w); }
        const float rsa = rsqrtf(wave_sum(sa2) * (1.f / DM) + EPS), rsb = rsqrtf(wave_sum(sb2) * (1.f / DM) + EPS);
#pragma unroll
        for (int half = 0; half < 2; ++half) {
            const int rr = half ? rb : ra; int b, j; row_info(rr, b, j); const int mr = (j < NCTX) ? 4 : b;
            if (mr != cur_mr) { cur_mr = mr; const float* sh_ = mod_vec(p, layer, rr, which * 3 + 0); const float* sc_ = mod_vec(p, layer, rr, which * 3 + 1);
#pragma unroll
                for (int q = 0; q < 4; ++q) { const f32x4 g = *(const f32x4*)(gain + q * 256 + lane * 4), s1 = *(const f32x4*)(sc_ + q * 256 + lane * 4); gm[q] = g * (s1 + 1.f); shv[q] = *(const f32x4*)(sh_ + q * 256 + lane * 4); } }
            const float rs = half ? rsb : rsa;
#pragma unroll
            for (int q = 0; q < 4; ++q) { const f32x4 o = ((half ? vb[q] : va[q]) * rs) * gm[q] + shv[q];
                *(u32x2*)(WSP(bf16, WS_A) + (size_t)rr * DM + q * 256 + lane * 4) = (u32x2){pk2(o.x, o.y), pk2(o.z, o.w)}; }
        }
    }
}

__device__ __forceinline__ void phase_post_a(const P& p, int wv, int bid, int nb) {
    const int tid = otid(wv), hw = (bid * 512 + tid) >> 5, nhw = nb * 16, l = tid & 31;
    const f32x2* cs = WSP(const f32x2, WS_ROPE128);
    u32x2 raw_n = (u32x2){0u, 0u};
    if (hw < T * 10) { const int r = hw / 10, h = hw - r * 10; raw_n = *(const u32x2*)(WSP(bf16, WS_QKV) + (size_t)r * A_NQKV + h * 128 + l * 4); }
    for (int it = hw; it < T * 10; it += nhw) {
        const int r = it / 10, h = it - r * 10; int b, j; row_info(r, b, j);
        bf16* ptr = WSP(bf16, WS_QKV) + (size_t)r * A_NQKV + h * 128 + l * 4;
        const u32x2 raw = raw_n;
        { const int it2 = it + nhw; if (it2 < T * 10) { const int r2 = it2 / 10, h2 = it2 - r2 * 10; raw_n = *(const u32x2*)(WSP(bf16, WS_QKV) + (size_t)r2 * A_NQKV + h2 * 128 + l * 4); } }
        float x[4] = {bflo(raw.x), bfhi(raw.x), bflo(raw.y), bfhi(raw.y)};
        float ss = x[0] * x[0] + x[1] * x[1] + x[2] * x[2] + x[3] * x[3];
#pragma unroll
        for (int o = 1; o < 32; o <<= 1) ss += __shfl_xor(ss, o);
        const float rs = rsqrtf(ss * (1.f / 128.f) + EPS);
        const float* w = (h < 8 ? p.in[10] : p.in[11]) + l * 4;
#pragma unroll
        for (int e = 0; e < 4; ++e) x[e] = x[e] * rs * w[e];
        float y[4];
        if (j >= NCTX) {
            const int s = j - NCTX, pos = (l < 16) ? (s / GRIDW) : (s % GRIDW);
            const bool second = (l & 8) != 0;
#pragma unroll
            for (int e = 0; e < 4; ++e) { const float o = __shfl_xor(x[e], 8); const int f = ((l & 7) * 4 + e); const f32x2 c = cs[pos * 32 + f];
                y[e] = second ? (x[e] * c.x + o * c.y) : (x[e] * c.x - o * c.y); }
        } else {
#pragma unroll
            for (int e = 0; e < 4; ++e) y[e] = x[e];
        }
        *(u32x2*)ptr = (u32x2){pk2(y[0], y[1]), pk2(y[2], y[3])};
    }
}
__device__ __forceinline__ void phase_post_b1(const P& p, int wv, int bid, int nb) {
    const int tid = otid(wv), lane = tid & 63, gw = bid * 8 + (tid >> 6), ngw = nb * 8;
    const f32x2* cs = WSP(const f32x2, WS_ROPE64);
    for (int r = gw; r < T; r += ngw) {
        int b, j; row_info(r, b, j);
        const bf16* d = WSP(const bf16, WS_DOWN) + (size_t)r * B_NDOWN_P;
        float q[6], kv[4];
        float s1 = 0.f, s2 = 0.f;
#pragma unroll
        for (int i = 0; i < 6; ++i) { q[i] = bf2f(d[i * 64 + lane]); s1 += q[i] * q[i]; }
#pragma unroll
        for (int i = 0; i < 4; ++i) { kv[i] = bf2f(d[384 + i * 64 + lane]); s2 += kv[i] * kv[i]; }
        float kr = bf2f(d[640 + lane]);
        const float r1 = rsqrtf(wave_sum(s1) * (1.f / 384.f) + EPS), r2 = rsqrtf(wave_sum(s2) * (1.f / 256.f) + EPS);
#pragma unroll
        for (int i = 0; i < 6; ++i) WSP(bf16, WS_DQN)[(size_t)r * B_QL + i * 64 + lane] = (bf16)f2bf(q[i] * r1 * p.in[14][i * 64 + lane]);
#pragma unroll
        for (int i = 0; i < 4; ++i) WSP(bf16, WS_DKVN)[(size_t)r * B_KVL + i * 64 + lane] = (bf16)f2bf(kv[i] * r2 * p.in[15][i * 64 + lane]);
        if (j >= NCTX) {
            const int s = j - NCTX, pos = (lane < 32) ? (s / GRIDW) : (s % GRIDW); const float o = __shfl_xor(kr, 16); const f32x2 c = cs[pos * 16 + (lane & 15)];
            kr = (lane & 16) ? (kr * c.x + o * c.y) : (kr * c.x - o * c.y);
        }
        const bf16 krb = (bf16)f2bf(kr);
#pragma unroll
        for (int h = 0; h < 8; ++h) WSP(bf16, WS_KB)[(size_t)r * 1536 + h * 192 + 128 + lane] = krb;
    }
}
__device__ __forceinline__ void phase_rope64(const P& p, int wv, int bid, int nb, bf16* buf, int ld, int nh, int hs, int off) {
    const int tid = otid(wv), lane = tid & 63, gw = bid * 8 + (tid >> 6), ngw = nb * 8;
    const f32x2* cs = WSP(const f32x2, WS_ROPE64);
    for (int r = gw; r < T; r += ngw) {
        int b, j; row_info(r, b, j); if (j < NCTX) continue;
        const int s = j - NCTX, pos = (lane < 32) ? (s / GRIDW) : (s % GRIDW); const f32x2 c = cs[pos * 16 + (lane & 15)];
        for (int h = 0; h < nh; ++h) { bf16* q = buf + (size_t)r * ld + h * hs + off + lane; const float x = bf2f(*q), o = __shfl_xor(x, 16);
            *q = (bf16)f2bf((lane & 16) ? (x * c.x + o * c.y) : (x * c.x - o * c.y)); }
    }
}

__device__ __forceinline__ void phase_sgu_simple(const P& p, int wv, int bid, int nb, unsigned char* lds_) {
    LAS unsigned char* lds = (LAS unsigned char*)lds_;
    const int tid = otid(wv), lane = tid & 63, wave = tid >> 6;
    LAS float* mean = (LAS float*)lds; LAS float* rstd = mean + 128; LAS float* vl = (LAS float*)(lds + 1024);
    const bf16* U = WSP(const bf16, WS_QKV); const bf16* V = WSP(const bf16, WS_KB); bf16* Mo = WSP(bf16, WS_VB);
    const float* Wsp = p.in[22]; const float* bsp = p.in[23];
    for (int ch = bid; ch < T / 128; ch += nb) {
        const int row0 = ch * 128;
        __syncthreads();
        for (int rr = wave; rr < 128; rr += 8) { const bf16* vr = V + (size_t)(row0 + rr) * DM; float x[16]; float s = 0.f;
#pragma unroll
            for (int i = 0; i < 16; ++i) { x[i] = bf2f(vr[i * 64 + lane]); s += x[i]; }
            const float mu = wave_sum(s) * (1.f / 1024.f); float q = 0.f;
#pragma unroll
            for (int i = 0; i < 16; ++i) { const float d = x[i] - mu; q += d * d; }
            const float var = wave_sum(q) * (1.f / 1024.f);
            if (lane == 0) { mean[rr] = mu; rstd[rr] = rsqrtf(var + EPS); } }
        for (int g = 0; g < 8; ++g) {
            __syncthreads();
            for (int i = tid; i < 128 * 128; i += 512) { const int q = i >> 7, c = i & 127, col = g * 128 + c;
                const float x = bf2f(V[(size_t)(row0 + q) * DM + col]); vl[i] = bf2f(f2bf((x - mean[q]) * rstd[q] * p.in[20][col] + p.in[21][col])); }
            __syncthreads();
            const int pp = tid >> 2, c0 = (tid & 3) * 32;
            float acc[32];
#pragma unroll
            for (int i = 0; i < 32; ++i) acc[i] = 0.f;
            const float* wrow = Wsp + ((size_t)g * 128 + pp) * 128;
            for (int q = 0; q < 128; ++q) { const float w = bf2f(f2bf(wrow[q]));
#pragma unroll
                for (int i = 0; i < 32; ++i) acc[i] += w * vl[q * 128 + c0 + i]; }
            const float bb = bsp[g * 128 + pp];
#pragma unroll
            for (int i = 0; i < 32; ++i) { const size_t o = (size_t)(row0 + pp) * DM + g * 128 + c0 + i; Mo[o] = (bf16)f2bf(bf2f(U[o]) * (acc[i] + bb)); }
        }
    }
}

__device__ __forceinline__ void phase_sgu(const P& p, int wv, int bid, int nb, unsigned char* lds_) {
    using f32x16 = __attribute__((ext_vector_type(16))) float;
    LAS unsigned char* lds = (LAS unsigned char*)lds_;
    const int tid = otid(wv), lane = tid & 63, wave = tid >> 6, r32 = lane & 31, hi = lane >> 5;
    constexpr int VT_ROW = 272, VT_BYTES = 128 * VT_ROW;
    LAS unsigned char* vT = lds; LAS unsigned char* oT = lds + 2 * VT_BYTES;
    const bf16* U = WSP(const bf16, WS_QKV); const bf16* V = WSP(const bf16, WS_KB); bf16* Mo = WSP(bf16, WS_VB);
    const bf16* Wsp = WSP(const bf16, W_SP); const float* bsp = p.in[23]; const float* lng = p.in[20]; const float* lnb = p.in[21];
    const int pb = wave & 3, cbh = wave >> 2;
    const int sq = tid >> 2, sc0 = (tid & 3) * 32;
    const int nch = T / 128, nfull = (nch / nb) * nb, ntail = (nch - nfull) * 8;
    for (int ui = bid; ui < nfull + ntail; ui += nb) {
        int ch, g0, g1; if (ui < nfull) { ch = ui; g0 = 0; g1 = 8; } else { ch = nfull + ((ui - nfull) >> 3); g0 = (ui - nfull) & 7; g1 = g0 + 1; }
        const int row0 = ch * 128;
        const bf16* vrow = V + (size_t)(row0 + sq) * DM; const bf16* urow = U + (size_t)(row0 + sq) * DM; bf16* mrow = Mo + (size_t)(row0 + sq) * DM;
        float s1 = 0.f, s2 = 0.f;
#pragma unroll
        for (int hb = 0; hb < 2; ++hb) { u32x4 w[16];
#pragma unroll
            for (int j = 0; j < 16; ++j) w[j] = *(const u32x4*)(vrow + (tid & 3) * 256 + hb * 128 + j * 8);
#pragma unroll
            for (int j = 0; j < 16; ++j) { const float x0 = bflo(w[j].x), x1 = bfhi(w[j].x), x2 = bflo(w[j].y), x3 = bfhi(w[j].y), x4 = bflo(w[j].z), x5 = bfhi(w[j].z), x6 = bflo(w[j].w), x7 = bfhi(w[j].w);
                s1 += ((x0 + x1) + (x2 + x3)) + ((x4 + x5) + (x6 + x7)); s2 += ((x0 * x0 + x1 * x1) + (x2 * x2 + x3 * x3)) + ((x4 * x4 + x5 * x5) + (x6 * x6 + x7 * x7)); } }
        s1 += __shfl_xor(s1, 1); s2 += __shfl_xor(s2, 1); s1 += __shfl_xor(s1, 2); s2 += __shfl_xor(s2, 2);
        const float mq = s1 * (1.f / 1024.f), rq = rsqrtf(fmaxf(s2 * (1.f / 1024.f) - mq * mq, 0.f) + EPS);
        u32x4 vreg[4], ureg[4];
#pragma unroll
        for (int j = 0; j < 4; ++j) { vreg[j] = *(const u32x4*)(vrow + g0 * 128 + sc0 + j * 8); ureg[j] = *(const u32x4*)(urow + g0 * 128 + sc0 + j * 8); }
#pragma unroll 1
        for (int g = g0; g < g1; ++g) {
            LAS unsigned char* buf = vT + (g & 1) * VT_BYTES;
            { const float* gg = lng + g * 128 + sc0; const float* gb = lnb + g * 128 + sc0;
#pragma unroll
              for (int j = 0; j < 4; ++j) { const u32x4 w = vreg[j]; const f32x4 ga = *(const f32x4*)(gg + j * 8), gc = *(const f32x4*)(gg + j * 8 + 4), ba = *(const f32x4*)(gb + j * 8), bc = *(const f32x4*)(gb + j * 8 + 4);
                  const float xv[8] = {bflo(w.x), bfhi(w.x), bflo(w.y), bfhi(w.y), bflo(w.z), bfhi(w.z), bflo(w.w), bfhi(w.w)}; const float gv[8] = {ga.x, ga.y, ga.z, ga.w, gc.x, gc.y, gc.z, gc.w}; const float bv[8] = {ba.x, ba.y, ba.z, ba.w, bc.x, bc.y, bc.z, bc.w};
#pragma unroll
                  for (int e = 0; e < 8; ++e) *(LAS bf16*)(buf + (sc0 + j * 8 + e) * VT_ROW + sq * 2) = (bf16)f2bf((xv[e] - mq) * rq * gv[e] + bv[e]); } }
            const u32x4 u0 = ureg[0], u1 = ureg[1], u2 = ureg[2], u3 = ureg[3];
            if (g + 1 < g1) {
#pragma unroll
                for (int j = 0; j < 4; ++j) { vreg[j] = *(const u32x4*)(vrow + (g + 1) * 128 + sc0 + j * 8); ureg[j] = *(const u32x4*)(urow + (g + 1) * 128 + sc0 + j * 8); } }
            bf16x8 af[8];
            { const bf16* wr = Wsp + ((size_t)g * 128 + pb * 32 + r32) * 128 + hi * 8;
#pragma unroll
              for (int ks = 0; ks < 8; ++ks) af[ks] = *(const bf16x8*)(wr + ks * 16); }
            float bias[16];
#pragma unroll
            for (int r = 0; r < 16; ++r) bias[r] = bsp[g * 128 + pb * 32 + (r & 3) + 8 * (r >> 2) + 4 * hi];
            __syncthreads();
#pragma unroll
            for (int t = 0; t < 2; ++t) { f32x16 acc = f32x16{}; const LAS unsigned char* br = buf + ((cbh * 2 + t) * 32 + r32) * VT_ROW + hi * 16;
#pragma unroll
                for (int ks = 0; ks < 8; ++ks) { const bf16x8 bfr = *(const LAS bf16x8*)(br + ks * 32); acc = __builtin_amdgcn_mfma_f32_32x32x16_bf16(af[ks], bfr, acc, 0, 0, 0); }
#pragma unroll
                for (int r = 0; r < 16; ++r) { const int pr = pb * 32 + (r & 3) + 8 * (r >> 2) + 4 * hi; *(LAS bf16*)(oT + pr * VT_ROW + ((cbh * 2 + t) * 32 + r32) * 2) = (bf16)f2bf(acc[r] + bias[r]); } }
            __syncthreads();
            { const u32x4 uu[4] = {u0, u1, u2, u3};
#pragma unroll
              for (int j = 0; j < 4; ++j) { const u32x4 mx = *(const LAS u32x4*)(oT + sq * VT_ROW + (sc0 + j * 8) * 2); u32x4 o;
                  o.x = pk2(bflo(uu[j].x) * bflo(mx.x), bfhi(uu[j].x) * bfhi(mx.x)); o.y = pk2(bflo(uu[j].y) * bflo(mx.y), bfhi(uu[j].y) * bfhi(mx.y));
                  o.z = pk2(bflo(uu[j].z) * bflo(mx.z), bfhi(uu[j].z) * bfhi(mx.z)); o.w = pk2(bflo(uu[j].w) * bflo(mx.w), bfhi(uu[j].w) * bfhi(mx.w));
                  *(u32x4*)(mrow + g * 128 + sc0 + j * 8) = o; } }
        }
        __syncthreads();
    }
}

namespace pg8 {
constexpr int BM = 256, BK = 64, HALF = 128, HTB = HALF * BK * 2, STAGE_BYTES = 8 * HTB, NXCD = 8, WGM = 4;
__host__ __device__ __forceinline__ int lds_byte(int r, int c) { const int st = (r >> 4) * 2 + (c >> 5), rr = r & 15, cc = c & 31, ob = rr * 64 + cc * 2; return st * 1024 + (ob ^ (((ob >> 9) & 1) << 5)); }
__host__ __device__ __forceinline__ void stage_rc(int b, int& R, int& C) { const int st = b / 1024, sb = b % 1024, swz = sb ^ (((sb >> 9) & 1) << 5); R = (st >> 1) * 16 + swz / 64; C = (st & 1) * 32 + (swz % 64) / 2; }
__host__ __device__ __forceinline__ int perm32(int rho) { const int n = rho >> 4, i = rho & 15; return 8 * (i >> 2) + 4 * n + (i & 3); }
struct Unit { int pm, pn, e, sub; };
struct Sched {
    int nM, nN, nwg, G, c; const LAS int* tl; int grouped, part, skipctx;
    __device__ __forceinline__ void init(int nM_, int nN_, int G_, int c_, const LAS int* tl_, int grouped_, int part_ = 0, int skipctx_ = 0) { nM = nM_; nN = nN_; nwg = nM * nN; G = G_; c = c_; tl = tl_; grouped = grouped_; part = part_; skipctx = skipctx_; }
    __device__ __forceinline__ bool next(int i, Unit& u) const {
        long L = (long)i * G + c; int sub = 0;
        const int full = (nwg / G) * G, R = nwg - full;
        if (part == 1 && L >= full) return false;
        if (part == 2) { if (i > 0 || R == 0) return false;
            if (4 * R <= G) { const int uu = (c >> 5) * 8 + (c & 7); if (uu >= R) return false; L = full + uu; sub = 1 + ((c >> 3) & 3); }
            else { if (c >= R) return false; L = full + c; } }
        if (L >= nwg) return false;
        int wgid = (int)L; { const int q = nwg / NXCD, r = nwg % NXCD, xcd = wgid % NXCD, off = wgid / NXCD; wgid = (xcd < r ? xcd * (q + 1) : r * (q + 1) + (xcd - r) * q) + off; }
        const int nig = WGM * nN, gid = wgid / nig, fm = gid * WGM, gsz = (nM - fm) < WGM ? (nM - fm) : WGM;
        u.pm = fm + ((wgid % nig) % gsz); u.pn = (wgid % nig) / gsz; int e = 0;
        if (grouped) {
#pragma unroll
            for (int x = 1; x < 8; ++x) e += (u.pm >= tl[x]) ? 1 : 0; }
        if (skipctx) u.pm = u.pm + (u.pm >> 5) + 1;
        u.e = e; u.sub = sub; return true;
    }
};
__device__ __forceinline__ unsigned cvt_pk_bf16(float lo, float hi) { unsigned r; asm volatile("v_cvt_pk_bf16_f32 %0, %1, %2" : "=v"(r) : "v"(lo), "v"(hi)); return r; }
__device__ __forceinline__ f32x2 gelu_pk(f32x2 v) {
    const f32x2 av = __builtin_elementwise_abs(v), d = av * 0.2316418882f + 1.0f;
    f32x2 t; t.x = __builtin_amdgcn_rcpf(d.x); t.y = __builtin_amdgcn_rcpf(d.y);
    f32x2 q = t * 0.5307027145f + (-0.7265760135f); q = q * t + 0.7107068705f; q = q * t + (-0.142248368f); q = q * t + 0.127414796f; q = q * t;
    const f32x2 s = (v * v) * (-0.72134752044f);
    f32x2 e; e.x = __builtin_amdgcn_exp2f(s.x); e.y = __builtin_amdgcn_exp2f(s.y);
    const f32x2 m = v * (q * e), r = v - m;
    f32x2 o; o.x = v.x < 0.f ? m.x : r.x; o.y = v.y < 0.f ? m.y : r.y; return o;
}
typedef f32x4 Acc[2][2][4][2];
__device__ __forceinline__ u32x4 pack8(f32x4 v0, f32x4 v1) { u32x4 w; w.x = cvt_pk_bf16(v0[0], v0[1]); w.y = cvt_pk_bf16(v0[2], v0[3]); w.z = cvt_pk_bf16(v1[0], v1[1]); w.w = cvt_pk_bf16(v1[2], v1[3]); return w; }
template <int ROPE>
struct EpiStoreT {
    static constexpr bool PERM = true;
    bf16* O; int ld; const f32x2* cs;
    __device__ __forceinline__ void operator()(const Acc& acc, const Unit& u, int wr, int wc, int fr, int fq) const {
        const int row0 = u.pm * BM + wr * 64 + fr, col0 = u.pn * BM + wc * 32 + 8 * fq;
        const int tb = (u.pm * BM) / RPB, tj = u.pm * BM - tb * RPB; const bool lat = tj >= NCTX;
#pragma unroll
        for (int ai = 0; ai < 2; ++ai)
#pragma unroll
            for (int m = 0; m < 4; ++m) { const int row = row0 + ai * HALF + m * 16; bf16* rowp = O + (size_t)row * ld + col0;
                const int spos = row - tb * RPB - NCTX;
#pragma unroll
                for (int bj = 0; bj < 2; ++bj) { if (SUB_SKIP(u, ai, bj)) continue;
                    f32x4 v0 = acc[ai][bj][m][0], v1 = acc[ai][bj][m][1];
                    if constexpr (ROPE != 0) {
                        const int slab = u.pn * 8 + bj * 4 + wc; bool rot; int axis;
                        if (ROPE == 1) { const int sm = slab % 6; rot = sm >= 4; axis = sm - 4; } else { rot = slab < 36; axis = slab & 1; }
                        if (rot && lat) {
                            const int pos = axis ? (spos & (GRIDW - 1)) : (spos / GRIDW); const f32x2* c = cs + pos * 16 + 8 * (fq & 1);
                            const f32x4 c0 = *(const f32x4*)(c), c1 = *(const f32x4*)(c + 2), c2 = *(const f32x4*)(c + 4), c3 = *(const f32x4*)(c + 6);
                            const float cc[8] = {c0.x, c0.z, c1.x, c1.z, c2.x, c2.z, c3.x, c3.z}, sn[8] = {c0.y, c0.w, c1.y, c1.w, c2.y, c2.w, c3.y, c3.w};
                            const float sg = (fq & 2) ? 1.f : -1.f;
                            float x[8] = {v0[0], v0[1], v0[2], v0[3], v1[0], v1[1], v1[2], v1[3]};
#pragma unroll
                            for (int e = 0; e < 8; ++e) { const auto rr = __builtin_amdgcn_permlane32_swap(__float_as_uint(x[e]), __float_as_uint(x[e]), false, false);
                                const float o = __uint_as_float((fq & 2) ? rr[0] : rr[1]); x[e] = x[e] * cc[e] + sg * o * sn[e]; }
                            v0 = (f32x4){x[0], x[1], x[2], x[3]}; v1 = (f32x4){x[4], x[5], x[6], x[7]};
                        }
                    }
                    *(u32x4*)(rowp + bj * HALF) = pack8(v0, v1); } }
    }
};
typedef EpiStoreT<0> EpiStore;
struct EpiKV {
    static constexpr bool PERM = true;
    bf16* Kb; bf16* Vb;
    __device__ __forceinline__ void operator()(const Acc& acc, const Unit& u, int wr, int wc, int fr, int fq) const {
        const int row0 = u.pm * BM + wr * 64 + fr, c0 = wc * 32 + 8 * fq;
#pragma unroll
        for (int ai = 0; ai < 2; ++ai)
#pragma unroll
            for (int m = 0; m < 4; ++m) { const size_t r = (size_t)(row0 + ai * HALF + m * 16);
                if (!SUB_SKIP(u, ai, 0)) *(u32x4*)(Kb + r * 1536 + u.pn * 192 + c0) = pack8(acc[ai][0][m][0], acc[ai][0][m][1]);
                if (!SUB_SKIP(u, ai, 1)) *(u32x4*)(Vb + r * DM + u.pn * 128 + c0) = pack8(acc[ai][1][m][0], acc[ai][1][m][1]); }
    }
};
struct EpiGelu {
    static constexpr bool PERM = true;
    bf16* U; bf16* V;
    __device__ __forceinline__ void operator()(const Acc& acc, const Unit& u, int wr, int wc, int fr, int fq) const {
        const int row0 = u.pm * BM + wr * 64 + fr; bf16* base = u.pn < 4 ? U : V; const int col0 = (u.pn & 3) * BM + wc * 32 + 8 * fq;
#pragma unroll
        for (int ai = 0; ai < 2; ++ai)
#pragma unroll
            for (int m = 0; m < 4; ++m) { bf16* rowp = base + (size_t)(row0 + ai * HALF + m * 16) * DM + col0;
#pragma unroll
                for (int bj = 0; bj < 2; ++bj) { if (SUB_SKIP(u, ai, bj)) continue; const f32x4 v0 = acc[ai][bj][m][0], v1 = acc[ai][bj][m][1];
                    const f32x2 a = gelu_pk((f32x2){v0[0], v0[1]}), b = gelu_pk((f32x2){v0[2], v0[3]}), c = gelu_pk((f32x2){v1[0], v1[1]}), d = gelu_pk((f32x2){v1[2], v1[3]});
                    *(u32x4*)(rowp + bj * HALF) = pack8((f32x4){a.x, a.y, b.x, b.y}, (f32x4){c.x, c.y, d.x, d.y}); } }
    }
};
struct EpiSwiglu {
    static constexpr bool PERM = true;
    bf16* O; int ld;
    __device__ __forceinline__ void operator()(const Acc& acc, const Unit& u, int wr, int wc, int fr, int fq) const {
        const int rl0 = wr * 64 + fr, nkt = ld >> 6;
        bf16* base = O + ((size_t)u.pm * nkt + (u.pn * 2 + (wc >> 1))) * (BM * BK) + (wc & 1) * 32 + 8 * fq;
#pragma unroll
        for (int ai = 0; ai < 2; ++ai)
#pragma unroll
            for (int m = 0; m < 4; ++m) { f32x4 o[2];
#pragma unroll
                for (int n = 0; n < 2; ++n) { const f32x4 a = acc[ai][0][m][n], b = acc[ai][1][m][n];
#pragma unroll
                    for (int k = 0; k < 4; ++k) o[n][k] = a[k] * __builtin_amdgcn_rcpf(1.f + __builtin_amdgcn_exp2f(-1.4426950408889634f * a[k])) * b[k]; }
                *(u32x4*)(base + (size_t)(rl0 + ai * HALF + m * 16) * BK) = pack8(o[0], o[1]); }
    }
};
struct EpiResid {
    static constexpr bool PERM = true;
    const float* x; const float* ctx; unsigned char* ws; int layer, chunk, from_in;
    __device__ __forceinline__ void operator()(const Acc& acc, const Unit& u, int wr, int wc, int fr, int fq) const {
        P p; p.in[0] = x; p.in[2] = ctx; p.ws = ws;
        const int r0 = u.pm * BM; const float* gate = mod_vec(p, layer, r0, chunk);
        const float* xin0 = in_row(p, r0); bf16* h0 = (bf16*)(ws + WS_H) + (size_t)r0 * DM;
        const int rl0 = wr * 64 + fr, col0 = u.pn * BM + wc * 32 + 8 * fq;
        f32x4 g0v[2], g1v[2];
#pragma unroll
        for (int bj = 0; bj < 2; ++bj) { g0v[bj] = *(const f32x4*)(gate + col0 + bj * HALF); g1v[bj] = *(const f32x4*)(gate + col0 + bj * HALF + 4); }
        u32x4 nx[2] = {(u32x4){0u, 0u, 0u, 0u}, (u32x4){0u, 0u, 0u, 0u}};
        if (!from_in) {
#pragma unroll
            for (int bj = 0; bj < 2; ++bj) { if (SUB_SKIP(u, 0, bj)) continue; nx[bj] = *(const u32x4*)(h0 + (size_t)rl0 * DM + col0 + bj * HALF); } }
#pragma unroll
        for (int it = 0; it < 8; ++it) { const int ai = it >> 2, m = it & 3; const size_t off = (size_t)(rl0 + ai * HALF + m * 16) * DM + col0;
            const u32x4 cu0 = nx[0], cu1 = nx[1];
            if (!from_in && it + 1 < 8) { const int ai2 = (it + 1) >> 2, m2 = (it + 1) & 3; const size_t off2 = (size_t)(rl0 + ai2 * HALF + m2 * 16) * DM + col0;
#pragma unroll
                for (int bj = 0; bj < 2; ++bj) { if (SUB_SKIP(u, ai2, bj)) continue; nx[bj] = *(const u32x4*)(h0 + off2 + bj * HALF); } }
#pragma unroll
            for (int bj = 0; bj < 2; ++bj) { if (SUB_SKIP(u, ai, bj)) continue; const f32x4 g0 = g0v[bj], g1 = g1v[bj]; f32x4 s0, s1;
                if (from_in) { s0 = *(const f32x4*)(xin0 + off + bj * HALF); s1 = *(const f32x4*)(xin0 + off + bj * HALF + 4); }
                else { const u32x4 w = bj ? cu1 : cu0; s0 = (f32x4){bflo(w.x), bfhi(w.x), bflo(w.y), bfhi(w.y)}; s1 = (f32x4){bflo(w.z), bfhi(w.z), bflo(w.w), bfhi(w.w)}; }
                *(u32x4*)(h0 + off + bj * HALF) = pack8(s0 + g0 * acc[ai][bj][m][0], s1 + g1 * acc[ai][bj][m][1]); }
            asm volatile("" ::: "memory"); }
    }
};

template <class Epi, bool GATHER, int K, bool SUB = false, bool ATILE = false, bool BTILE = false>
__device__ __forceinline__ void gemm_phase(int wv, LAS unsigned char* lds, const bf16* A, const bf16* Bt, size_t bstride, const Sched& S, const Epi& E, const LAS unsigned short* gtab) {
    const int tid = otid(wv), wid = __builtin_amdgcn_readfirstlane(tid >> 6), lane = tid & 63, wr = wid >> 2, wc = wid & 3, fr = lane & 15, fq = lane >> 4;
    constexpr int nt = K / BK;
    unsigned voffA[2], voffB[2]; int RA[2], CA[2];
#pragma unroll
    for (int i = 0; i < 2; ++i) { int R, C; stage_rc(tid * 16 + i * 8192, R, C); const int Rb = Epi::PERM ? ((R & ~31) + perm32(R & 31)) : R;
        RA[i] = R; CA[i] = C; voffA[i] = (unsigned)(R * (ATILE ? BK : K) + C) * 2u; voffB[i] = (unsigned)(Rb * (BTILE ? BK : K) + C) * 2u; }
    constexpr size_t kstepA = ATILE ? (size_t)BM * BK * 2 : (size_t)(BK * 2), hstepA = ATILE ? (size_t)HALF * BK * 2 : (size_t)HALF * K * 2, tstepA = (size_t)BM * K * 2;
    constexpr size_t kstepB = BTILE ? (size_t)BM * BK * 2 : (size_t)(BK * 2), hstepB = BTILE ? (size_t)HALF * BK * 2 : (size_t)HALF * K * 2, tstepB = (size_t)BM * K * 2;
    const unsigned ldsw = (unsigned)wid * 1024u;
    const int aoff = lds_byte(wr * 64 + fr, fq * 8), boff = lds_byte(wc * 32 + fr, fq * 8);
    const char* Ab = (const char*)A;
    unsigned cg[2][2], ng[2][2];
#define PG8_SA(b, h) (((b) * 2 + (h)) * HTB)
#define PG8_SB(b, h) ((4 + (b) * 2 + (h)) * HTB)
#define PG8_GLDS(gp, bufoff, i) __builtin_amdgcn_global_load_lds((const unsigned*)(gp), (LAS unsigned*)(lds + (bufoff) + ldsw + (i) * 8192), 16, 0, 0)
#define PG8_STAGE_B(bufoff, gbase) do { _Pragma("unroll") for (int _i = 0; _i < 2; ++_i) PG8_GLDS((const char*)(gbase) + voffB[_i], bufoff, _i); } while (0)
#define PG8_STAGE_A(bufoff, nxtsel, h, kt) do { \
        if constexpr (GATHER) { const char* _b = Ab + (size_t)(kt) * kstepA; _Pragma("unroll") for (int _i = 0; _i < 2; ++_i) { const unsigned _o = (nxtsel) ? ng[h][_i] : cg[h][_i]; PG8_GLDS(_b + _o, bufoff, _i); } } \
        else { const char* _b = ((nxtsel) ? nA : cA) + (size_t)(h) * hstepA + (size_t)(kt) * kstepA; _Pragma("unroll") for (int _i = 0; _i < 2; ++_i) PG8_GLDS(_b + voffA[_i], bufoff, _i); } } while (0)
#define PG8_LDA(dst, b, h) do { _Pragma("unroll") for (int m = 0; m < 4; ++m) _Pragma("unroll") for (int k = 0; k < 2; ++k) dst[m][k] = *(const LAS bf16x8*)(lds + PG8_SA(b, h) + aoff + m * 2048 + k * 1024); } while (0)
#define PG8_LDB(dst, b, h) do { _Pragma("unroll") for (int n = 0; n < 2; ++n) _Pragma("unroll") for (int k = 0; k < 2; ++k) dst[n][k] = *(const LAS bf16x8*)(lds + PG8_SB(b, h) + boff + n * 2048 + k * 1024); } while (0)
#define PG8_MMA(ai, bj, At, Bt_) do { if constexpr (SUB) { if (csub != 0 && csub != 1 + (ai) * 2 + (bj)) break; } __builtin_amdgcn_s_setprio(1); _Pragma("unroll") for (int m = 0; m < 4; ++m) _Pragma("unroll") for (int n = 0; n < 2; ++n) _Pragma("unroll") for (int k = 0; k < 2; ++k) \
        acc[ai][bj][m][n] = __builtin_amdgcn_mfma_f32_16x16x32_bf16(Bt_[n][k], At[m][k], acc[ai][bj][m][n], 0, 0, 0); __builtin_amdgcn_s_setprio(0); } while (0)
#define PG8_WAIT_V(n) asm volatile("s_waitcnt vmcnt(" #n ")" ::: "memory")
#define PG8_WAIT_L(n) asm volatile("s_waitcnt lgkmcnt(" #n ")" ::: "memory")
#define PG8_BAR __builtin_amdgcn_s_barrier()
#define PG8_SCHED __builtin_amdgcn_sched_barrier(0)
#define PG8_GOFF(dst, ui_) do { _Pragma("unroll") for (int _h = 0; _h < 2; ++_h) _Pragma("unroll") for (int _i = 0; _i < 2; ++_i) \
        dst[_h][_i] = ((unsigned)gtab[(ui_) * 256 + _h * HALF + RA[_i]] * (unsigned)K + (unsigned)CA[_i]) * 2u; } while (0)
    Unit cur, nxt; int ui = 0;
    if (!S.next(0, cur)) return;
    f32x4 acc[2][2][4][2];
#pragma unroll
    for (int a = 0; a < 2; ++a)
#pragma unroll
        for (int b = 0; b < 2; ++b)
#pragma unroll
            for (int m = 0; m < 4; ++m)
#pragma unroll
                for (int n = 0; n < 2; ++n) acc[a][b][m][n] = (f32x4){0.f, 0.f, 0.f, 0.f};
    bf16x8 At[4][2], B0[2][2], B1[2][2];
    const char* cA = Ab + (size_t)cur.pm * tstepA; const char* cB = (const char*)(Bt + (size_t)cur.e * bstride) + (size_t)cur.pn * tstepB;
    const char* nA = cA; int csub = cur.sub;
    if constexpr (GATHER) { PG8_GOFF(cg, 0); PG8_GOFF(ng, 0); }
    PG8_STAGE_B(PG8_SB(0, 0), cB); PG8_STAGE_B(PG8_SB(0, 1), cB + hstepB); PG8_STAGE_A(PG8_SA(0, 0), false, 0, 0); PG8_STAGE_A(PG8_SA(0, 1), false, 1, 0);
    if (wr == 1) PG8_BAR;
    PG8_WAIT_V(2); PG8_BAR;
    PG8_STAGE_B(PG8_SB(1, 0), cB + kstepB); PG8_STAGE_A(PG8_SA(1, 0), false, 0, 1); PG8_STAGE_B(PG8_SB(1, 1), cB + hstepB + kstepB);
    PG8_WAIT_V(6); PG8_BAR;
    for (;;) {
        const bool has_next = S.next(ui + 1, nxt);
        nA = has_next ? Ab + (size_t)nxt.pm * tstepA : cA; const char* nB = has_next ? (const char*)(Bt + (size_t)nxt.e * bstride) + (size_t)nxt.pn * tstepB : cB;
        if constexpr (GATHER) { if (has_next) PG8_GOFF(ng, ui + 1); else { _Pragma("unroll") for (int _h = 0; _h < 2; ++_h) _Pragma("unroll") for (int _i = 0; _i < 2; ++_i) ng[_h][_i] = cg[_h][_i]; } }
#pragma nounroll
        for (int t = 0; t < nt; t += 2) {
            const bool last = (t == nt - 2);
            const int t1 = t + 1, t2 = last ? 0 : t + 2, t3 = t2 + 1;
            const char* b2 = (last ? nB : cB) + (size_t)t2 * kstepB; const char* b3 = b2 + kstepB;
            PG8_LDB(B0, 0, 0); PG8_LDB(B1, 0, 1); PG8_SCHED; PG8_LDA(At, 0, 0); PG8_STAGE_A(PG8_SA(1, 1), false, 1, t1);
            PG8_WAIT_V(8); PG8_WAIT_L(0); PG8_BAR; PG8_MMA(0, 0, At, B0); PG8_MMA(0, 1, At, B1); PG8_BAR; PG8_SCHED;
            PG8_LDA(At, 0, 1); PG8_STAGE_B(PG8_SB(0, 0), b2); PG8_STAGE_B(PG8_SB(0, 1), b2 + hstepB); PG8_STAGE_A(PG8_SA(0, 0), last, 0, t2);
            PG8_WAIT_V(8); PG8_WAIT_L(0); PG8_BAR; PG8_MMA(1, 0, At, B0); PG8_MMA(1, 1, At, B1); PG8_BAR; PG8_SCHED;
            PG8_LDB(B0, 1, 0); PG8_LDB(B1, 1, 1); PG8_SCHED; PG8_LDA(At, 1, 0); PG8_STAGE_A(PG8_SA(0, 1), last, 1, t2);
            PG8_WAIT_V(8); PG8_WAIT_L(0); PG8_BAR; PG8_MMA(0, 0, At, B0); PG8_MMA(0, 1, At, B1); PG8_BAR; PG8_SCHED;
            PG8_LDA(At, 1, 1); PG8_STAGE_B(PG8_SB(1, 0), b3); PG8_STAGE_B(PG8_SB(1, 1), b3 + hstepB); PG8_STAGE_A(PG8_SA(1, 0), last, 0, t3);
            PG8_WAIT_V(8); PG8_WAIT_L(0); PG8_BAR; PG8_MMA(1, 0, At, B0); PG8_MMA(1, 1, At, B1); PG8_BAR; PG8_SCHED;
        }
        if (wr == 0) PG8_BAR;
        E(acc, cur, wr, wc, fr, fq);
        if (!has_next) break;
#pragma unroll
        for (int a = 0; a < 2; ++a)
#pragma unroll
            for (int b = 0; b < 2; ++b)
#pragma unroll
                for (int m = 0; m < 4; ++m)
#pragma unroll
                    for (int n = 0; n < 2; ++n) acc[a][b][m][n] = (f32x4){0.f, 0.f, 0.f, 0.f};
        cur = nxt; cA = nA; cB = nB; ++ui; csub = cur.sub;
        if constexpr (GATHER) { _Pragma("unroll") for (int _h = 0; _h < 2; ++_h) _Pragma("unroll") for (int _i = 0; _i < 2; ++_i) cg[_h][_i] = ng[_h][_i]; }
        if (wr == 1) PG8_BAR;
    }
    PG8_WAIT_V(0);
    PG8_BAR;
#undef PG8_SA
#undef PG8_SB
#undef PG8_GLDS
#undef PG8_STAGE_A
#undef PG8_STAGE_B
#undef PG8_LDA
#undef PG8_LDB
#undef PG8_MMA
#undef PG8_WAIT_V
#undef PG8_WAIT_L
#undef PG8_BAR
#undef PG8_SCHED
#undef PG8_GOFF
}

template <class Epi, int K, bool ATILE, bool BTILE>
__device__ __forceinline__ void gemm_sub_unit(int wv, LAS unsigned char* lds, const bf16* A, const bf16* Bt, size_t bstride, const Sched& S, const Epi& E) {
    Unit u; if (!S.next(0, u)) return;
    const int tid = otid(wv), wid = __builtin_amdgcn_readfirstlane(tid >> 6), lane = tid & 63, wr = wid >> 2, wc = wid & 3, fr = lane & 15, fq = lane >> 4;
    constexpr int nt = K / BK;
    unsigned voffA[2], voffB[2];
#pragma unroll
    for (int i = 0; i < 2; ++i) { int R, C; stage_rc(tid * 16 + i * 8192, R, C); const int Rb = Epi::PERM ? ((R & ~31) + perm32(R & 31)) : R;
        voffA[i] = (unsigned)(R * (ATILE ? BK : K) + C) * 2u; voffB[i] = (unsigned)(Rb * (BTILE ? BK : K) + C) * 2u; }
    constexpr size_t kstepA = ATILE ? (size_t)BM * BK * 2 : (size_t)(BK * 2), hstepA = ATILE ? (size_t)HALF * BK * 2 : (size_t)HALF * K * 2, tstepA = (size_t)BM * K * 2;
    constexpr size_t kstepB = BTILE ? (size_t)BM * BK * 2 : (size_t)(BK * 2), hstepB = BTILE ? (size_t)HALF * BK * 2 : (size_t)HALF * K * 2, tstepB = (size_t)BM * K * 2;
    const unsigned ldsw = (unsigned)wid * 1024u;
    const int aoff = lds_byte(wr * 64 + fr, fq * 8), boff = lds_byte(wc * 32 + fr, fq * 8);
#pragma nounroll
    for (int sq = (u.sub ? u.sub - 1 : 0); sq < (u.sub ? u.sub : 4); ++sq) {
    const int ai = sq >> 1, bj = sq & 1; Unit uq = u; uq.sub = sq + 1;
    const char* cA = (const char*)A + (size_t)u.pm * tstepA + (size_t)ai * hstepA;
    const char* cB = (const char*)(Bt + (size_t)u.e * bstride) + (size_t)u.pn * tstepB + (size_t)bj * hstepB;
#define SU_SA(b) ((b) * 2 * HTB)
#define SU_SB(b) ((4 + (b) * 2) * HTB)
#define SU_STAGE(b, kt) do { _Pragma("unroll") for (int _i = 0; _i < 2; ++_i) { \
        __builtin_amdgcn_global_load_lds((const unsigned*)(cA + (size_t)(kt) * kstepA + voffA[_i]), (LAS unsigned*)(lds + SU_SA(b) + ldsw + _i * 8192), 16, 0, 0); \
        __builtin_amdgcn_global_load_lds((const unsigned*)(cB + (size_t)(kt) * kstepB + voffB[_i]), (LAS unsigned*)(lds + SU_SB(b) + ldsw + _i * 8192), 16, 0, 0); } } while (0)
    f32x4 a1[4][2];
#pragma unroll
    for (int m = 0; m < 4; ++m)
#pragma unroll
        for (int n = 0; n < 2; ++n) a1[m][n] = (f32x4){0.f, 0.f, 0.f, 0.f};
#define SU_READ(At, Bf, b) do { _Pragma("unroll") for (int _m = 0; _m < 4; ++_m) { _Pragma("unroll") for (int _k = 0; _k < 2; ++_k) At[_m][_k] = *(const LAS bf16x8*)(lds + SU_SA(b) + aoff + _m * 2048 + _k * 1024); } \
        _Pragma("unroll") for (int _n = 0; _n < 2; ++_n) { _Pragma("unroll") for (int _k = 0; _k < 2; ++_k) Bf[_n][_k] = *(const LAS bf16x8*)(lds + SU_SB(b) + boff + _n * 2048 + _k * 1024); } } while (0)
#define SU_MMA(At, Bf) do { __builtin_amdgcn_s_setprio(1); _Pragma("unroll") for (int _m = 0; _m < 4; ++_m) { _Pragma("unroll") for (int _n = 0; _n < 2; ++_n) { _Pragma("unroll") for (int _k = 0; _k < 2; ++_k) \
        a1[_m][_n] = __builtin_amdgcn_mfma_f32_16x16x32_bf16(Bf[_n][_k], At[_m][_k], a1[_m][_n], 0, 0, 0); } } __builtin_amdgcn_s_setprio(0); } while (0)
#define SU_HALF(Fa, Fb, Ga, Gb, b, t2) do { \
        asm volatile("s_waitcnt lgkmcnt(0)" ::: "memory"); __builtin_amdgcn_s_barrier();        \
        SU_STAGE(b, t2); \
        asm volatile("s_waitcnt vmcnt(4)" ::: "memory"); __builtin_amdgcn_s_barrier();           \
        __builtin_amdgcn_sched_barrier(0); \
        SU_READ(Ga, Gb, (b) ^ 1); \
        __builtin_amdgcn_sched_barrier(0); \
        SU_MMA(Fa, Fb); \
        __builtin_amdgcn_sched_barrier(0); } while (0)
    bf16x8 A0[4][2], B0[2][2], A1[4][2], B1[2][2];
    SU_STAGE(0, 0); SU_STAGE(1, 1);
    asm volatile("s_waitcnt vmcnt(4)" ::: "memory"); __builtin_amdgcn_s_barrier();
    SU_READ(A0, B0, 0);
    static_assert(nt % 2 == 0, "K tiles come in pairs");
#pragma nounroll
    for (int t = 0; t < nt; t += 2) {
        { const int t2 = (t + 2 < nt) ? t + 2 : 0; SU_HALF(A0, B0, A1, B1, 0, t2); }
        { const int t3 = (t + 3 < nt) ? t + 3 : 1; SU_HALF(A1, B1, A0, B0, 1, t3); }
    }
    asm volatile("s_waitcnt vmcnt(0) lgkmcnt(0)" ::: "memory");
    __builtin_amdgcn_s_barrier();
#undef SU_READ
#undef SU_MMA
#undef SU_HALF
    f32x4 acc[2][2][4][2];
#pragma unroll
    for (int a = 0; a < 2; ++a)
#pragma unroll
        for (int bb = 0; bb < 2; ++bb)
#pragma unroll
            for (int m = 0; m < 4; ++m)
#pragma unroll
                for (int n = 0; n < 2; ++n) acc[a][bb][m][n] = a1[m][n];
    E(acc, uq, wr, wc, fr, fq);
    }
#undef SU_SA
#undef SU_SB
#undef SU_STAGE
}
}

namespace att {
using f32x16 = __attribute__((ext_vector_type(16))) float;
using s16x4 = __attribute__((ext_vector_type(4))) short;
constexpr int NW = 8, QBLK = 32, KVBLK = 64;
#define ATT_SBAR() __builtin_amdgcn_sched_barrier(0)
__device__ __forceinline__ int crow(int r, int hi) { return (r & 3) + 8 * (r >> 2) + 4 * hi; }
__device__ __forceinline__ unsigned cvtpk(float lo, float hi) { unsigned r; asm volatile("v_cvt_pk_bf16_f32 %0, %1, %2" : "=v"(r) : "v"(lo), "v"(hi)); return r; }
template <int DQK> struct Cst { static constexpr float scale() { return DQK == 128 ? 0.088388347648318440f : (DQK == 192 ? 0.072168783648703220f : 0.125f); } };
template <int DQK> __device__ __forceinline__ int kswz(int row, int colB) { constexpr int RS = DQK * 2; return row * RS + (colB ^ ((RS == 256 ? (row & 15) : ((row >> 1) & 7)) << 4)); }
template <int DV> __device__ __forceinline__ int v_st(int k, int c) { const int kk = (k & ~0xC) | ((k & 4) << 1) | ((k & 8) >> 1); return ((kk >> 3) * (DV / 32) + (c >> 5)) * 512 + ((kk & 7) * 32 + (c & 31)) * 2; }
__device__ __forceinline__ int v_rd_base(int lane) { return ((lane & 3) << 3) | (((lane >> 2) & 3) << 6) | (((lane >> 4) & 1) << 5) | (((lane >> 5) & 1) << 8); }
typedef short v4i16_t __attribute__((ext_vector_type(4)));
typedef __attribute__((address_space(3))) v4i16_t lds_v4i16_t;
template <int OFF> __device__ __forceinline__ s16x4 tr_read(int vb) { return __builtin_bit_cast(s16x4, __builtin_amdgcn_ds_read_tr16_b64_v4i16((lds_v4i16_t*)(unsigned)(vb + OFF))); }

template <int DQK, int THRI> __device__ __forceinline__ void partialSM(f32x16& p0, f32x16& p1, float& m_reg, float& mn, float& alpha) {
    constexpr float SC = Cst<DQK>::scale(), C = SC * 1.4426950408889634f, THR = (float)THRI;
    float pmax = p0[0];
#pragma unroll
    for (int r = 1; r < 16; ++r) pmax = fmaxf(pmax, p0[r]);
#pragma unroll
    for (int r = 0; r < 16; ++r) pmax = fmaxf(pmax, p1[r]);
    { auto rr = __builtin_amdgcn_permlane32_swap(__float_as_uint(pmax), __float_as_uint(pmax), false, false); pmax = fmaxf(__uint_as_float(rr[0]), __uint_as_float(rr[1])); }
    if (__builtin_expect(__all(pmax - m_reg <= THR / SC), 1)) { mn = m_reg; alpha = 1.f; }
    else { mn = fmaxf(m_reg, pmax); alpha = __builtin_amdgcn_exp2f((m_reg - mn) * C); m_reg = mn; }
    const float mnC = -mn * C;
#pragma unroll
    for (int r = 0; r < 16; ++r) p0[r] = fmaf(p0[r], C, mnC);
#pragma unroll
    for (int r = 0; r < 16; ++r) p1[r] = fmaf(p1[r], C, mnC);
#pragma unroll
    for (int r = 0; r < 16; ++r) p0[r] = __builtin_amdgcn_exp2f(p0[r]);
}
__device__ __forceinline__ void finishSM(f32x16& p0, f32x16& p1, float alpha, float& l_reg, bf16x8& pa0, bf16x8& pa1, bf16x8& pa2, bf16x8& pa3) {
#pragma unroll
    for (int r = 0; r < 16; ++r) p1[r] = __builtin_amdgcn_exp2f(p1[r]);
    float ps = 0;
#pragma unroll
    for (int r = 0; r < 16; ++r) ps += p0[r];
#pragma unroll
    for (int r = 0; r < 16; ++r) ps += p1[r];
    { auto rr = __builtin_amdgcn_permlane32_swap(__float_as_uint(ps), __float_as_uint(ps), false, false); ps = __uint_as_float(rr[0]) + __uint_as_float(rr[1]); }
    l_reg = l_reg * alpha + ps;
#define ATT_PK4(Pv, BASE, OUT) do { unsigned a0 = cvtpk(Pv[BASE + 0], Pv[BASE + 1]), a1 = cvtpk(Pv[BASE + 2], Pv[BASE + 3]); \
    unsigned b0 = cvtpk(Pv[BASE + 4], Pv[BASE + 5]), b1 = cvtpk(Pv[BASE + 6], Pv[BASE + 7]); \
    auto r0 = __builtin_amdgcn_permlane32_swap(a0, b0, false, false); auto r1 = __builtin_amdgcn_permlane32_swap(a1, b1, false, false); \
    u32x4 w = {r0[0], r1[0], r0[1], r1[1]}; OUT = *reinterpret_cast<bf16x8*>(&w); } while (0)
    ATT_PK4(p0, 0, pa0); ATT_PK4(p0, 8, pa1); ATT_PK4(p1, 0, pa2); ATT_PK4(p1, 8, pa3);
#undef ATT_PK4
}
template <int DQK, int QL> __device__ __forceinline__ void qkt(f32x16& p0, f32x16& p1, const char* Ks, const bf16x8* qr, const char* ql, const int* kb, int r32, int hi) {
    p0 = f32x16{}; p1 = f32x16{};
#pragma unroll
    for (int d0 = 0; d0 < DQK / 16; ++d0) {
        bf16x8 b0, b1;
        if constexpr (DQK == 192) { b0 = *reinterpret_cast<const bf16x8*>(Ks + kb[d0 & 3] + 128 * (d0 >> 2)); b1 = *reinterpret_cast<const bf16x8*>(Ks + kb[d0 & 3] + 128 * (d0 >> 2) + 32 * DQK * 2); }
        else { const int cb = (d0 * 16 + hi * 8) * 2; b0 = *reinterpret_cast<const bf16x8*>(Ks + kswz<DQK>(r32, cb)); b1 = *reinterpret_cast<const bf16x8*>(Ks + kswz<DQK>(32 + r32, cb)); }
        bf16x8 q; if constexpr (QL > 0) { if (d0 >= DQK / 16 - QL) q = *reinterpret_cast<const bf16x8*>(ql + (d0 - (DQK / 16 - QL)) * 1024); else q = qr[d0]; } else q = qr[d0];
        p0 = __builtin_amdgcn_mfma_f32_32x32x16_bf16(b0, q, p0, 0, 0, 0);
        p1 = __builtin_amdgcn_mfma_f32_32x32x16_bf16(b1, q, p1, 0, 0, 0); }
}
template <int DV, int D0> __device__ __forceinline__ void pv_one(f32x16& od, int vb, bf16x8 pa0, bf16x8 pa1, bf16x8 pa2, bf16x8 pa3) {
    constexpr int KS = (DV / 32) * 1024, HF = (DV / 32) * 512;
    const s16x4 l0 = tr_read<D0 * 512 + 0 * KS>(vb), h0 = tr_read<D0 * 512 + 0 * KS + HF>(vb), l1 = tr_read<D0 * 512 + 1 * KS>(vb), h1 = tr_read<D0 * 512 + 1 * KS + HF>(vb);
    const s16x4 l2 = tr_read<D0 * 512 + 2 * KS>(vb), h2 = tr_read<D0 * 512 + 2 * KS + HF>(vb), l3 = tr_read<D0 * 512 + 3 * KS>(vb), h3 = tr_read<D0 * 512 + 3 * KS + HF>(vb);
#define ATT_PK(L, H) (bf16x8){L[0], L[1], L[2], L[3], H[0], H[1], H[2], H[3]}
    od = __builtin_amdgcn_mfma_f32_32x32x16_bf16(pa0, ATT_PK(l0, h0), od, 0, 0, 0);
    od = __builtin_amdgcn_mfma_f32_32x32x16_bf16(pa1, ATT_PK(l1, h1), od, 0, 0, 0);
    od = __builtin_amdgcn_mfma_f32_32x32x16_bf16(pa2, ATT_PK(l2, h2), od, 0, 0, 0);
    od = __builtin_amdgcn_mfma_f32_32x32x16_bf16(pa3, ATT_PK(l3, h3), od, 0, 0, 0);
#undef ATT_PK
}
template <int DV> __device__ __forceinline__ void pv_all(f32x16* o, int vb, bf16x8 pa0, bf16x8 pa1, bf16x8 pa2, bf16x8 pa3) {
    pv_one<DV, 0>(o[0], vb, pa0, pa1, pa2, pa3); pv_one<DV, 1>(o[1], vb, pa0, pa1, pa2, pa3);
    if constexpr (DV == 128) { pv_one<DV, 2>(o[2], vb, pa0, pa1, pa2, pa3); pv_one<DV, 3>(o[3], vb, pa0, pa1, pa2, pa3); }
}
template <int DQK, int DV> struct Shm { static constexpr int V = KVBLK * DV * 2, K = KVBLK * DQK * 2, WSO = 2 * V + 2 * K, QLO = WSO + NW * 64 * 4; };

template <int DQK, int DV, int SD, bool WINDOW, int THRI, int QL, bool DMA = false>
__device__ __forceinline__ void attn_unit(const bf16* __restrict__ Qb, int ldq, const bf16* __restrict__ Kh, int ldk, const bf16* __restrict__ Vh, int ldv, bf16* __restrict__ Ob, int ldo,
                                          int NT, int segB, int qlat0, int klat0, float m_init, float l_init, char* lds, int wv) {
    constexpr int SHM_V = Shm<DQK, DV>::V, SHM_K = Shm<DQK, DV>::K, NKP = DQK / 64, NVP = DV / 64, ND0 = DV / 32;
    int tid_ = otid(wv);
    const int tid = tid_, wid = tid >> 6, lane = tid & 63, r32 = lane & 31, hi = lane >> 5;
    char* V_lds = lds; char* K_lds = lds + 2 * SHM_V;
    float* wsf = (float*)(lds + Shm<DQK, DV>::WSO) + wid * 64; float* li_l = wsf; float* al_l = wsf + 32;
    float m_reg = m_init, l_reg = l_init; f32x16 o[ND0]; bf16x8 qr[DQK / 16 - QL > 0 ? DQK / 16 - QL : 1];
    char* ql = lds + Shm<DQK, DV>::QLO + wid * (QL > 0 ? QL : 1) * 1024 + lane * 16;
#pragma unroll
    for (int d = 0; d < ND0; ++d) o[d] = f32x16{};
    const bf16* Qw = Qb + (long)(wid * QBLK + r32) * ldq + hi * 8;
#pragma unroll
    for (int d0 = 0; d0 < DQK / 16; ++d0) { const bf16x8 q = *reinterpret_cast<const bf16x8*>(Qw + d0 * 16); if (d0 < DQK / 16 - QL) qr[d0 < DQK / 16 - QL ? d0 : 0] = q; else *reinterpret_cast<bf16x8*>(ql + (d0 - (DQK / 16 - QL)) * 1024) = q; }
    const int srow = tid >> 3, sch = tid & 7;
    const int kflip = (DQK == 128) ? ((srow >> 3) & 1) * 128 : 0;
    const int kgo = srow * ldk + sch * 8, klo = kswz<DQK>(srow, sch * 16) & ~kflip, vgo = srow * ldv + sch * 8, vlo = v_st<DV>(srow, sch * 8);
    const int vb0 = (int)(uintptr_t)V_lds + v_rd_base(lane);
    int kb[4];
#pragma unroll
    for (int j = 0; j < 4; ++j) kb[j] = kswz<DQK>(r32, 32 * j + 16 * hi);
    bf16x8 ks[SD][NKP], vs[SD][NVP];
#define ATT_BAR() asm volatile("s_waitcnt lgkmcnt(0)\n\ts_barrier" ::: "memory")
#define ATT_KROW(t) ((t) < 4 ? 64 * (t) : segB + 64 * ((t) - 4))
#define ATT_SLOAD(i, t) do { const long _kr = ATT_KROW(t); _Pragma("unroll") for (int _x = 0; _x < NVP; ++_x) vs[i][_x] = *reinterpret_cast<const bf16x8*>(Vh + _kr * ldv + vgo + 64 * _x); \
        _Pragma("unroll") for (int _x = 0; _x < NKP; ++_x) ks[i][_x] = *reinterpret_cast<const bf16x8*>(Kh + _kr * ldk + kgo + 64 * _x); } while (0)
#define ATT_SWRITE(b, i) do { _Pragma("unroll") for (int _x = 0; _x < NVP; ++_x) *(bf16x8*)(V_lds + (b) * SHM_V + vlo + 1024 * _x) = vs[i][_x]; \
        _Pragma("unroll") for (int _x = 0; _x < NKP; ++_x) *(bf16x8*)(K_lds + (b) * SHM_K + klo + ((128 * _x) ^ kflip)) = ks[i][_x]; } while (0)
#define ATT_SWAIT() do { if constexpr (SD == 2) { if constexpr (NKP + NVP == 4) asm volatile("s_waitcnt vmcnt(4)" ::: "memory"); else if constexpr (NKP + NVP == 2) asm volatile("s_waitcnt vmcnt(2)" ::: "memory"); else asm volatile("s_waitcnt vmcnt(5)" ::: "memory"); } \
        else asm volatile("s_waitcnt vmcnt(0)" ::: "memory"); } while (0)
#define ATT_RESC(a) do { if (__any((a) < 1.f)) { if (hi == 0) al_l[r32] = (a); asm volatile("s_waitcnt lgkmcnt(0)" ::: "memory"); \
        _Pragma("unroll") for (int d = 0; d < ND0; ++d) _Pragma("unroll") for (int r = 0; r < 16; ++r) o[d][r] *= al_l[crow(r, hi)]; } } while (0)
#define ATT_MASK(P0, P1, t) do { if constexpr (WINDOW) { if ((t) >= 4) { const int _d0 = klat0 + 64 * ((t) - 4) - (qlat0 + wid * QBLK + r32); \
        _Pragma("unroll") for (int r = 0; r < 16; ++r) { const int _d = _d0 + crow(r, hi); P0[r] = (_d > 128 || _d < -128) ? -1e30f : P0[r]; P1[r] = (_d + 32 > 128 || _d + 32 < -128) ? -1e30f : P1[r]; } } } } while (0)
    f32x16 pA0, pA1, pB0, pB1; float mnA, mnB, alA, alB; bf16x8 pa0, pa1, pa2, pa3;
    constexpr int SE = 0, SO = SD - 1;
    if (wv >= 4) __builtin_amdgcn_s_setprio(1);
    if constexpr (!DMA) {
    ATT_SLOAD(SE, 0); asm volatile("s_waitcnt vmcnt(0)" ::: "memory"); ATT_SWRITE(0, SE); ATT_BAR();
    qkt<DQK, QL>(pA0, pA1, K_lds, qr, ql, kb, r32, hi); partialSM<DQK, THRI>(pA0, pA1, m_reg, mnA, alA);
    ATT_SLOAD(SO, 1); if constexpr (SD == 2) { if (2 < NT) ATT_SLOAD(SE, 2); }
    ATT_SWAIT(); ATT_SWRITE(1, SO); ATT_BAR();
    for (int j = 1; j + 1 < NT; j += 2) {
        ATT_SBAR(); qkt<DQK, QL>(pB0, pB1, K_lds + SHM_K, qr, ql, kb, r32, hi); ATT_MASK(pB0, pB1, j);
        finishSM(pA0, pA1, alA, l_reg, pa0, pa1, pa2, pa3); ATT_SBAR();
        ATT_SLOAD(SO, j + SD); ATT_SBAR();
        pv_all<DV>(o, vb0, pa0, pa1, pa2, pa3); partialSM<DQK, THRI>(pB0, pB1, m_reg, mnB, alB);
        ATT_BAR(); ATT_SWAIT(); ATT_SWRITE(0, SE);
        ATT_RESC(alB); ATT_BAR();
        ATT_SBAR(); qkt<DQK, QL>(pA0, pA1, K_lds, qr, ql, kb, r32, hi); ATT_MASK(pA0, pA1, j + 1);
        finishSM(pB0, pB1, alB, l_reg, pa0, pa1, pa2, pa3); ATT_SBAR();
        if (SD == 1 || j + 3 < NT) ATT_SLOAD(SE, j + 1 + SD); ATT_SBAR();
        pv_all<DV>(o, vb0 + SHM_V, pa0, pa1, pa2, pa3); partialSM<DQK, THRI>(pA0, pA1, m_reg, mnA, alA);
        ATT_BAR(); ATT_SWAIT(); ATT_SWRITE(1, SO);
        ATT_RESC(alA); ATT_BAR();
    }
    ATT_SBAR(); qkt<DQK, QL>(pB0, pB1, K_lds + SHM_K, qr, ql, kb, r32, hi); ATT_MASK(pB0, pB1, NT - 1);
    finishSM(pA0, pA1, alA, l_reg, pa0, pa1, pa2, pa3); ATT_SBAR();
    pv_all<DV>(o, vb0, pa0, pa1, pa2, pa3); partialSM<DQK, THRI>(pB0, pB1, m_reg, mnB, alB);
    ATT_BAR(); ATT_RESC(alB);
    finishSM(pB0, pB1, alB, l_reg, pa0, pa1, pa2, pa3); ATT_SBAR();
    pv_all<DV>(o, vb0 + SHM_V, pa0, pa1, pa2, pa3);
    } else {
        static_assert(!DMA || (DQK == 128 && DV == 128 && !WINDOW), "DMA staging: D = 128 dense only");
        LAS char* ldsL = (LAS char*)lds;
        const int krow = 4 * wid + ((lane >> 4) & 3);
        const int kgo_d = krow * ldk + (((lane & 15) ^ (krow & 15)) << 3);
        const int vsub = 2 * wid + (lane >> 5), w32 = lane & 31, vkk = ((vsub >> 2) << 3) | (w32 >> 2), vk = (vkk & ~0xC) | ((vkk & 4) << 1) | ((vkk & 8) >> 1);
        const int vgo_d = vk * ldv + (vsub & 3) * 32 + (w32 & 3) * 8;
#define ATT_DMA_K(b, t) do { const bf16* _g = Kh + (long)ATT_KROW(t) * ldk + kgo_d; \
        __builtin_amdgcn_global_load_lds((const unsigned*)_g, (LAS unsigned*)(ldsL + 2 * SHM_V + (b) * SHM_K + wv * 1024), 16, 0, 0); \
        __builtin_amdgcn_global_load_lds((const unsigned*)(_g + 32 * ldk), (LAS unsigned*)(ldsL + 2 * SHM_V + (b) * SHM_K + wv * 1024 + 8192), 16, 0, 0); } while (0)
#define ATT_DMA_V(b, t) do { const bf16* _g = Vh + (long)ATT_KROW(t) * ldv + vgo_d; \
        __builtin_amdgcn_global_load_lds((const unsigned*)_g, (LAS unsigned*)(ldsL + (b) * SHM_V + wv * 1024), 16, 0, 0); \
        __builtin_amdgcn_global_load_lds((const unsigned*)(_g + 32 * ldv), (LAS unsigned*)(ldsL + (b) * SHM_V + wv * 1024 + 8192), 16, 0, 0); } while (0)
#define ATT_LAND() asm volatile("s_waitcnt vmcnt(0) lgkmcnt(0)\n\ts_barrier" ::: "memory")
        ATT_DMA_K(0, 0); ATT_DMA_V(0, 0); ATT_DMA_K(1, 1);
        ATT_LAND();
        qkt<DQK, QL>(pA0, pA1, K_lds, qr, ql, kb, r32, hi); partialSM<DQK, THRI>(pA0, pA1, m_reg, mnA, alA);
        ATT_BAR();
        ATT_DMA_K(0, 2); ATT_DMA_V(1, 1);
        for (int j = 1; j + 1 < NT; j += 2) {
            ATT_SBAR(); qkt<DQK, QL>(pB0, pB1, K_lds + SHM_K, qr, ql, kb, r32, hi);
            finishSM(pA0, pA1, alA, l_reg, pa0, pa1, pa2, pa3); ATT_SBAR();
            pv_all<DV>(o, vb0, pa0, pa1, pa2, pa3); partialSM<DQK, THRI>(pB0, pB1, m_reg, mnB, alB);
            ATT_LAND();
            if (j + 2 < NT) ATT_DMA_K(1, j + 2);
            ATT_DMA_V(0, j + 1);
            ATT_RESC(alB);
            ATT_SBAR(); qkt<DQK, QL>(pA0, pA1, K_lds, qr, ql, kb, r32, hi);
            finishSM(pB0, pB1, alB, l_reg, pa0, pa1, pa2, pa3); ATT_SBAR();
            pv_all<DV>(o, vb0 + SHM_V, pa0, pa1, pa2, pa3); partialSM<DQK, THRI>(pA0, pA1, m_reg, mnA, alA);
            ATT_LAND();
            if (j + 3 < NT) ATT_DMA_K(0, j + 3);
            ATT_DMA_V(1, j + 2);
            ATT_RESC(alA);
        }
        ATT_SBAR(); qkt<DQK, QL>(pB0, pB1, K_lds + SHM_K, qr, ql, kb, r32, hi);
        finishSM(pA0, pA1, alA, l_reg, pa0, pa1, pa2, pa3); ATT_SBAR();
        pv_all<DV>(o, vb0, pa0, pa1, pa2, pa3); partialSM<DQK, THRI>(pB0, pB1, m_reg, mnB, alB);
        ATT_LAND(); ATT_RESC(alB);
        finishSM(pB0, pB1, alB, l_reg, pa0, pa1, pa2, pa3); ATT_SBAR();
        pv_all<DV>(o, vb0 + SHM_V, pa0, pa1, pa2, pa3);
#undef ATT_DMA_K
#undef ATT_DMA_V
#undef ATT_LAND
    }
    __builtin_amdgcn_s_setprio(0);
    if (hi == 0) li_l[r32] = l_reg; asm volatile("s_waitcnt lgkmcnt(0)" ::: "memory");
    float rli[16];
#pragma unroll
    for (int r = 0; r < 16; ++r) rli[r] = __builtin_amdgcn_rcpf(li_l[crow(r, hi)]);
    int tid2 = otid(wv);
    bf16* Ow = Ob + (long)((tid2 >> 6) * QBLK) * ldo + (tid2 & 31);
#pragma unroll
    for (int r = 0; r < 16; ++r) { const int orow = crow(r, (tid2 >> 5) & 1);
#pragma unroll
        for (int d0 = 0; d0 < ND0; ++d0) Ow[(long)orow * ldo + d0 * 32] = (bf16)f2bf(o[d0][r] * rli[r]); }
    ATT_BAR();
#undef ATT_BAR
#undef ATT_KROW
#undef ATT_SLOAD
#undef ATT_SWRITE
#undef ATT_SWAIT
#undef ATT_RESC
#undef ATT_MASK
}

template <int DQK, int DV, int SD, bool WINDOW, int QL, bool DMA = false>
__device__ __forceinline__ void attn_phase(const bf16* Q, int ldq, int qhs, const bf16* Kb, int ldk, int khs, const bf16* Vb, int ldv, int vhs, bf16* O, int ldo, int ohs, int H, int G, const float* sinks, char* lds, int wv) {
    const int nlat = NB * H * 32, ntot = WINDOW ? nlat : nlat + NB * H;
    const int c0 = (gridDim.x == 256) ? (((int)blockIdx.x & 7) * 32 + ((int)blockIdx.x >> 3)) : (int)blockIdx.x;
    for (int L = c0; L < ntot; L += gridDim.x) {
        int b, h, q0row, NT, segB = NCTX, qlat0 = 0, klat0 = 0; float m0 = -1e30f, l0 = 0.f;
        if (L < nlat) { const int qb = L & 31; h = (L >> 5) % H; b = (L >> 5) / H; q0row = NCTX + qb * 256; NT = 4 + SEQ / 64;
            if constexpr (WINDOW) { qlat0 = qb * 256; klat0 = max(0, qlat0 - 128); const int hi_ = min(SEQ, qlat0 + 256 + 128); NT = 4 + (hi_ - klat0) / 64; segB = NCTX + klat0; m0 = sinks[h] / Cst<DQK>::scale(); l0 = 1.f; } }
        else { const int L2 = L - nlat; h = L2 % H; b = L2 / H; q0row = 0; NT = 4; }
        const size_t rb = (size_t)b * RPB; const int kvh = h / G;
        attn_unit<DQK, DV, SD, WINDOW, 8, QL, DMA>(Q + (rb + q0row) * ldq + h * qhs, ldq, Kb + rb * ldk + kvh * khs, ldk, Vb + rb * ldv + kvh * vhs, ldv, O + (rb + q0row) * ldo + h * ohs, ldo, NT, segB, qlat0, klat0, m0, l0, lds, wv);
    }
}
}

#define XB_TMO      128
#define XB_XCNT(j)  (256  + 64 * (j))
#define XB_XSUB(j)  (1280 + 64 * (j))
#define XB_XGEN(j)  (2304 + 64 * (j))
#define XB_TOP      3328
#define XB_TOPGEN   3392
#define XCD_BAR_WORDS 3456
#define XB_SPIN_CAP (1u << 18)
__device__ __forceinline__ unsigned xb_ld(unsigned* p)              { return __hip_atomic_load(p, __ATOMIC_RELAXED, __HIP_MEMORY_SCOPE_AGENT); }
__device__ __forceinline__ unsigned xb_add(unsigned* p, unsigned v) { return __hip_atomic_fetch_add(p, v, __ATOMIC_RELAXED, __HIP_MEMORY_SCOPE_AGENT); }
__device__ __forceinline__ unsigned xb_xcc_id() { return (unsigned)__builtin_amdgcn_s_getreg((3 << 11) | 20) & 0xFu; }
#define XB_SPIN(cond, bar) do { unsigned _sp = 0; while (cond) { __builtin_amdgcn_s_sleep(1); \
    if ((++_sp & 255u) == 0u) { if (xb_ld(&(bar)[XB_TMO])) break; if (_sp > XB_SPIN_CAP) { atomicAdd(&(bar)[XB_TMO], 1u); break; } } } } while (0)
struct XcdBarrier { unsigned* bar; unsigned x; volatile LAS unsigned* st; };
__device__ __forceinline__ XcdBarrier xcd_barrier_post(unsigned* bar, volatile LAS unsigned* st) {
    XcdBarrier b; b.bar = bar; b.x = xb_xcc_id(); b.st = st;
    if (threadIdx.x == 0) (void)xb_add(&bar[XB_XCNT(b.x)], 1u);
    return b;
}
__device__ __forceinline__ void xcd_barrier_complete(unsigned* bar, unsigned x, unsigned& nloc, unsigned& nx) {
    const unsigned G = gridDim.x * gridDim.y * gridDim.z;
    unsigned sum, cnt, mine, sp = 0u;
    for (;;) {
        sum = 0u; cnt = 0u; mine = 0u;
#pragma unroll
        for (unsigned j = 0; j < 16; ++j) { const unsigned c = xb_ld(&bar[XB_XCNT(j)]); sum += c; cnt += (c > 0u) ? 1u : 0u; mine = (j == x) ? c : mine; }
        if (sum == G) break;
        __builtin_amdgcn_s_sleep(1);
        if ((++sp & 255u) == 0u) { if (xb_ld(&bar[XB_TMO])) break; if (sp > XB_SPIN_CAP) { atomicAdd(&bar[XB_TMO], 1u); break; } }
    }
    nloc = mine > 0u ? mine : 1u; nx = cnt > 0u ? cnt : 1u;
}
__device__ __forceinline__ void xcd_barrier(const XcdBarrier& b, int wv) {
    asm volatile("s_waitcnt vmcnt(0)" ::: "memory");
    __syncthreads();
    if (otid(wv) == 0) {
        unsigned* bar = b.bar;
        __builtin_amdgcn_s_waitcnt(0);
        unsigned nloc = b.st[0], nx = b.st[1];
        if (nloc == 0u) { xcd_barrier_complete(bar, b.x, nloc, nx); b.st[0] = nloc; b.st[1] = nx; }
        const unsigned old = xb_add(&bar[XB_XSUB(b.x)], 1u);
        const unsigned gen = old / nloc;
        if (old + 1u == (gen + 1u) * nloc) {
            __builtin_amdgcn_fence(__ATOMIC_RELEASE, "agent");
            asm volatile("s_waitcnt vmcnt(0)" ::: "memory");
            const unsigned og = xb_add(&bar[XB_TOP], 1u);
            const unsigned tg = og / nx;
            if (og + 1u == (tg + 1u) * nx) xb_add(&bar[XB_TOPGEN], 1u);
            else XB_SPIN(xb_ld(&bar[XB_TOPGEN]) == tg, bar);
            __builtin_amdgcn_fence(__ATOMIC_ACQUIRE, "agent");
            xb_add(&bar[XB_XGEN(b.x)], 1u);
            asm volatile("s_waitcnt vmcnt(0)" ::: "memory");
        } else {
            XB_SPIN(xb_ld(&bar[XB_XGEN(b.x)]) == gen, bar);
            __builtin_amdgcn_fence(__ATOMIC_ACQUIRE, "agent");
            asm volatile("s_waitcnt vmcnt(0)" ::: "memory");
        }
    }
    __syncthreads();
}

constexpr int RING_OFF = 0, GT_OFF = 131072, MISC_OFF = GT_OFF + 15360, LDS_BYTES = MISC_OFF + 1024;
constexpr int MAX_UNITS_PER_WG = 30;
constexpr int NPH = 35;
__device__ __forceinline__ void grouped_setup(const P& p, int wv, int m, LAS int* tl) {
    __syncthreads();
    const int t_ = otid(wv);
    if (t_ < NE) { const unsigned* cnt = WSP(const unsigned, WS_CTL) + CW_CNT + 64 * m; tl[16 + t_] = (int)__hip_atomic_load(cnt + t_, __ATOMIC_RELAXED, __HIP_MEMORY_SCOPE_AGENT); }
    __syncthreads();
    if (t_ == 0) { int o = 0;
        for (int e = 0; e < NE; ++e) { tl[e] = o; o += (tl[16 + e] + 255) >> 8; }
        tl[8] = o; }
    __syncthreads();
}
template <int K, int N, class Epi, int SPLIT = 1, int SKIPCTX = 0, bool ATILE = false, bool BTILE = false> __device__ __forceinline__ void gemm_plain(const P& p, int wv, unsigned char* lds_, const bf16* A, const bf16* Bt, const Epi& E) {
    LAS unsigned char* lds = (LAS unsigned char*)lds_;
    constexpr int nM = SKIPCTX ? 128 : T / 256, nwg = nM * (N / 256), R = nwg % 256;
    pg8::Sched S; S.init(nM, N / 256, (int)gridDim.x, (int)blockIdx.x, (const LAS int*)(lds + MISC_OFF), 0, (SPLIT && R > 0 && 4 * R <= 256) ? 1 : 0, SKIPCTX);
    pg8::gemm_phase<Epi, false, K, false, ATILE, BTILE>(wv, lds + RING_OFF, A, Bt, 0, S, E, nullptr);
    if constexpr (SPLIT && R > 0 && 4 * R <= 256) {
        pg8::Sched S2; S2.init(nM, N / 256, (int)gridDim.x, (int)blockIdx.x, (const LAS int*)(lds + MISC_OFF), 0, 2, SKIPCTX);
        pg8::gemm_sub_unit<Epi, K, ATILE, BTILE>(wv, lds + RING_OFF, A, Bt, 0, S2, E);
    }
}
__device__ __forceinline__ void moe_w13(const P& p, int wv, unsigned char* lds_, int m) {
    LAS unsigned char* lds = (LAS unsigned char*)lds_; LAS int* tl = (LAS int*)(lds + MISC_OFF); LAS unsigned short* gtab = (LAS unsigned short*)(lds + GT_OFF);
    grouped_setup(p, wv, m, tl);
    pg8::Sched S; S.init(tl[8], 2 * FE / 256, (int)gridDim.x, (int)blockIdx.x, tl, 1);
    const int* idx = WSP(const int, WS_IDX); const int tidg = otid(wv);
    { static_assert(MAX_UNITS_PER_WG % 2 == 0, "two units per step");
      const int half = __builtin_amdgcn_readfirstlane(tidg >> 8), row = tidg & 255; int vals[MAX_UNITS_PER_WG / 2];
#pragma unroll
      for (int k = 0; k < MAX_UNITS_PER_WG / 2; ++k) { pg8::Unit u; int v = 0;
          if (S.next(2 * k + half, u)) { const int pr = (u.pm - tl[u.e]) * 256 + row; const int* ie = idx + (size_t)u.e * T; v = ie[pr < tl[16 + u.e] ? pr : 0]; }
          vals[k] = v; }
#pragma unroll
      for (int k = 0; k < MAX_UNITS_PER_WG / 2; ++k) gtab[(2 * k + half) * 256 + row] = (unsigned short)vals[k]; }
    __syncthreads();
    pg8::EpiSwiglu E{WSP(bf16, WS_ACT), FE};
    pg8::gemm_phase<pg8::EpiSwiglu, true, DM>(wv, lds + RING_OFF, WSP(const bf16, WS_A), WSP(const bf16, W_13M) + (size_t)m * NE * 2 * FE * DM, (size_t)2 * FE * DM, S, E, gtab);
}
__device__ __forceinline__ void moe_w2(const P& p, int wv, unsigned char* lds_, int m) {
    LAS unsigned char* lds = (LAS unsigned char*)lds_; LAS int* tl = (LAS int*)(lds + MISC_OFF);
    grouped_setup(p, wv, m, tl);
    pg8::Sched S; S.init(tl[8], DM / 256, (int)gridDim.x, (int)blockIdx.x, tl, 1, 1, 0);
    pg8::EpiStore E{WSP(bf16, WS_Y), DM, nullptr};
    pg8::gemm_phase<pg8::EpiStore, false, FE, false, true, true>(wv, lds + RING_OFF, WSP(const bf16, WS_ACT), WSP(const bf16, W_2M) + (size_t)m * NE * DM * FE, (size_t)DM * FE, S, E, nullptr);
    pg8::Sched S2; S2.init(tl[8], DM / 256, (int)gridDim.x, (int)blockIdx.x, tl, 1, 2, 0);
    pg8::gemm_sub_unit<pg8::EpiStore, FE, true, true>(wv, lds + RING_OFF, WSP(const bf16, WS_ACT), WSP(const bf16, W_2M) + (size_t)m * NE * DM * FE, (size_t)DM * FE, S2, E);
}
__device__ __forceinline__ void dense_w13(const P& p, int wv, unsigned char* lds, int pi) { pg8::EpiSwiglu E{WSP(bf16, WS_ACT), FF}; gemm_plain<DM, 2 * FF, pg8::EpiSwiglu, 0>(p, wv, lds, WSP(const bf16, WS_A), WSP(const bf16, W_13F) + (size_t)pi * 2 * FF * DM, E); }
__device__ __forceinline__ void dense_w2(const P& p, int wv, unsigned char* lds, int pi, int layer) { pg8::EpiResid E{p.in[0], p.in[2], p.ws, layer, 5, 0}; gemm_plain<FF, DM, pg8::EpiResid, 1, 0, true, true>(p, wv, lds, WSP(const bf16, WS_ACT), WSP(const bf16, W_2F) + (size_t)pi * DM * FF, E); }
template <int SKIPCTX = 0> __device__ __forceinline__ void wo_gemm(const P& p, int wv, unsigned char* lds, const bf16* Ain, size_t woff, int layer, int from_in) { pg8::EpiResid E{p.in[0], p.in[2], p.ws, layer, 2, from_in}; gemm_plain<DM, DM, pg8::EpiResid, 1, SKIPCTX>(p, wv, lds, Ain, WSP(const bf16, woff), E); }

template <int PH> __device__ __forceinline__ void run_phase(const P& p, int wv, unsigned char* lds) {
    const int bid = blockIdx.x, nb = gridDim.x;
    if constexpr (PH == 0) phase_prologue(p, wv, bid, nb, lds);
    if constexpr (PH == 1) phase_norm_plain<true>(p, wv, bid, nb, 0, 0);
    if constexpr (PH == 2) { pg8::EpiStore E{WSP(bf16, WS_QKV), A_NQKV, nullptr}; gemm_plain<DM, A_NQKV>(p, wv, lds, WSP(const bf16, WS_A), WSP(const bf16, W_QKVA), E); }
    if constexpr (PH == 3) phase_post_a(p, wv, bid, nb);
    if constexpr (PH == 4) att::attn_phase<128, 128, 2, false, 0, true>(WSP(const bf16, WS_QKV), A_NQKV, 128, WSP(const bf16, WS_QKV) + 1024, A_NQKV, 128, WSP(const bf16, WS_QKV) + 1280, A_NQKV, 128, WSP(bf16, WS_OB), DM, 128, 8, 4, nullptr, (char*)lds, wv);
    if constexpr (PH == 5) wo_gemm(p, wv, lds, WSP(const bf16, WS_OB), W_OA, 0, 1);
    if constexpr (PH == 6) phase_norm_plain<false>(p, wv, bid, nb, 0, 1);
    if constexpr (PH == 7) dense_w13(p, wv, lds, 0);
    if constexpr (PH == 8) dense_w2(p, wv, lds, 0, 0);
    if constexpr (PH == 9) phase_norm_plain<false>(p, wv, bid, nb, 1, 0);
    if constexpr (PH == 10) { pg8::EpiStore E{WSP(bf16, WS_DOWN), B_NDOWN_P, nullptr}; gemm_plain<DM, B_NDOWN_P>(p, wv, lds, WSP(const bf16, WS_A), WSP(const bf16, W_DOWN), E); }
    if constexpr (PH == 11) phase_post_b1(p, wv, bid, nb);
    if constexpr (PH == 12) { pg8::EpiStoreT<1> E{WSP(bf16, WS_QKV), 1536, WSP(const f32x2, WS_ROPE64)}; gemm_plain<B_QL, B_NUQ>(p, wv, lds, WSP(const bf16, WS_DQN), WSP(const bf16, W_UQ), E); }
    if constexpr (PH == 13) { pg8::EpiKV E{WSP(bf16, WS_KB), WSP(bf16, WS_VB)}; gemm_plain<B_KVL, B_NUKV>(p, wv, lds, WSP(const bf16, WS_DKVN), WSP(const bf16, W_UKV), E); }
    if constexpr (PH == 14) att::attn_phase<192, 128, 1, false, 5>(WSP(const bf16, WS_QKV), 1536, 192, WSP(const bf16, WS_KB), 1536, 192, WSP(const bf16, WS_VB), DM, 128, WSP(bf16, WS_OB), DM, 128, 8, 1, nullptr, (char*)lds, wv);
    if constexpr (PH == 15) wo_gemm(p, wv, lds, WSP(const bf16, WS_OB), W_OB, 1, 0);
    if constexpr (PH == 16) phase_norm<4>(p, wv, bid, nb, lds, 1, 1, 0, 0, 0, true);
    if constexpr (PH == 17) moe_w13(p, wv, lds, 0);
    if constexpr (PH == 18) moe_w2(p, wv, lds, 0);
    if constexpr (PH == 19) phase_combine<false>(p, wv, bid, nb, lds, 2, 0, 0, 1);
    if constexpr (PH == 20) { pg8::EpiGelu E{WSP(bf16, WS_QKV), WSP(bf16, WS_KB)}; gemm_plain<DM, C_NIN>(p, wv, lds, WSP(const bf16, WS_A), WSP(const bf16, W_IN), E); }
    if constexpr (PH == 21) phase_sgu(p, wv, bid, nb, lds);
    if constexpr (PH == 22) wo_gemm(p, wv, lds, WSP(const bf16, WS_VB), W_OUT, 2, 0);
    if constexpr (PH == 23) phase_norm_plain<false>(p, wv, bid, nb, 2, 1);
    if constexpr (PH == 24) dense_w13(p, wv, lds, 1);
    if constexpr (PH == 25) dense_w2(p, wv, lds, 1, 2);
    if constexpr (PH == 26) phase_norm_plain<false>(p, wv, bid, nb, 3, 0);
    if constexpr (PH == 27) { pg8::EpiStoreT<3> E{WSP(bf16, WS_QKV), D_NQKV, WSP(const f32x2, WS_ROPE64)}; gemm_plain<DM, D_NQKV>(p, wv, lds, WSP(const bf16, WS_A), WSP(const bf16, W_QKVD), E); }
    if constexpr (PH == 29) att::attn_phase<64, 64, 2, true, 0>(WSP(const bf16, WS_QKV), D_NQKV, 64, WSP(const bf16, WS_QKV) + 1024, D_NQKV, 64, WSP(const bf16, WS_QKV) + 1152, D_NQKV, 64, WSP(bf16, WS_OB), DM, 64, 16, 8, p.in[26], (char*)lds, wv);
    if constexpr (PH == 30) wo_gemm<1>(p, wv, lds, WSP(const bf16, WS_OB), W_OD, 3, 0);
    if constexpr (PH == 31) phase_norm<4>(p, wv, bid, nb, lds, 3, 1, 0, 0, 1, false);
    if constexpr (PH == 32) moe_w13(p, wv, lds, 1);
    if constexpr (PH == 33) moe_w2(p, wv, lds, 1);
    if constexpr (PH == 34) phase_combine<true>(p, wv, bid, nb, lds, 0, 0, 1, 3);
}
#ifndef MK_PER_PHASE
#define MK_PER_PHASE 0
#endif
template <int PH> __global__ void __launch_bounds__(512, 2) k_phase(P p) {
    extern __shared__ __attribute__((aligned(16))) unsigned char lds[];
    run_phase<PH>(p, __builtin_amdgcn_readfirstlane((int)threadIdx.x >> 6), lds);
}
#define AS4 __attribute__((address_space(4)))
#ifndef PROBE_DUP_MASK
#define PROBE_DUP_MASK 0ull
#endif
template <int PH> __device__ __forceinline__ void phase_fn(const AS4 P* pp, int wv, LAS unsigned char* lds_) {
    const AS4 P* q = pp; asm volatile("" : "+s"(q));
    P p;
#pragma unroll
    for (int i = 0; i < 33; ++i) p.in[i] = q->in[i];
    p.out = q->out; p.ws = q->ws; p.ph_lo = 0; p.ph_hi = 0;
    run_phase<PH>(p, wv, (unsigned char*)lds_);
}
template <int PH> __device__ __forceinline__ void run_all(const AS4 P* pp, int wv, LAS unsigned char* lds, const XcdBarrier& bar) {
    constexpr bool on = (PH != 28);
    if constexpr (on) phase_fn<PH>(pp, wv, lds);
    if constexpr (on && ((PROBE_DUP_MASK >> PH) & 1ull) != 0) { __syncthreads(); phase_fn<PH>(pp, wv, lds); }
    if constexpr (PH + 1 < NPH) { if constexpr (on) xcd_barrier(bar, wv); run_all<PH + 1>(pp, wv, lds, bar); }
}
__global__ void __launch_bounds__(512, 2) k_mega(P p_) {
    extern __shared__ __attribute__((aligned(16))) unsigned char lds[];
    const AS4 P* pp = (const AS4 P*)__builtin_amdgcn_kernarg_segment_ptr();
    const int wv = __builtin_amdgcn_readfirstlane((int)threadIdx.x >> 6);
    LAS unsigned* misc = (LAS unsigned*)((LAS unsigned char*)lds + MISC_OFF);
    if (threadIdx.x < 256) misc[threadIdx.x] = 0u;
    __syncthreads();
    const XcdBarrier bar = xcd_barrier_post((unsigned*)(pp->ws + WS_CTL) + CW_BAR, (volatile LAS unsigned*)(misc + 64));
    run_all<0>(pp, wv, (LAS unsigned char*)lds, bar);
}

template <int PH> static void phase(hipStream_t st, const P& p) {
    static bool attr = false; if (!attr) { (void)hipFuncSetAttribute((const void*)k_phase<PH>, hipFuncAttributeMaxDynamicSharedMemorySize, LDS_BYTES); attr = true; }
    hipLaunchKernelGGL((k_phase<PH>), dim3(256), dim3(512), LDS_BYTES, st, p);
}
template <int LO, int HI> static void phases(hipStream_t st, const P& p) { if constexpr (LO < HI) { phase<LO>(st, p); phases<LO + 1, HI>(st, p); } }

extern "C" void kernel_launch(void* const* d_in, const int* in_sizes, int n_in, void* d_out, int out_size, void* d_ws, size_t ws_size, hipStream_t stream) {
    if (n_in != 33 || ws_size < WS_END || out_size != NB * SEQ * DM) { fprintf(stderr, "kernel_launch: unexpected shapes n_in %d ws %zu (need %zu) out %d\n", n_in, ws_size, (size_t)WS_END, out_size); return; }
    P p{}; for (int i = 0; i < 33; ++i) p.in[i] = (const float*)d_in[i]; p.out = (float*)d_out; p.ws = (unsigned char*)d_ws; p.ph_lo = 0; p.ph_hi = 0;
    unsigned char* ws = (unsigned char*)d_ws;
    (void)hipMemsetAsync(ws + WS_CTL, 0, CTL_BYTES, stream);
#if MK_PER_PHASE
    phases<0, NPH>(stream, p);
#else
    static int grid = 0;
    if (grid == 0) {
        int dev = 0, cus = 0, per_cu = 0;
        (void)hipGetDevice(&dev); (void)hipDeviceGetAttribute(&cus, hipDeviceAttributeMultiprocessorCount, dev);
        if (hipFuncSetAttribute((const void*)k_mega, hipFuncAttributeMaxDynamicSharedMemorySize, LDS_BYTES) != hipSuccess) { fprintf(stderr, "kernel_launch: hipFuncSetAttribute failed\n"); grid = -1; return; }
        if (hipOccupancyMaxActiveBlocksPerMultiprocessor(&per_cu, (const void*)k_mega, 512, LDS_BYTES) != hipSuccess || per_cu < 1) { fprintf(stderr, "kernel_launch: occupancy query says %d blocks per CU\n", per_cu); (void)hipGetLastError(); }
        grid = cus;
        if (grid != 256) fprintf(stderr, "kernel_launch: %d CUs (built for 256)\n", grid);
    }
    if (grid < 0) return;
    hipLaunchKernelGGL(k_mega, dim3(grid), dim3(512), LDS_BYTES, stream, p);
#endif
    const hipError_t le = hipPeekAtLastError();
    if (le != hipSuccess) fprintf(stderr, "kernel_launch: launch failed: %s\n", hipGetErrorName(le));
}
```
